# Optimizing an MI355X kernel written in HIP

```python
import math
import jax, jax.numpy as jnp
from jax import lax
import numpy as np

D_MODEL = 1024
BATCH = 8
SEQ = 2048
DEPTH = 1

CHUNK = 64
MEM_LEN = 256
Q_BLOCK = 128
EPS = 1e-6
RET_HEADS = 4
RET_DK = D_MODEL // RET_HEADS
RET_DV = 2 * RET_DK
RET_THETA_BASE = 10000.0
DIFF_HEADS = 8
DIFF_DK = D_MODEL // (2 * DIFF_HEADS)
DIFF_DV = 2 * DIFF_DK
ROPE_THETA = 500000.0
ROT_DIM = DIFF_DK // 4
LAMBDA_INIT_SCALE = 0.1
MEM_HEADS = 4
MEM_DH = D_MODEL // MEM_HEADS
D_FF = 2816
N_BRANCHES = 3

RET_QK_W = RET_HEADS * RET_DK
RET_V_W = RET_HEADS * RET_DV
DIFF_QK_W = DIFF_HEADS * 2 * DIFF_DK
DIFF_V_W = DIFF_HEADS * DIFF_DV
MEM_Q_W = MEM_HEADS * MEM_DH
GATE_W = N_BRANCHES * D_MODEL
IN_SPLITS = (RET_QK_W, RET_QK_W, RET_V_W, RET_V_W, DIFF_QK_W, DIFF_QK_W, DIFF_V_W, MEM_Q_W, GATE_W)
D_IN = int(sum(IN_SPLITS))
IN_OFFSETS = tuple(int(o) for o in np.cumsum(IN_SPLITS)[:-1])

kernel_name = "hybrid_retention_diffattn_memory_macaron"


def _rms(x, w=None):
    xf = x.astype(jnp.float32)
    y = xf * lax.rsqrt(jnp.mean(xf * xf, axis=-1, keepdims=True) + EPS)
    if w is not None:
        y = y * w.astype(jnp.float32)
    return y.astype(x.dtype)


def _swiglu(h, wg, wu, wd):
    return (jax.nn.silu(h @ wg) * (h @ wu)) @ wd


def _rope_partial(x, cos, sin):
    x1 = x[..., :ROT_DIM // 2]
    x2 = x[..., ROT_DIM // 2:ROT_DIM]
    return jnp.concatenate([x1 * cos - x2 * sin, x2 * cos + x1 * sin, x[..., ROT_DIM:]], axis=-1)


def _rot_interleaved(x, cos, sin):
    xe = x[..., 0::2]
    xo = x[..., 1::2]
    return jnp.stack([xe * cos - xo * sin, xo * cos + xe * sin], axis=-1).reshape(x.shape)


def _retention(q, k, v):
    B, S = q.shape[0], q.shape[1]
    N = S // CHUNK
    dt = v.dtype
    log_g = jnp.log(1.0 - 2.0 ** (-5.0 - jnp.arange(RET_HEADS, dtype=jnp.float32)))
    idx = jnp.arange(CHUNK, dtype=jnp.float32)
    d_intra = jnp.exp(log_g[:, None, None] * jnp.abs(idx[:, None] - idx[None, :])).astype(dt)
    q_dec = jnp.exp(log_g[:, None] * (idx[None, :] + 1.0)).astype(dt)
    k_dec = jnp.exp(log_g[:, None] * (CHUNK - 1.0 - idx[None, :])).astype(dt)
    c_dec = jnp.exp(log_g * CHUNK).astype(dt)

    def to_chunks(t):
        return t.reshape(B, N, CHUNK, RET_HEADS, t.shape[-1]).transpose(1, 0, 3, 2, 4)

    qc, kc, vc = to_chunks(q), to_chunks(k), to_chunks(v)
    scores = jnp.einsum('nbhcd,nbhed->nbhce', qc, kc) * d_intra
    o_intra = jnp.einsum('nbhce,nbhef->nbhcf', scores, vc)

    def step(state, xs):
        qn, kn, vn = xs
        o = jnp.einsum('bhcd,bhde->bhce', qn * q_dec[None, :, :, None], state)
        state = state * c_dec[None, :, None, None] + jnp.einsum(
            'bhcd,bhce->bhde', kn * k_dec[None, :, :, None], vn)
        return state, o

    s0 = jnp.zeros((B, RET_HEADS, RET_DK, RET_DV), dt)
    _, o_inter = lax.scan(step, s0, (qc, kc, vc))
    o = (o_intra + o_inter).transpose(1, 0, 3, 2, 4)
    return o.reshape(B, S, RET_HEADS, RET_DV)


def _diff_attention(q, k, v, lam):
    S = q.shape[1]
    scale = 1.0 / math.sqrt(DIFF_DK)
    q = q.transpose(0, 2, 3, 1, 4)
    k = k.transpose(0, 2, 3, 1, 4)
    v = v.transpose(0, 2, 1, 3)
    chunk_id = jnp.arange(S) // CHUNK
    outs = []
    for i in range(S // Q_BLOCK):
        q0, q1 = i * Q_BLOCK, (i + 1) * Q_BLOCK
        s = jnp.einsum('bhrqd,bhrkd->bhrqk', q[:, :, :, q0:q1], k[:, :, :, :q1]).astype(jnp.float32) * scale
        mask = chunk_id[q0:q1, None] >= chunk_id[None, :q1]
        p = jax.nn.softmax(jnp.where(mask, s, -jnp.inf), axis=-1)
        a = p[:, :, 0] - lam * p[:, :, 1]
        outs.append(jnp.einsum('bhqk,bhkd->bhqd', a.astype(v.dtype), v[:, :, :q1]))
    return jnp.concatenate(outs, axis=2).transpose(0, 2, 1, 3)


def _mem_attention(q, k, v):
    s = jnp.einsum('bshd,bmhd->bhsm', q, k).astype(jnp.float32) * (1.0 / math.sqrt(MEM_DH))
    p = jax.nn.softmax(s, axis=-1)
    return jnp.einsum('bhsm,bmhd->bshd', p.astype(v.dtype), v)


def setup_inputs(seed: int = 0) -> dict:
    key = jax.random.key(seed)
    ks = jax.random.split(key, 32)
    f32 = jnp.float32
    L = DEPTH

    def w(k, shape, fan_in):
        return jax.random.normal(k, shape, f32) * (fan_in ** -0.5)

    def gain(k, shape):
        return 1.0 + 0.05 * jax.random.normal(k, shape, f32)

    offset = jax.random.randint(ks[2], (BATCH, 1), 0, 64) * CHUNK
    positions = (offset + jnp.arange(SEQ)[None, :]).astype(jnp.int32)
    return {
        "x": jax.random.normal(ks[0], (BATCH, SEQ, D_MODEL), f32),
        "mem": jax.random.normal(ks[1], (BATCH, MEM_LEN, D_MODEL), f32),
        "positions": positions,
        "ffn1_norm": gain(ks[3], (L, D_MODEL)),
        "ffn1_w_gate": w(ks[4], (L, D_MODEL, D_FF), D_MODEL),
        "ffn1_w_up": w(ks[5], (L, D_MODEL, D_FF), D_MODEL),
        "ffn1_w_down": w(ks[6], (L, D_FF, D_MODEL), D_FF),
        "mix_norm": gain(ks[7], (L, D_MODEL)),
        "w_in": w(ks[8], (L, D_MODEL, D_IN), D_MODEL),
        "b_gate": 0.01 * jax.random.normal(ks[9], (L, GATE_W), f32),
        "ret_w_o": w(ks[10], (L, RET_V_W, D_MODEL), RET_V_W),
        "diff_q_norm": gain(ks[11], (L, DIFF_DK)),
        "diff_k_norm": gain(ks[12], (L, DIFF_DK)),
        "diff_lambda_q1": LAMBDA_INIT_SCALE * jax.random.normal(ks[13], (L, DIFF_DK), f32),
        "diff_lambda_k1": LAMBDA_INIT_SCALE * jax.random.normal(ks[14], (L, DIFF_DK), f32),
        "diff_lambda_q2": LAMBDA_INIT_SCALE * jax.random.normal(ks[15], (L, DIFF_DK), f32),
        "diff_lambda_k2": LAMBDA_INIT_SCALE * jax.random.normal(ks[16], (L, DIFF_DK), f32),
        "diff_subln": gain(ks[17], (L, DIFF_DV)),
        "diff_w_o": w(ks[18], (L, DIFF_V_W, D_MODEL), DIFF_V_W),
        "mem_norm": gain(ks[19], (L, D_MODEL)),
        "mem_w_kv": w(ks[20], (L, D_MODEL, 2 * MEM_Q_W), D_MODEL),
        "mem_q_norm": gain(ks[21], (L, MEM_DH)),
        "mem_k_norm": gain(ks[22], (L, MEM_DH)),
        "mem_w_o": w(ks[23], (L, MEM_Q_W, D_MODEL), MEM_Q_W),
        "w_out": w(ks[24], (L, D_MODEL, D_MODEL), D_MODEL),
        "ffn2_norm": gain(ks[25], (L, D_MODEL)),
        "ffn2_w_gate": w(ks[26], (L, D_MODEL, D_FF), D_MODEL),
        "ffn2_w_up": w(ks[27], (L, D_MODEL, D_FF), D_MODEL),
        "ffn2_w_down": w(ks[28], (L, D_FF, D_MODEL), D_FF),
        "final_norm": gain(ks[29], (L, D_MODEL)),
    }


def reference(x, mem, positions, ffn1_norm, ffn1_w_gate, ffn1_w_up, ffn1_w_down, mix_norm, w_in, b_gate,
              ret_w_o, diff_q_norm, diff_k_norm, diff_lambda_q1, diff_lambda_k1, diff_lambda_q2,
              diff_lambda_k2, diff_subln, diff_w_o, mem_norm, mem_w_kv, mem_q_norm, mem_k_norm, mem_w_o,
              w_out, ffn2_norm, ffn2_w_gate, ffn2_w_up, ffn2_w_down, final_norm):
    B, S = x.shape[0], x.shape[1]
    M = mem.shape[1]
    dt = x.dtype
    pos = positions.astype(jnp.float32)[..., None]
    ret_inv = 1.0 / (RET_THETA_BASE ** jnp.linspace(0.0, 1.0, RET_DK // 2, dtype=jnp.float32))
    ret_ang = pos * ret_inv
    r_cos = jnp.cos(ret_ang)[:, :, None, :].astype(dt)
    r_sin = jnp.sin(ret_ang)[:, :, None, :].astype(dt)
    rope_inv = 1.0 / (ROPE_THETA ** (jnp.arange(0, ROT_DIM, 2, dtype=jnp.float32) / ROT_DIM))
    d_ang = pos * rope_inv
    d_cos = jnp.cos(d_ang)[:, :, None, None, :].astype(dt)
    d_sin = jnp.sin(d_ang)[:, :, None, None, :].astype(dt)

    for l in range(DEPTH):
        x = x + 0.5 * _swiglu(_rms(x, ffn1_norm[l]), ffn1_w_gate[l], ffn1_w_up[l], ffn1_w_down[l])

        h = _rms(x, mix_norm[l])
        rq, rk, rv, rg, dq, dk, dv, mq, gates = jnp.split(h @ w_in[l], IN_OFFSETS, axis=-1)

        rq = _rot_interleaved(rq.reshape(B, S, RET_HEADS, RET_DK), r_cos, r_sin)
        rk = _rot_interleaved(rk.reshape(B, S, RET_HEADS, RET_DK), r_cos, r_sin) * (RET_DK ** -0.5)
        ro = _retention(rq, rk, rv.reshape(B, S, RET_HEADS, RET_DV))
        ro = _rms(ro).reshape(B, S, RET_V_W) * jax.nn.silu(rg)
        ret_out = ro @ ret_w_o[l]

        dq = _rope_partial(_rms(dq.reshape(B, S, DIFF_HEADS, 2, DIFF_DK), diff_q_norm[l]), d_cos, d_sin)
        dk = _rope_partial(_rms(dk.reshape(B, S, DIFF_HEADS, 2, DIFF_DK), diff_k_norm[l]), d_cos, d_sin)
        lam_init = 0.8 - 0.6 * math.exp(-0.3 * l)
        lam = (jnp.exp(jnp.sum(diff_lambda_q1[l].astype(jnp.float32) * diff_lambda_k1[l].astype(jnp.float32)))
               - jnp.exp(jnp.sum(diff_lambda_q2[l].astype(jnp.float32) * diff_lambda_k2[l].astype(jnp.float32)))
               + lam_init)
        do = _diff_attention(dq, dk, dv.reshape(B, S, DIFF_HEADS, DIFF_DV), lam)
        do = _rms(do, diff_subln[l]) * (1.0 - lam_init)
        diff_out = do.reshape(B, S, DIFF_V_W) @ diff_w_o[l]

        mk, mv = jnp.split(_rms(mem, mem_norm[l]) @ mem_w_kv[l], 2, axis=-1)
        mq = _rms(mq.reshape(B, S, MEM_HEADS, MEM_DH), mem_q_norm[l])
        mk = _rms(mk.reshape(B, M, MEM_HEADS, MEM_DH), mem_k_norm[l])
        mo = _mem_attention(mq, mk, mv.reshape(B, M, MEM_HEADS, MEM_DH))
        mem_out = mo.reshape(B, S, MEM_Q_W) @ mem_w_o[l]

        g = jax.nn.sigmoid(gates + b_gate[l]).reshape(B, S, N_BRANCHES, D_MODEL)
        merged = g[:, :, 0] * ret_out + g[:, :, 1] * diff_out + g[:, :, 2] * mem_out
        x = x + merged @ w_out[l]

        x = x + 0.5 * _swiglu(_rms(x, ffn2_norm[l]), ffn2_w_gate[l], ffn2_w_up[l], ffn2_w_down[l])
        x = _rms(x, final_norm[l])
    return x
```

```cpp
#include <hip/hip_runtime.h>
#include <cstdio>
#include <cstdint>

#ifndef MK_N_LAUNCHES
#define MK_N_LAUNCHES 1
#endif

#define LAS __attribute__((address_space(3)))
#define GAS __attribute__((address_space(1)))
typedef unsigned short bf16_t;
typedef short bf16x8 __attribute__((ext_vector_type(8)));
typedef short s16x4 __attribute__((ext_vector_type(4)));
typedef float f32x4 __attribute__((ext_vector_type(4)));
typedef float f32x2 __attribute__((ext_vector_type(2)));
typedef unsigned u32x4 __attribute__((ext_vector_type(4)));
typedef unsigned u32x2 __attribute__((ext_vector_type(2)));

constexpr int D = 1024, NB = 8, SEQ = 2048, T = NB * SEQ, DFF = 2816, MEML = 256, TM = NB * MEML;
constexpr int DIN = 13312;
constexpr float EPS = 1e-6f;
constexpr float LOG2E = 1.4426950408889634f;

constexpr size_t MiB = 1u << 20;
constexpr size_t HALFMiB = 1u << 19;
constexpr size_t WS_WIN = 0;
constexpr size_t WS_W2GU = 26 * MiB;
constexpr size_t WS_W2D = 37 * MiB;
constexpr size_t WS_WDO = 42 * MiB + HALFMiB;
constexpr size_t WS_WMO = 44 * MiB + HALFMiB;
constexpr size_t WS_WOUT = 46 * MiB + HALFMiB;
constexpr size_t WS_WRO = 48 * MiB + HALFMiB;
constexpr size_t WS_WMKV = 52 * MiB + HALFMiB;
constexpr size_t WS_XB = 56 * MiB + HALFMiB;
constexpr size_t WS_W1GU = 88 * MiB + HALFMiB;
constexpr size_t WS_W1D = 99 * MiB + HALFMiB;
constexpr size_t WS_ACT = 105 * MiB;
constexpr size_t WS_MEMN = 236 * MiB;
constexpr size_t WS_MK = 240 * MiB;
constexpr size_t WS_MV = 244 * MiB;
constexpr size_t WS_DQ = 88 * MiB + HALFMiB;
constexpr size_t WS_DK = 120 * MiB + HALFMiB;
constexpr size_t WS_DV = 152 * MiB + HALFMiB;
constexpr size_t WS_MQ = 184 * MiB + HALFMiB;
constexpr size_t WS_SG = WS_DK;
constexpr size_t WS_M = WS_DV;
constexpr size_t WS_RQ = 88 * MiB + HALFMiB;
constexpr size_t WS_RK = 104 * MiB + HALFMiB;
constexpr size_t WS_RV = 120 * MiB + HALFMiB;
constexpr size_t WS_RG0 = 184 * MiB + HALFMiB;
constexpr size_t WS_RG1 = 216 * MiB + HALFMiB;
constexpr size_t WS_SG2 = 88 * MiB + HALFMiB;
constexpr size_t WS_ST = 0;
constexpr size_t WS_SGB = 216 * MiB + HALFMiB;
constexpr size_t WS_PART = 250 * MiB;
constexpr size_t WS_DROPE = 254 * MiB;
constexpr size_t WS_CTL = 255 * MiB;
constexpr size_t CTL_ZERO_BYTES = 64 * 1024;
constexpr size_t WS_RINV = 255 * MiB + 768 * 1024;
constexpr size_t WS_RSS = 255 * MiB + 128 * 1024;
constexpr size_t WS_END = 256 * MiB;

constexpr int RING_BYTES = 131072;
constexpr int ATT_BYTES = 157696;
constexpr int EPI_OFF = 131072;
constexpr int MISC_OFF = ATT_BYTES;
constexpr int LDS_BYTES = ATT_BYTES + 512;

#define RLX_AGENT __ATOMIC_RELAXED, __HIP_MEMORY_SCOPE_AGENT
typedef __bf16 bf16x2_t __attribute__((ext_vector_type(2)));
__device__ __forceinline__ unsigned cvt_pk_bf16(float lo, float hi) { f32x2 v = {lo, hi}; bf16x2_t b = __builtin_convertvector(v, bf16x2_t); return __builtin_bit_cast(unsigned, b); }
__device__ __forceinline__ float bf2f(unsigned short b) { return __uint_as_float((unsigned)b << 16); }
__device__ __forceinline__ float bflo(unsigned w) { return __uint_as_float(w << 16); }
__device__ __forceinline__ float bfhi(unsigned w) { return __uint_as_float(w & 0xffff0000u); }
__device__ __forceinline__ unsigned short f2bf(float f) { return (unsigned short)(cvt_pk_bf16(f, 0.f) & 0xffffu); }
__device__ __forceinline__ int lane_id() { int r; asm volatile("v_mbcnt_lo_u32_b32 %0, -1, 0\n\tv_mbcnt_hi_u32_b32 %0, -1, %0" : "=v"(r)); return r; }
#define TID_OF(wv) ((wv) * 64 + lane_id())

template <int K> __device__ __forceinline__ float xor_f(float v) {
    if (K == 32) { auto r = __builtin_amdgcn_permlane32_swap(__float_as_uint(v), __float_as_uint(v), false, false); return (lane_id() & 32) ? __uint_as_float(r[0]) : __uint_as_float(r[1]); }
    return __int_as_float(__builtin_amdgcn_ds_swizzle(__float_as_int(v), 0x1F | (K << 10)));
}
__device__ __forceinline__ float sum_xor32(float v) { auto r = __builtin_amdgcn_permlane32_swap(__float_as_uint(v), __float_as_uint(v), false, false); return __uint_as_float(r[0]) + __uint_as_float(r[1]); }
template <int CTRL> __device__ __forceinline__ float dppf(float v) { return __int_as_float(__builtin_amdgcn_update_dpp(0, __float_as_int(v), CTRL, 0xF, 0xF, true)); }
__device__ __forceinline__ float row32_sum(float v) {
    v += dppf<0xB1>(v); v += dppf<0x4E>(v); v += dppf<0x141>(v); v += dppf<0x140>(v);
    auto r = __builtin_amdgcn_permlane16_swap(__float_as_uint(v), __float_as_uint(v), false, false);
    return __uint_as_float(r[0]) + __uint_as_float(r[1]);
}
__device__ __forceinline__ float wave_sum(float v) {
    v += xor_f<1>(v); v += xor_f<2>(v); v += xor_f<4>(v); v += xor_f<8>(v); v += xor_f<16>(v);
    return sum_xor32(v);
}
__device__ __forceinline__ float wave_max(float v) {
    v = fmaxf(v, xor_f<1>(v)); v = fmaxf(v, xor_f<2>(v)); v = fmaxf(v, xor_f<4>(v)); v = fmaxf(v, xor_f<8>(v)); v = fmaxf(v, xor_f<16>(v));
    auto r = __builtin_amdgcn_permlane32_swap(__float_as_uint(v), __float_as_uint(v), false, false); return fmaxf(__uint_as_float(r[0]), __uint_as_float(r[1]));
}
__device__ __forceinline__ float uni(float v) { return __uint_as_float(__builtin_amdgcn_readfirstlane(__float_as_uint(v))); }

#define XB_TMO      128
#define XB_XCNT(j)  (256  + 64 * (j))
#define XB_XSUB(j)  (1280 + 64 * (j))
#define XB_XGEN(j)  (2304 + 64 * (j))
#define XB_TOP      3328
#define XB_TOPGEN   3392
#define XCD_BAR_WORDS 3456
#define XB_SPIN_CAP (1u << 22)
__device__ __forceinline__ unsigned xb_ld(unsigned* p)              { return __hip_atomic_load(p, __ATOMIC_RELAXED, __HIP_MEMORY_SCOPE_AGENT); }
__device__ __forceinline__ unsigned xb_add(unsigned* p, unsigned v) { return __hip_atomic_fetch_add(p, v, __ATOMIC_RELAXED, __HIP_MEMORY_SCOPE_AGENT); }
__device__ __forceinline__ unsigned xb_xcc_id() { return (unsigned)__builtin_amdgcn_s_getreg((3 << 11) | 20) & 0xFu; }
#define XB_SPIN(cond, bar) do { unsigned _sp = 0; while (cond) { __builtin_amdgcn_s_sleep(1); \
    if ((++_sp & 255u) == 0u) { if (xb_ld(&(bar)[XB_TMO])) break; if (_sp > XB_SPIN_CAP) { atomicAdd(&(bar)[XB_TMO], 1u); break; } } } } while (0)
struct XcdBarrier { unsigned* bar; unsigned x; volatile LAS unsigned* st; };
__device__ __forceinline__ XcdBarrier xcd_barrier_post(unsigned* bar, volatile LAS unsigned* st, bool t0) {
    XcdBarrier b; b.bar = bar; b.x = xb_xcc_id(); b.st = st;
    if (t0) (void)xb_add(&bar[XB_XCNT(b.x)], 1u);
    return b;
}
__device__ __forceinline__ void xcd_barrier_complete(unsigned* bar, unsigned x, unsigned& nloc, unsigned& nx) {
    const unsigned G = gridDim.x * gridDim.y * gridDim.z;
    unsigned sum, cnt, mine, sp = 0u;
    for (;;) {
        sum = 0u; cnt = 0u; mine = 0u;
#pragma unroll
        for (unsigned j = 0; j < 16; ++j) { const unsigned c = xb_ld(&bar[XB_XCNT(j)]); sum += c; cnt += (c > 0u) ? 1u : 0u; mine = (j == x) ? c : mine; }
        if (sum == G) break;
        __builtin_amdgcn_s_sleep(1);
        if ((++sp & 255u) == 0u) { if (xb_ld(&bar[XB_TMO])) break; if (sp > XB_SPIN_CAP) { atomicAdd(&bar[XB_TMO], 1u); break; } }
    }
    nloc = mine > 0u ? mine : 1u; nx = cnt > 0u ? cnt : 1u;
}
__device__ __forceinline__ void xcd_barrier(const XcdBarrier& b, bool t0) {
    asm volatile("s_waitcnt vmcnt(0)" ::: "memory");
    __syncthreads();
    if (t0) {
        unsigned* bar = b.bar;
        __builtin_amdgcn_s_waitcnt(0);
        unsigned nloc = b.st[0], nx = b.st[1];
        if (nloc == 0u) { xcd_barrier_complete(bar, b.x, nloc, nx); b.st[0] = nloc; b.st[1] = nx; }
        const unsigned old = xb_add(&bar[XB_XSUB(b.x)], 1u);
        const unsigned gen = old / nloc;
        if (old + 1u == (gen + 1u) * nloc) {
            __builtin_amdgcn_fence(__ATOMIC_RELEASE, "agent");
            asm volatile("s_waitcnt vmcnt(0)" ::: "memory");
            const unsigned og = xb_add(&bar[XB_TOP], 1u);
            const unsigned tg = og / nx;
            if (og + 1u == (tg + 1u) * nx) xb_add(&bar[XB_TOPGEN], 1u);
            else XB_SPIN(xb_ld(&bar[XB_TOPGEN]) == tg, bar);
            __builtin_amdgcn_fence(__ATOMIC_ACQUIRE, "agent");
            xb_add(&bar[XB_XGEN(b.x)], 1u);
            asm volatile("s_waitcnt vmcnt(0)" ::: "memory");
        } else {
            XB_SPIN(xb_ld(&bar[XB_XGEN(b.x)]) == gen, bar);
            __builtin_amdgcn_fence(__ATOMIC_ACQUIRE, "agent");
            asm volatile("s_waitcnt vmcnt(0)" ::: "memory");
        }
    }
    __syncthreads();
}

struct InTab { const float* p[30]; };
struct CtxIn {
    const __attribute__((address_space(4))) InTab* tab;
    __device__ __forceinline__ const float* operator[](int i) const { typedef const float* cfp; return *(volatile const __attribute__((address_space(4))) cfp*)&tab->p[i]; }
};
struct Ctx {
    CtxIn in;
    float* out;
    unsigned char* ws;
};
#define CX_F(i) (cx.in[i])
#define WSP(T_, off) ((T_*)(cx.ws + (off)))

namespace pg8 {
constexpr int BM = 256, BK = 64, HALF = 128, HTB = HALF * BK * 2, STAGE_BYTES = 8 * HTB, NXCD = 8, WGM = 8;
__device__ __forceinline__ int lds_byte(int r, int c) { const int st = (r >> 4) * 2 + (c >> 5), rr = r & 15, cc = c & 31, ob = rr * 64 + cc * 2; return st * 1024 + (ob ^ (((ob >> 9) & 1) << 5)); }
__device__ __forceinline__ void stage_rc(int b, int& R, int& C) { const int st = b / 1024, sb = b % 1024, swz = sb ^ (((sb >> 9) & 1) << 5); R = (st >> 1) * 16 + swz / 64; C = (st & 1) * 32 + (swz % 64) / 2; }
__device__ __forceinline__ int perm32(int rho) { const int n = rho >> 4, i = rho & 15; return 8 * (i >> 2) + 4 * n + (i & 3); }
__device__ __forceinline__ void tile_of(int L, int nM, int nN, int& pm, int& pn) {
    const int nwg = nM * nN; int wgid = L;
    { const int q = nwg / NXCD, r = nwg % NXCD, xcd = wgid % NXCD, off = wgid / NXCD; wgid = (xcd < r ? xcd * (q + 1) : r * (q + 1) + (xcd - r) * q) + off; }
    const int nig = WGM * nN, gid = wgid / nig, fm = gid * WGM, gsz = (nM - fm) < WGM ? (nM - fm) : WGM;
    pm = fm + ((wgid % nig) % gsz); pn = (wgid % nig) / gsz;
}
}

enum { EP_GU = 0, EP_MK, EP_MV, EP_RES, EP_DQK, EP_PLAIN, EP_MQ, EP_ROT, EP_SG, EP_PM, EP_RSC };
struct Unit { const bf16_t* A; const bf16_t* Bt; int K, lda; int pm, pn; int epi, aux, po; int kjt; long kjump; int rs; };

enum { PH_PRO = 0, PH_F1GU, PH_F1D, PH_IN_DM, PH_ATT_DM, PH_MG1, PH_IN_R0, PH_ST0, PH_ATT_R0, PH_IN_R1, PH_ST1, PH_ATT_R1,
       PH_MG2, PH_WOUT, PH_F2GU, PH_F2D, PH_FIN, PH_COUNT };

struct GemmSched {
    int ph, c, G;
    const Ctx* cxp;
    __device__ __forceinline__ bool next(int i, Unit& u) const { u.lda = 0; const bool ok = next_(i, u); if (u.lda == 0) u.lda = u.K; return ok; }
    __device__ __forceinline__ bool next_(int i, Unit& u) const {
        const Ctx& cx = *cxp;
        const int L = i * G + c;
        u.kjt = 1 << 30; u.kjump = 0; u.rs = 0;
        switch (ph) {
        case PH_F1GU: case PH_F2GU: {
            const int f2 = (ph == PH_F2GU);
            if (L < 64 * 22) { pg8::tile_of(L, 64, 22, u.pm, u.pn); u.A = WSP(bf16_t, WS_XB); u.Bt = WSP(bf16_t, f2 ? WS_W2GU : WS_W1GU); u.K = 1024; u.epi = EP_GU; u.aux = f2; u.po = u.pn; return true; }
            if (f2) return false;
            const int j = L - 64 * 22; if (j >= 64) return false;
            pg8::tile_of(j, 8, 8, u.pm, u.pn); u.A = WSP(bf16_t, WS_MEMN); u.Bt = WSP(bf16_t, WS_WMKV); u.K = 1024;
            if (u.pn < 4) { u.epi = EP_MK; u.po = u.pn; } else { u.epi = EP_MV; u.po = u.pn - 4; }
            u.aux = 0; return true; }
        case PH_F1D: case PH_F2D: {
            if (L >= 256) return false; pg8::tile_of(L, 64, 4, u.pm, u.pn);
            u.A = WSP(bf16_t, WS_ACT); u.Bt = WSP(bf16_t, ph == PH_F1D ? WS_W1D : WS_W2D); u.K = DFF; u.epi = EP_RES; u.aux = (ph == PH_F1D) ? 0 : 2; u.po = u.pn; return true; }
        case PH_IN_DM: {
            if (L >= 64 * 16) return false; pg8::tile_of(L, 64, 16, u.pm, u.pn);
            u.A = WSP(bf16_t, WS_XB); u.Bt = WSP(bf16_t, WS_WIN); u.K = 1024;
            const int s = u.pn >> 2; u.po = u.pn & 3;
            if (s == 0) { u.epi = EP_DQK; u.aux = 0; } else if (s == 1) { u.epi = EP_DQK; u.aux = 1; } else if (s == 2) { u.epi = EP_PLAIN; u.aux = 0; } else { u.epi = EP_MQ; u.aux = 0; }
            return true; }
        case PH_MG1: {
            const int kind = i & 3, tl = c + G * (i >> 2); if (tl >= 256) return false; pg8::tile_of(tl, 64, 4, u.pm, u.pn); u.K = 1024; u.po = u.pn;
            if (kind == 0) { u.A = WSP(bf16_t, WS_XB); u.Bt = WSP(bf16_t, WS_WIN); u.pn += 16; u.epi = EP_SG; u.aux = 1; }
            else if (kind == 1) { u.A = WSP(bf16_t, WS_DQ); u.Bt = WSP(bf16_t, WS_WDO); u.epi = EP_PM; u.aux = 0; }
            else if (kind == 2) { u.A = WSP(bf16_t, WS_XB); u.Bt = WSP(bf16_t, WS_WIN); u.pn += 20; u.epi = EP_SG; u.aux = 2; }
            else { u.A = WSP(bf16_t, WS_MQ); u.Bt = WSP(bf16_t, WS_WMO); u.epi = EP_PM; u.aux = 1 | 4; }
            return true; }
        case PH_MG2: {
            const int kind = i % 5, tl = c + G * (i / 5); if (tl >= 256) return false; pg8::tile_of(tl, 64, 4, u.pm, u.pn); u.po = u.pn;
            if (kind == 0) { u.A = WSP(bf16_t, WS_XB); u.Bt = WSP(bf16_t, WS_WIN); u.K = 1024; u.pn += 48; u.epi = EP_SG; u.aux = 0; }
            else { const int h = kind - 1; u.A = WSP(bf16_t, (h < 2) ? WS_RG0 : WS_RG1) + (h & 1) * 512; u.lda = 1024; u.Bt = WSP(bf16_t, WS_WRO) + (size_t)h * 1024 * 512; u.K = 512;
                   if (h < 3) { u.epi = EP_RSC; u.aux = h + 1; } else { u.epi = EP_PM; u.aux = 1 | 2; u.rs = 1; } }
            return true; }
        case PH_IN_R0: case PH_IN_R1: {
            if (L >= 64 * 12) return false; pg8::tile_of(L, 64, 12, u.pm, u.pn);
            const int hg = (ph == PH_IN_R1); const int t = u.pn;
            u.A = WSP(bf16_t, WS_XB); u.Bt = WSP(bf16_t, WS_WIN); u.K = 1024; u.pn = 24 + 12 * hg + t;
            if (t < 2) { u.epi = EP_ROT; u.aux = 0; u.po = t; } else if (t < 4) { u.epi = EP_ROT; u.aux = 1; u.po = t - 2; }
            else if (t < 8) { u.epi = EP_PLAIN; u.aux = 1; u.po = t - 4; } else { u.epi = EP_PLAIN; u.aux = 2 + hg; u.po = t - 8; }
            return true; }
        case PH_WOUT: {
            if (L >= 256) return false; pg8::tile_of(L, 64, 4, u.pm, u.pn);
            u.A = WSP(bf16_t, WS_M); u.Bt = WSP(bf16_t, WS_WOUT); u.K = 1024; u.epi = EP_RES; u.aux = 1; u.po = u.pn; return true; }
        default: return false;
        }
    }
};

__device__ __forceinline__ float row_rinv(const float* part, int row) {
    const f32x4* p = (const f32x4*)(part + (size_t)row * 16);
    const f32x4 a = p[0], b = p[1], c = p[2], d = p[3];
    const float s = ((a[0] + a[1]) + (a[2] + a[3])) + ((b[0] + b[1]) + (b[2] + b[3])) + ((c[0] + c[1]) + (c[2] + c[3])) + ((d[0] + d[1]) + (d[2] + d[3]));
    return __builtin_amdgcn_rsqf(s * (1.0f / 1024.0f) + EPS);
}
__device__ __forceinline__ float fsigmoid(float v) { return __builtin_amdgcn_rcpf(1.0f + __builtin_amdgcn_exp2f(v * (-LOG2E))); }
__device__ __forceinline__ f32x4 exp2_4(f32x4 v) { return (f32x4){__builtin_amdgcn_exp2f(v[0]), __builtin_amdgcn_exp2f(v[1]), __builtin_amdgcn_exp2f(v[2]), __builtin_amdgcn_exp2f(v[3])}; }
__device__ __forceinline__ f32x4 rcp_4(f32x4 v) { return (f32x4){__builtin_amdgcn_rcpf(v[0]), __builtin_amdgcn_rcpf(v[1]), __builtin_amdgcn_rcpf(v[2]), __builtin_amdgcn_rcpf(v[3])}; }
__device__ __forceinline__ float ret_rms2(const float* ss, int row, int h);
__device__ __forceinline__ void rescale_rows(const Ctx& cx, f32x4 (&acc)[2][2][4][2], int rowb, int hn);

__device__ __forceinline__ void epilogue(const Ctx& cx, const Unit& u, f32x4 (&acc)[2][2][4][2], int wr, int wc, int fr, int fq, LAS unsigned char* lds) {
    const int rowb = u.pm * 256 + wr * 64 + fr;
    const int colw = wc * 32 + 8 * fq;
    float* PART = WSP(float, WS_PART);
#ifdef EPI_ONLY
    if (u.epi != EPI_ONLY) return;
#endif
    LAS float* rl = (LAS float*)(lds + EPI_OFF + 8192);
    LAS float* pl = (LAS float*)(lds + EPI_OFF + 9216);
    LAS unsigned char* ropl = lds + EPI_OFF + 10240;
    {
        const float* rp = nullptr;
        if (u.epi == EP_GU) rp = PART + (size_t)(u.aux ? 2 : 0) * T * 16;
        else if (u.epi == EP_PLAIN || u.epi == EP_DQK || u.epi == EP_MQ || u.epi == EP_ROT || u.epi == EP_SG) rp = PART + (size_t)1 * T * 16;
        if (rp) {
            const int lt = (wr * 4 + wc) * 64 + fq * 16 + fr, r = lt >> 1, hf = lt & 1;
            const f32x4* p = (const f32x4*)(rp + (size_t)(u.pm * 256 + r) * 16 + hf * 8);
            const f32x4 a = p[0], b = p[1];
            f32x4 c0 = (f32x4){0.f, 0.f, 0.f, 0.f}, c1 = c0; float pf = 0.f;
            if (u.epi == EP_DQK) { const f32x4* q = (const f32x4*)(WSP(float, WS_DROPE) + (size_t)(u.pm * 256 + r) * 16 + hf * 8); c0 = q[0]; c1 = q[1]; }
            if (u.epi == EP_ROT) pf = (float)((const int*)cx.in[2])[u.pm * 256 + (lt & 255)];
            float s = ((a[0] + a[1]) + (a[2] + a[3])) + ((b[0] + b[1]) + (b[2] + b[3]));
            s += dppf<0xB1>(s);
            if (hf == 0) rl[r] = __builtin_amdgcn_rsqf(s * (1.0f / 1024.0f) + EPS);
            if (u.epi == EP_DQK) { *(LAS f32x4*)(ropl + r * 64 + hf * 32) = c0; *(LAS f32x4*)(ropl + r * 64 + hf * 32 + 16) = c1; }
            if (u.epi == EP_ROT && lt < 256) pl[lt] = pf;
            asm volatile("s_waitcnt vmcnt(0) lgkmcnt(0)" ::: "memory"); __builtin_amdgcn_s_barrier(); asm volatile("" ::: "memory");
        }
    }
    const int lrb = wr * 64 + fr;
    switch (u.epi) {
    case EP_GU: {
        bf16_t* O = WSP(bf16_t, WS_ACT);
#pragma unroll
        for (int ai = 0; ai < 2; ++ai)
#pragma unroll
            for (int m = 0; m < 4; ++m) {
                const int row = rowb + ai * 128 + m * 16; const float ri = rl[lrb + ai * 128 + m * 16];
                const float k1 = -ri * LOG2E, ri2 = ri * ri; f32x4 ov[2];
#pragma unroll
                for (int n = 0; n < 2; ++n) { const f32x4 gq = acc[ai][0][m][n], uq = acc[ai][1][m][n];
                    const f32x4 den = exp2_4(gq * k1) + 1.0f; ov[n] = (gq * uq) * (rcp_4(den) * ri2); }
                u32x4 w; w.x = cvt_pk_bf16(ov[0][0], ov[0][1]); w.y = cvt_pk_bf16(ov[0][2], ov[0][3]); w.z = cvt_pk_bf16(ov[1][0], ov[1][1]); w.w = cvt_pk_bf16(ov[1][2], ov[1][3]);
                *(u32x4*)(O + (size_t)row * DFF + u.po * 128 + colw) = w;
            }
    } break;
    case EP_MV: case EP_PLAIN: {
        bf16_t* O; int ld; const bool part = (u.epi != EP_MV);
        if (u.epi == EP_MV) { O = WSP(bf16_t, WS_MV); ld = 1024; }
        else { ld = 1024; O = WSP(bf16_t, u.aux == 0 ? WS_DV : u.aux == 1 ? WS_RV : u.aux == 2 ? WS_RG0 : WS_RG1); }
#pragma unroll
        for (int ai = 0; ai < 2; ++ai)
#pragma unroll
            for (int m = 0; m < 4; ++m) {
                const int row = rowb + ai * 128 + m * 16; const float ri = part ? rl[lrb + ai * 128 + m * 16] : 1.0f;
#pragma unroll
                for (int bj = 0; bj < 2; ++bj) { const f32x4 v0 = acc[ai][bj][m][0] * ri, v1 = acc[ai][bj][m][1] * ri;
                    u32x4 w; w.x = cvt_pk_bf16(v0[0], v0[1]); w.y = cvt_pk_bf16(v0[2], v0[3]); w.z = cvt_pk_bf16(v1[0], v1[1]); w.w = cvt_pk_bf16(v1[2], v1[3]);
                    *(u32x4*)(O + (size_t)row * ld + u.po * 256 + bj * 128 + colw) = w; }
            }
    } break;
    case EP_RES: if (u.aux == 2) {
        float* part = PART + (size_t)3 * T * 16; unsigned* cnt = WSP(unsigned, WS_CTL) + 8192 + 64 * u.pm; const float* wn = cx.in[29]; const bf16_t* XB = WSP(bf16_t, WS_XB);
        LAS unsigned* flag = (LAS unsigned*)(lds + EPI_OFF);
#pragma unroll
        for (int ai = 0; ai < 2; ++ai) {
            u32x4 xv[4][2];
#pragma unroll
            for (int m = 0; m < 4; ++m)
#pragma unroll
                for (int bj = 0; bj < 2; ++bj) xv[m][bj] = *(const u32x4*)(XB + (size_t)(rowb + ai * 128 + m * 16) * D + u.po * 256 + bj * 128 + colw);
#pragma unroll
            for (int m = 0; m < 4; ++m) {
                const int row = rowb + ai * 128 + m * 16; float ss = 0.f;
#pragma unroll
                for (int bj = 0; bj < 2; ++bj) { const u32x4 xq = xv[m][bj];
                    const f32x4 x0 = (f32x4){bflo(xq.x), bfhi(xq.x), bflo(xq.y), bfhi(xq.y)}, x1 = (f32x4){bflo(xq.z), bfhi(xq.z), bflo(xq.w), bfhi(xq.w)};
                    const f32x4 y0 = x0 + acc[ai][bj][m][0] * 0.5f, y1 = x1 + acc[ai][bj][m][1] * 0.5f;
                    ss += (y0[0] * y0[0] + y0[1] * y0[1]) + (y0[2] * y0[2] + y0[3] * y0[3]) + (y1[0] * y1[0] + y1[1] * y1[1]) + (y1[2] * y1[2] + y1[3] * y1[3]); }
                ss += xor_f<16>(ss); ss = sum_xor32(ss);
                if (fq == 0) __hip_atomic_store(part + (size_t)row * 16 + u.po * 4 + wc, ss, __ATOMIC_RELAXED, __HIP_MEMORY_SCOPE_AGENT);
            }
        }
        asm volatile("s_waitcnt vmcnt(0)" ::: "memory");
        if (fr == 0 && fq == 0) __hip_atomic_fetch_add(cnt, 1u, __ATOMIC_RELAXED, __HIP_MEMORY_SCOPE_AGENT);
        if (wr == 0 && wc == 0) {
            unsigned sp = 0;
            while ((unsigned)__builtin_amdgcn_readfirstlane(__hip_atomic_load(cnt, __ATOMIC_RELAXED, __HIP_MEMORY_SCOPE_AGENT)) < 32u) { __builtin_amdgcn_s_sleep(2); if (++sp > (1u << 22)) break; }
            __builtin_amdgcn_fence(__ATOMIC_ACQUIRE, "agent");
            asm volatile("s_waitcnt vmcnt(0)" ::: "memory");
            if (fr == 0 && fq == 0) flag[0] = 1u;
        }
        asm volatile("s_waitcnt vmcnt(0) lgkmcnt(0)" ::: "memory"); __builtin_amdgcn_s_barrier(); asm volatile("" ::: "memory");
        int rowb2 = rowb, colw2 = colw; asm volatile("" : "+v"(rowb2), "+v"(colw2));
#pragma unroll
        for (int q4 = 0; q4 < 4; ++q4) {
            const int ai = q4 >> 1, m0 = (q4 & 1) * 2;
            u32x4 xv[2][2]; float ri[2];
#pragma unroll
            for (int mm = 0; mm < 2; ++mm) { const int row = rowb2 + ai * 128 + (m0 + mm) * 16; ri[mm] = row_rinv(part, row);
#pragma unroll
                for (int bj = 0; bj < 2; ++bj) xv[mm][bj] = *(const u32x4*)(XB + (size_t)row * D + u.po * 256 + bj * 128 + colw2); }
            __builtin_amdgcn_sched_barrier(0);
#pragma unroll
            for (int mm = 0; mm < 2; ++mm) { const int row = rowb2 + ai * 128 + (m0 + mm) * 16;
#pragma unroll
                for (int bj = 0; bj < 2; ++bj) { const size_t off = (size_t)row * D + u.po * 256 + bj * 128 + colw2; const u32x4 xq = xv[mm][bj];
                    const f32x4 x0 = (f32x4){bflo(xq.x), bfhi(xq.x), bflo(xq.y), bfhi(xq.y)}, x1 = (f32x4){bflo(xq.z), bfhi(xq.z), bflo(xq.w), bfhi(xq.w)};
                    const f32x4 w0 = *(const f32x4*)(wn + u.po * 256 + bj * 128 + colw2), w1 = *(const f32x4*)(wn + u.po * 256 + bj * 128 + colw2 + 4);
                    *(f32x4*)(cx.out + off) = (x0 + acc[ai][bj][m0 + mm][0] * 0.5f) * ri[mm] * w0; *(f32x4*)(cx.out + off + 4) = (x1 + acc[ai][bj][m0 + mm][1] * 0.5f) * ri[mm] * w1; } }
            __builtin_amdgcn_sched_barrier(0);
        }
    } else {
        float* part = PART + (size_t)(u.aux + 1) * T * 16; bf16_t* XB = WSP(bf16_t, WS_XB);
#pragma unroll
        for (int ai = 0; ai < 2; ++ai) {
            f32x4 xv[4][2][2];
            if (u.aux == 0) {
#pragma unroll
                for (int m = 0; m < 4; ++m)
#pragma unroll
                    for (int bj = 0; bj < 2; ++bj) { const size_t off = (size_t)(rowb + ai * 128 + m * 16) * D + u.po * 256 + bj * 128 + colw;
                        xv[m][bj][0] = *(const f32x4*)(cx.in[0] + off) ; xv[m][bj][1] = *(const f32x4*)(cx.in[0] + off + 4); }
            } else {
                u32x4 xb[4][2];
#pragma unroll
                for (int m = 0; m < 4; ++m)
#pragma unroll
                    for (int bj = 0; bj < 2; ++bj) xb[m][bj] = *(const u32x4*)(XB + (size_t)(rowb + ai * 128 + m * 16) * D + u.po * 256 + bj * 128 + colw);
#pragma unroll
                for (int m = 0; m < 4; ++m)
#pragma unroll
                    for (int bj = 0; bj < 2; ++bj) { const u32x4 xq = xb[m][bj];
                        xv[m][bj][0] = (f32x4){bflo(xq.x), bfhi(xq.x), bflo(xq.y), bfhi(xq.y)}; xv[m][bj][1] = (f32x4){bflo(xq.z), bfhi(xq.z), bflo(xq.w), bfhi(xq.w)}; }
            }
            __builtin_amdgcn_sched_barrier(0);
            const float sc = (u.aux == 1) ? 1.0f : 0.5f;
#pragma unroll
            for (int m = 0; m < 4; ++m) {
                const int row = rowb + ai * 128 + m * 16; float ss = 0.f;
#pragma unroll
                for (int bj = 0; bj < 2; ++bj) { const size_t off = (size_t)row * D + u.po * 256 + bj * 128 + colw;
                    const f32x4 y0 = xv[m][bj][0] + acc[ai][bj][m][0] * sc, y1 = xv[m][bj][1] + acc[ai][bj][m][1] * sc;
                    ss += (y0[0] * y0[0] + y0[1] * y0[1]) + (y0[2] * y0[2] + y0[3] * y0[3]) + (y1[0] * y1[0] + y1[1] * y1[1]) + (y1[2] * y1[2] + y1[3] * y1[3]);
                    u32x4 w; w.x = cvt_pk_bf16(y0[0], y0[1]); w.y = cvt_pk_bf16(y0[2], y0[3]); w.z = cvt_pk_bf16(y1[0], y1[1]); w.w = cvt_pk_bf16(y1[2], y1[3]);
                    *(u32x4*)(XB + off) = w; }
                ss += xor_f<16>(ss); ss = sum_xor32(ss);
                if (fq == 0) part[(size_t)row * 16 + u.po * 4 + wc] = ss;
            }
            __builtin_amdgcn_sched_barrier(0);
        }
    } break;
    case EP_DQK: {
        const float* wn = cx.in[u.aux ? 12 : 11];
        bf16_t* O = WSP(bf16_t, u.aux ? WS_DK : WS_DQ);
        f32x4 wv[2][2];
#pragma unroll
        for (int bj = 0; bj < 2; ++bj)
#pragma unroll
            for (int n = 0; n < 2; ++n) wv[bj][n] = *(const f32x4*)(wn + 16 * fq + 8 * bj + 4 * n);
#pragma unroll
        for (int ai = 0; ai < 2; ++ai)
#pragma unroll
            for (int m = 0; m < 4; ++m) {
                const int row = rowb + ai * 128 + m * 16; const float ri = rl[lrb + ai * 128 + m * 16];
                f32x4 v[2][2]; float ss = 0.f;
#pragma unroll
                for (int bj = 0; bj < 2; ++bj)
#pragma unroll
                    for (int n = 0; n < 2; ++n) { v[bj][n] = acc[ai][bj][m][n] * ri; ss += (v[bj][n][0] * v[bj][n][0] + v[bj][n][1] * v[bj][n][1]) + (v[bj][n][2] * v[bj][n][2] + v[bj][n][3] * v[bj][n][3]); }
                ss += xor_f<16>(ss); ss = sum_xor32(ss);
                const float r2 = __builtin_amdgcn_rsqf(ss * (1.0f / 64.0f) + EPS);
#pragma unroll
                for (int bj = 0; bj < 2; ++bj)
#pragma unroll
                    for (int n = 0; n < 2; ++n) v[bj][n] = v[bj][n] * r2 * wv[bj][n];
                if (fq == 0) {
                    const LAS f32x4* rp = (const LAS f32x4*)(ropl + (lrb + ai * 128 + m * 16) * 64);
#pragma unroll
                    for (int n = 0; n < 2; ++n) { const f32x4 cs0 = rp[2 * n], cs1 = rp[2 * n + 1];
                        const float c_[4] = {cs0[0], cs0[2], cs1[0], cs1[2]}, s_[4] = {cs0[1], cs0[3], cs1[1], cs1[3]};
#pragma unroll
                        for (int e = 0; e < 4; ++e) { const float x1 = v[0][n][e], x2 = v[1][n][e]; v[0][n][e] = x1 * c_[e] - x2 * s_[e]; v[1][n][e] = x2 * c_[e] + x1 * s_[e]; } }
                }
#pragma unroll
                for (int bj = 0; bj < 2; ++bj) { u32x4 w; w.x = cvt_pk_bf16(v[bj][0][0], v[bj][0][1]); w.y = cvt_pk_bf16(v[bj][0][2], v[bj][0][3]); w.z = cvt_pk_bf16(v[bj][1][0], v[bj][1][1]); w.w = cvt_pk_bf16(v[bj][1][2], v[bj][1][3]);
                    *(u32x4*)(O + (size_t)row * 1024 + u.po * 256 + wc * 64 + bj * 32 + 8 * fq) = w; }
            }
    } break;
    case EP_MQ: case EP_MK: {
        const bool part = (u.epi == EP_MQ); const float* wn = cx.in[u.epi == EP_MQ ? 21 : 22];
        bf16_t* O = WSP(bf16_t, u.epi == EP_MQ ? WS_MQ : WS_MK);
        LAS float* red = (LAS float*)(lds + EPI_OFF);
        float ri[2][4];
#pragma unroll
        for (int ai = 0; ai < 2; ++ai)
#pragma unroll
            for (int m = 0; m < 4; ++m) {
                ri[ai][m] = part ? rl[lrb + ai * 128 + m * 16] : 1.0f; float ss = 0.f;
#pragma unroll
                for (int bj = 0; bj < 2; ++bj)
#pragma unroll
                    for (int n = 0; n < 2; ++n) { const f32x4 v = acc[ai][bj][m][n] * ri[ai][m]; ss += (v[0] * v[0] + v[1] * v[1]) + (v[2] * v[2] + v[3] * v[3]); }
                ss += xor_f<16>(ss); ss = sum_xor32(ss);
                if (fq == 0) red[(ai * 128 + wr * 64 + m * 16 + fr) * 4 + wc] = ss;
            }
        asm volatile("s_waitcnt lgkmcnt(0)" ::: "memory"); __builtin_amdgcn_s_barrier(); asm volatile("" ::: "memory");
        f32x4 wv[2][2];
#pragma unroll
        for (int bj = 0; bj < 2; ++bj)
#pragma unroll
            for (int n = 0; n < 2; ++n) wv[bj][n] = *(const f32x4*)(wn + bj * 128 + colw + 4 * n);
#pragma unroll
        for (int ai = 0; ai < 2; ++ai)
#pragma unroll
            for (int m = 0; m < 4; ++m) {
                const int row = rowb + ai * 128 + m * 16; const int lr = ai * 128 + wr * 64 + m * 16 + fr;
                const float tot = (red[lr * 4 + 0] + red[lr * 4 + 1]) + (red[lr * 4 + 2] + red[lr * 4 + 3]);
                const float r2 = __builtin_amdgcn_rsqf(tot * (1.0f / 256.0f) + EPS) * ri[ai][m];
#pragma unroll
                for (int bj = 0; bj < 2; ++bj) { const f32x4 v0 = acc[ai][bj][m][0] * r2 * wv[bj][0], v1 = acc[ai][bj][m][1] * r2 * wv[bj][1];
                    u32x4 w; w.x = cvt_pk_bf16(v0[0], v0[1]); w.y = cvt_pk_bf16(v0[2], v0[3]); w.z = cvt_pk_bf16(v1[0], v1[1]); w.w = cvt_pk_bf16(v1[2], v1[3]);
                    *(u32x4*)(O + (size_t)row * 1024 + u.po * 256 + bj * 128 + colw) = w; }
            }
        asm volatile("s_waitcnt lgkmcnt(0)" ::: "memory"); __builtin_amdgcn_s_barrier(); asm volatile("" ::: "memory");
    } break;
    case EP_ROT: {
        const float* rinvf = WSP(float, WS_RINV);
        bf16_t* O = WSP(bf16_t, u.aux ? WS_RK : WS_RQ); const float ksc = u.aux ? 0.0625f : 1.0f;
        f32x4 fr4[2];
#pragma unroll
        for (int bj = 0; bj < 2; ++bj) fr4[bj] = *(const f32x4*)(rinvf + (bj * 128 + colw) / 2);
#pragma unroll
        for (int ai = 0; ai < 2; ++ai)
#pragma unroll
            for (int m = 0; m < 4; ++m) {
                const int row = rowb + ai * 128 + m * 16; const float ri = rl[lrb + ai * 128 + m * 16] * ksc; const float pf = pl[lrb + ai * 128 + m * 16];
#pragma unroll
                for (int bj = 0; bj < 2; ++bj) { float o[8];
#pragma unroll
                    for (int p = 0; p < 4; ++p) { const float ang = pf * fr4[bj][p];
                        const float rh = ang * 0.15915494309189535f; const float rl = __builtin_fmaf(ang, 0.15915494309189535f, -rh) + ang * (-1.2154201256553420e-10f);
                        float fr_ = rh - floorf(rh); fr_ += rl;
                        const float sn = __builtin_amdgcn_sinf(fr_), cs = __builtin_amdgcn_cosf(fr_);
                        const float xe = acc[ai][bj][m][p >> 1][(p & 1) * 2] * ri, xo = acc[ai][bj][m][p >> 1][(p & 1) * 2 + 1] * ri;
                        o[2 * p] = xe * cs - xo * sn; o[2 * p + 1] = xo * cs + xe * sn; }
                    u32x4 w; w.x = cvt_pk_bf16(o[0], o[1]); w.y = cvt_pk_bf16(o[2], o[3]); w.z = cvt_pk_bf16(o[4], o[5]); w.w = cvt_pk_bf16(o[6], o[7]);
                    *(u32x4*)(O + (size_t)row * 512 + u.po * 256 + bj * 128 + colw) = w; }
            }
    } break;
    case EP_SG: {
        const float* bg = cx.in[9] + u.aux * 1024 + u.po * 256;
        bf16_t* O = WSP(bf16_t, u.aux == 0 ? WS_SG2 : u.aux == 1 ? WS_SG : WS_SGB);
        f32x4 bv[2][2];
#pragma unroll
        for (int bj = 0; bj < 2; ++bj)
#pragma unroll
            for (int n = 0; n < 2; ++n) bv[bj][n] = *(const f32x4*)(bg + bj * 128 + colw + 4 * n);
#pragma unroll
        for (int ai = 0; ai < 2; ++ai)
#pragma unroll
            for (int m = 0; m < 4; ++m) {
                const int row = rowb + ai * 128 + m * 16; const float ri = rl[lrb + ai * 128 + m * 16];
#pragma unroll
                for (int bj = 0; bj < 2; ++bj) { f32x4 ov[2];
#pragma unroll
                    for (int n = 0; n < 2; ++n) ov[n] = rcp_4(exp2_4((acc[ai][bj][m][n] * ri + bv[bj][n]) * (-LOG2E)) + 1.0f);
                    u32x4 w; w.x = cvt_pk_bf16(ov[0][0], ov[0][1]); w.y = cvt_pk_bf16(ov[0][2], ov[0][3]); w.z = cvt_pk_bf16(ov[1][0], ov[1][1]); w.w = cvt_pk_bf16(ov[1][2], ov[1][3]);
                    *(u32x4*)(O + (size_t)row * 1024 + u.po * 256 + bj * 128 + colw) = w; }
            }
    } break;
    case EP_PM: {
        const bf16_t* SG = WSP(bf16_t, (u.aux & 2) ? WS_SG2 : (u.aux & 4) ? WS_SGB : WS_SG); bf16_t* Mb = WSP(bf16_t, WS_M); const bool accum = (u.aux & 1);
#pragma unroll
        for (int ai = 0; ai < 2; ++ai) {
            u32x4 gv[4][2], pv[4][2]; float rs[4];
#pragma unroll
            for (int m = 0; m < 4; ++m) { const int row = rowb + ai * 128 + m * 16; rs[m] = u.rs ? rsqrtf(ret_rms2(WSP(float, WS_RSS), row, 3)) : 1.0f;
#pragma unroll
                for (int bj = 0; bj < 2; ++bj) { const size_t off = (size_t)row * 1024 + u.po * 256 + bj * 128 + colw;
                    gv[m][bj] = *(const u32x4*)(SG + off); pv[m][bj] = (u32x4){0u, 0u, 0u, 0u}; if (accum) pv[m][bj] = *(const u32x4*)(Mb + off); } }
            __builtin_amdgcn_sched_barrier(0);
#pragma unroll
            for (int m = 0; m < 4; ++m) { const int row = rowb + ai * 128 + m * 16;
#pragma unroll
                for (int bj = 0; bj < 2; ++bj) { const size_t off = (size_t)row * 1024 + u.po * 256 + bj * 128 + colw;
                    const u32x4 g = gv[m][bj], pm = pv[m][bj];
                    const f32x4 a0 = acc[ai][bj][m][0] * rs[m], a1 = acc[ai][bj][m][1] * rs[m];
                    float o[8];
                    o[0] = bflo(g.x) * a0[0] + bflo(pm.x); o[1] = bfhi(g.x) * a0[1] + bfhi(pm.x); o[2] = bflo(g.y) * a0[2] + bflo(pm.y); o[3] = bfhi(g.y) * a0[3] + bfhi(pm.y);
                    o[4] = bflo(g.z) * a1[0] + bflo(pm.z); o[5] = bfhi(g.z) * a1[1] + bfhi(pm.z); o[6] = bflo(g.w) * a1[2] + bflo(pm.w); o[7] = bfhi(g.w) * a1[3] + bfhi(pm.w);
                    u32x4 w; w.x = cvt_pk_bf16(o[0], o[1]); w.y = cvt_pk_bf16(o[2], o[3]); w.z = cvt_pk_bf16(o[4], o[5]); w.w = cvt_pk_bf16(o[6], o[7]);
                    *(u32x4*)(Mb + off) = w; } }
            __builtin_amdgcn_sched_barrier(0);
        }
    } break;
    default: break;
    }
}


__device__ __forceinline__ float ret_rms2(const float* ss, int row, int h) { const f32x2 v = *(const f32x2*)(ss + (size_t)row * 8 + 2 * h); return (v[0] + v[1]) * (1.0f / 512.0f) + EPS; }
__device__ __forceinline__ void rescale_rows(const Ctx& cx, f32x4 (&acc)[2][2][4][2], int rowb, int hn) {
    const float* ss = WSP(float, WS_RSS);
#pragma unroll
    for (int ai = 0; ai < 2; ++ai)
#pragma unroll
        for (int m = 0; m < 4; ++m) { const int row = rowb + ai * 128 + m * 16; const float f = sqrtf(ret_rms2(ss, row, hn) / ret_rms2(ss, row, hn - 1));
#pragma unroll
            for (int bj = 0; bj < 2; ++bj)
#pragma unroll
                for (int n = 0; n < 2; ++n) acc[ai][bj][m][n] = acc[ai][bj][m][n] * f; }
}
__device__ __forceinline__ void gemm_phase(LAS unsigned char* lds, const GemmSched& S, const Ctx& cx, int WV) {
    using namespace pg8;
    int tid = TID_OF(WV); asm volatile("" : "+v"(tid));
    const int wid = __builtin_amdgcn_readfirstlane(tid >> 6), lane = tid & 63, wr = wid >> 2, wc = wid & 3, fr = lane & 15, fq = lane >> 4;
    int RA, RB, CC;
    { int R, C; stage_rc(tid * 16, R, C); RA = R * 2; RB = ((R & ~31) + perm32(R & 31)) * 2; CC = C * 2; }
    const size_t kstep = (size_t)(BK * 2);
    const unsigned ldsw = (unsigned)wid * 1024u;
    const int aoff = lds_byte(wr * 64 + fr, fq * 8), boff = lds_byte(wc * 32 + fr, fq * 8);
#define PG8_SA(b, h) (((b) * 2 + (h)) * HTB)
#define PG8_SB(b, h) ((4 + (b) * 2 + (h)) * HTB)
#define PG8_STAGE(bufoff, gbase, voff, hs) do { \
        __builtin_amdgcn_global_load_lds((const unsigned*)((const char*)(gbase) + (voff)), (LAS unsigned*)(lds + (bufoff) + ldsw), 16, 0, 0); \
        __builtin_amdgcn_global_load_lds((const unsigned*)((const char*)(gbase) + ((hs) >> 1) + (voff)), (LAS unsigned*)(lds + (bufoff) + ldsw + 8192), 16, 0, 0); } while (0)
#define PG8_LDA(dst, b, h) do { _Pragma("unroll") for (int m = 0; m < 4; ++m) _Pragma("unroll") for (int k = 0; k < 2; ++k) dst[m][k] = *(const LAS bf16x8*)(lds + PG8_SA(b, h) + aoff + m * 2048 + k * 1024); } while (0)
#define PG8_LDB(dst, b, h) do { _Pragma("unroll") for (int n = 0; n < 2; ++n) _Pragma("unroll") for (int k = 0; k < 2; ++k) dst[n][k] = *(const LAS bf16x8*)(lds + PG8_SB(b, h) + boff + n * 2048 + k * 1024); } while (0)
#define PG8_MMA(ai, bj, At, Bt) do { __builtin_amdgcn_s_setprio(1); _Pragma("unroll") for (int m = 0; m < 4; ++m) _Pragma("unroll") for (int n = 0; n < 2; ++n) _Pragma("unroll") for (int k = 0; k < 2; ++k) \
        acc[ai][bj][m][n] = __builtin_amdgcn_mfma_f32_16x16x32_bf16(Bt[n][k], At[m][k], acc[ai][bj][m][n], 0, 0, 0); __builtin_amdgcn_s_setprio(0); } while (0)
#define PG8_WAIT_V(n) asm volatile("s_waitcnt vmcnt(" #n ")" ::: "memory")
#define PG8_WAIT_L(n) asm volatile("s_waitcnt lgkmcnt(" #n ")" ::: "memory")
#define PG8_BAR __builtin_amdgcn_s_barrier()
#define PG8_SCHED __builtin_amdgcn_sched_barrier(0)
    Unit cur, nxt; int ui = 0;
    if (!S.next(0, cur)) return;
    f32x4 acc[2][2][4][2];
    { float z = 0.f; asm volatile("" : "+v"(z));
#pragma unroll
    for (int a = 0; a < 2; ++a)
#pragma unroll
        for (int b = 0; b < 2; ++b)
#pragma unroll
            for (int m = 0; m < 4; ++m)
#pragma unroll
                for (int n = 0; n < 2; ++n) acc[a][b][m][n] = (f32x4){z, z, z, z}; }
    bf16x8 At[4][2], B0[2][2], B1[2][2];
    int Kc = cur.K; size_t hsAc = (size_t)HALF * cur.lda * 2, hsBc = (size_t)HALF * Kc * 2;
    unsigned vAc = (unsigned)(RA * cur.lda + CC), vBc = (unsigned)(RB * Kc + CC);
    const char* cA = (const char*)cur.A + (size_t)cur.pm * 2 * hsAc; const char* cB = (const char*)cur.Bt + (size_t)cur.pn * 2 * hsBc;
    PG8_STAGE(PG8_SB(0, 0), cB, vBc, hsBc); PG8_STAGE(PG8_SB(0, 1), cB + hsBc, vBc, hsBc); PG8_STAGE(PG8_SA(0, 0), cA, vAc, hsAc); PG8_STAGE(PG8_SA(0, 1), cA + hsAc, vAc, hsAc);
    if (wr == 1) PG8_BAR;
    PG8_WAIT_V(2); PG8_BAR;
    PG8_STAGE(PG8_SB(1, 0), cB + kstep, vBc, hsBc); PG8_STAGE(PG8_SA(1, 0), cA + kstep, vAc, hsAc); PG8_STAGE(PG8_SB(1, 1), cB + hsBc + kstep, vBc, hsBc);
    PG8_WAIT_V(6); PG8_BAR;
    for (;;) {
        const bool has_next = S.next(ui + 1, nxt);
        const int Kn = has_next ? nxt.K : Kc; const int ldan = has_next ? nxt.lda : cur.lda; const size_t hsAn = (size_t)HALF * ldan * 2, hsBn = (size_t)HALF * Kn * 2;
        const unsigned vAn = (unsigned)(RA * ldan + CC), vBn = (unsigned)(RB * Kn + CC);
        const char* nA = has_next ? (const char*)nxt.A + (size_t)nxt.pm * 2 * hsAn : cA; const char* nB = has_next ? (const char*)nxt.Bt + (size_t)nxt.pn * 2 * hsBn : cB;
        const int nt = Kc / BK; const int kjt = cur.kjt; const size_t kj = (size_t)cur.kjump;
#define PG8_AOFF(tt) ((size_t)(tt) * kstep + (((tt) >= kjt) ? kj : (size_t)0))
        for (int t = 0; t < nt; t += 2) {
            const bool last = (t == nt - 2);
            const bool fresh = (t == 0) && (ui > 0);
            const char* a1 = cA + PG8_AOFF(t + 1);
            const char* a2 = last ? nA : cA + PG8_AOFF(t + 2); const char* b2 = last ? nB : cB + (size_t)(t + 2) * kstep;
            const char* a3 = last ? nA + kstep : cA + PG8_AOFF(t + 3); const char* b3 = b2 + kstep;
            const size_t hsA2 = last ? hsAn : hsAc, hsB2 = last ? hsBn : hsBc;
            const unsigned vA2 = last ? vAn : vAc, vB2 = last ? vBn : vBc;
            PG8_LDB(B0, 0, 0); PG8_LDB(B1, 0, 1); PG8_SCHED; PG8_LDA(At, 0, 0); if (!fresh) PG8_STAGE(PG8_SA(1, 1), a1 + hsAc, vAc, hsAc);
            if (!fresh) PG8_WAIT_V(8); PG8_WAIT_L(0); PG8_BAR; PG8_MMA(0, 0, At, B0); PG8_MMA(0, 1, At, B1); PG8_BAR; PG8_SCHED;
            PG8_LDA(At, 0, 1); PG8_STAGE(PG8_SB(0, 0), b2, vB2, hsB2); PG8_STAGE(PG8_SB(0, 1), b2 + hsB2, vB2, hsB2); PG8_STAGE(PG8_SA(0, 0), a2, vA2, hsA2);
            if (!fresh) PG8_WAIT_V(8); PG8_WAIT_L(0); PG8_BAR; PG8_MMA(1, 0, At, B0); PG8_MMA(1, 1, At, B1); PG8_BAR; PG8_SCHED;
            PG8_LDB(B0, 1, 0); PG8_LDB(B1, 1, 1); PG8_SCHED; PG8_LDA(At, 1, 0); PG8_STAGE(PG8_SA(0, 1), a2 + hsA2, vA2, hsA2);
            if (!fresh) PG8_WAIT_V(8); PG8_WAIT_L(0); PG8_BAR; PG8_MMA(0, 0, At, B0); PG8_MMA(0, 1, At, B1); PG8_BAR; PG8_SCHED;
            PG8_LDA(At, 1, 1); PG8_STAGE(PG8_SB(1, 0), b3, vB2, hsB2); PG8_STAGE(PG8_SB(1, 1), b3 + hsB2, vB2, hsB2); PG8_STAGE(PG8_SA(1, 0), a3, vA2, hsA2);
            PG8_WAIT_V(8); PG8_WAIT_L(0); PG8_BAR; PG8_MMA(1, 0, At, B0); PG8_MMA(1, 1, At, B1); PG8_BAR; PG8_SCHED;
        }
#undef PG8_AOFF
        if (wr == 0) PG8_BAR;
        if (has_next) {
            const char* a1n = nA + kstep + ((1 >= nxt.kjt) ? (size_t)nxt.kjump : (size_t)0);
            PG8_STAGE(PG8_SA(1, 1), a1n + hsAn, vAn, hsAn);
            const int ek = cur.epi;
            if (!(ek == EP_GU || ek == EP_PLAIN || ek == EP_DQK || ek == EP_MQ || ek == EP_ROT || ek == EP_SG)) PG8_WAIT_V(0);
        }
        { int fr_ = fr, fq_ = fq; asm volatile("" : "+v"(fr_), "+v"(fq_));
          epilogue(cx, cur, acc, wr, wc, fr_, fq_, lds); }
        if (!has_next) break;
        {
            const bool rsc = (cur.epi == EP_RSC); const int hn = rsc ? cur.aux : 1; const float* ss = WSP(float, WS_RSS); const int rowb = cur.pm * 256 + wr * 64 + fr;
#pragma unroll
            for (int a = 0; a < 2; ++a)
#pragma unroll
                for (int m = 0; m < 4; ++m) { const int row = rowb + a * 128 + m * 16; float f = 0.0f; if (rsc) f = sqrtf(ret_rms2(ss, row, hn) / ret_rms2(ss, row, hn - 1));
#pragma unroll
                    for (int b = 0; b < 2; ++b)
#pragma unroll
                        for (int n = 0; n < 2; ++n) acc[a][b][m][n] = acc[a][b][m][n] * f; }
        }
        cur = nxt; cA = nA; cB = nB; Kc = Kn; hsAc = hsAn; hsBc = hsBn; vAc = vAn; vBc = vBn;
        ++ui;
        if (wr == 1) PG8_BAR;
    }
    PG8_WAIT_V(0);
    PG8_BAR;
#undef PG8_SA
#undef PG8_SB
#undef PG8_STAGE
#undef PG8_LDA
#undef PG8_LDB
#undef PG8_MMA
#undef PG8_WAIT_V
#undef PG8_WAIT_L
#undef PG8_BAR
#undef PG8_SCHED
}

struct AttItem {
    const bf16_t* Q; int ldq;
    const bf16_t* K; int ldk;
    const bf16_t* V; int ldv;
    bf16_t* O; int ldo;
    const bf16_t* G;
    int nt;
    int q0;
    float p0, p1, p2;
};
__device__ __forceinline__ s16x4 ds_tr16(const LAS unsigned char* p) { return __builtin_bit_cast(s16x4, __builtin_amdgcn_ds_read_tr16_b64_v4i16((LAS s16x4*)p)); }

template <int NM, int DQ, int DV, int MODE>
__device__ __forceinline__ void attn_item(LAS unsigned char* lds, const AttItem& it, const Ctx& cx, int WV) {
    constexpr int QW = NM * DQ, QP = (QW + 8) * 2  , VP = (DV + 8) * 2, PP = 72 * 2;
    constexpr int OFF_Q = 0, OFF_K = OFF_Q + 64 * QP, OFF_V = OFF_K + 64 * QP, OFF_P = OFF_V + 64 * VP, OFF_R = OFF_P + NM * 64 * PP;
    static_assert(OFF_R + 8 * 64 * 4 + 2 * 64 * 4 <= ATT_BYTES, "attention LDS");
    int tid = TID_OF(WV); asm volatile("" : "+v"(tid));
    const int w = __builtin_amdgcn_readfirstlane(tid >> 6), l = tid & 63, l15 = l & 15, g = l >> 4;
    const int rb = w >> 1, ch = w & 1;
    constexpr int NTV = DV / 128;
    const int c0 = w * (DV / 8);
    LAS float* RED = (LAS float*)(lds + OFF_R);
    LAS float* FIN = RED + 8 * 64;
    for (int i = tid; i < 64 * (QW / 8); i += 512) { const int r = i / (QW / 8), c = i % (QW / 8);
        *(LAS u32x4*)(lds + OFF_Q + r * QP + c * 16) = *(const u32x4*)(it.Q + (size_t)r * it.ldq + c * 8); }
    f32x4 o[NM][4][NTV];
#pragma unroll
    for (int r = 0; r < NM; ++r)
#pragma unroll
        for (int m = 0; m < 4; ++m)
#pragma unroll
            for (int n = 0; n < NTV; ++n) o[r][m][n] = (f32x4){0.f, 0.f, 0.f, 0.f};
    float lsum[NM][4];
#pragma unroll
    for (int r = 0; r < NM; ++r)
#pragma unroll
        for (int j = 0; j < 4; ++j) lsum[r][j] = 0.f;
    for (int kt = 0; kt < it.nt; ++kt) {
        for (int i = tid; i < 64 * (QW / 8); i += 512) { const int r = i / (QW / 8), c = i % (QW / 8);
            *(LAS u32x4*)(lds + OFF_K + r * QP + c * 16) = *(const u32x4*)(it.K + (size_t)(kt * 64 + r) * it.ldk + c * 8); }
        for (int i = tid; i < 64 * (DV / 8); i += 512) { const int r = i / (DV / 8), c = i % (DV / 8);
            *(LAS u32x4*)(lds + OFF_V + r * VP + c * 16) = *(const u32x4*)(it.V + (size_t)(kt * 64 + r) * it.ldv + c * 8); }
        __syncthreads();
#pragma unroll
        for (int r = 0; r < NM; ++r) {
            f32x4 s[2]; s[0] = (f32x4){0.f, 0.f, 0.f, 0.f}; s[1] = s[0];
#pragma unroll
            for (int ks = 0; ks < DQ / 32; ++ks) {
                const bf16x8 a = *(const LAS bf16x8*)(lds + OFF_Q + (16 * rb + l15) * QP + (r * DQ + 32 * ks + 8 * g) * 2);
#pragma unroll
                for (int n = 0; n < 2; ++n) { const bf16x8 b = *(const LAS bf16x8*)(lds + OFF_K + (32 * ch + 16 * n + l15) * QP + (r * DQ + 32 * ks + 8 * g) * 2);
                    s[n] = __builtin_amdgcn_mfma_f32_16x16x32_bf16(a, b, s[n], 0, 0, 0); }
            }
#pragma unroll
            for (int n = 0; n < 2; ++n)
#pragma unroll
                for (int j = 0; j < 4; ++j) {
                    const int row = 16 * rb + 4 * g + j, key = 32 * ch + 16 * n + l15; float p;
                    if (MODE == 0) { const int dist = (it.q0 + row) - (kt * 64 + key); p = s[n][j] * __builtin_amdgcn_exp2f(it.p0 * (float)(dist < 0 ? -dist : dist)); }
                    else { p = __builtin_amdgcn_exp2f(s[n][j] * it.p0 - it.p1); lsum[r][j] += p; }
                    *(LAS unsigned short*)(lds + OFF_P + r * 64 * PP + row * PP + key * 2) = f2bf(p);
                }
        }
        __syncthreads();
#pragma unroll
        for (int ks = 0; ks < 2; ++ks) {
            bf16x8 bv[NTV];
#pragma unroll
            for (int n = 0; n < NTV; ++n) {
                const int q = (l & 15) >> 2, p = l & 3;
                const LAS unsigned char* base = lds + OFF_V + (32 * ks + 8 * g + q) * VP + (c0 + 16 * n + 4 * p) * 2;
                const s16x4 t0 = ds_tr16(base), t1 = ds_tr16(base + 4 * VP);
                bv[n] = (bf16x8){t0[0], t0[1], t0[2], t0[3], t1[0], t1[1], t1[2], t1[3]};
            }
#pragma unroll
            for (int r = 0; r < NM; ++r)
#pragma unroll
                for (int m = 0; m < 4; ++m) {
                    const bf16x8 a = *(const LAS bf16x8*)(lds + OFF_P + r * 64 * PP + (16 * m + l15) * PP + (32 * ks + 8 * g) * 2);
#pragma unroll
                    for (int n = 0; n < NTV; ++n) o[r][m][n] = __builtin_amdgcn_mfma_f32_16x16x32_bf16(a, bv[n], o[r][m][n], 0, 0, 0);
                }
        }
        __syncthreads();
    }
    if (MODE != 0) {
#pragma unroll
        for (int r = 0; r < NM; ++r)
#pragma unroll
            for (int j = 0; j < 4; ++j) { float v = lsum[r][j]; v += xor_f<1>(v); v += xor_f<2>(v); v += xor_f<4>(v); v += xor_f<8>(v);
                if (l15 == 0) RED[(r * 2 + ch) * 64 + 16 * rb + 4 * g + j] = v; }
        __syncthreads();
        if (tid < NM * 64) { const int r = tid >> 6, row = tid & 63; FIN[r * 64 + row] = 1.0f / (RED[(r * 2 + 0) * 64 + row] + RED[(r * 2 + 1) * 64 + row]); }
        __syncthreads();
    }
    f32x4 y[4][NTV];
#pragma unroll
    for (int m = 0; m < 4; ++m)
#pragma unroll
        for (int n = 0; n < NTV; ++n)
#pragma unroll
            for (int j = 0; j < 4; ++j) { const int row = 16 * m + 4 * g + j;
                if (MODE == 0) y[m][n][j] = o[0][m][n][j];
                else if (MODE == 1) y[m][n][j] = o[0][m][n][j] * FIN[row] - it.p2 * (o[NM - 1][m][n][j] * FIN[(NM - 1) * 64 + row]);
                else y[m][n][j] = o[0][m][n][j] * FIN[row]; }
    if (MODE != 2) {
        __syncthreads();
#pragma unroll
        for (int m = 0; m < 4; ++m)
#pragma unroll
            for (int j = 0; j < 4; ++j) { float v = 0.f;
#pragma unroll
                for (int n = 0; n < NTV; ++n) v += y[m][n][j] * y[m][n][j];
                v += xor_f<1>(v); v += xor_f<2>(v); v += xor_f<4>(v); v += xor_f<8>(v);
                if (l15 == 0) RED[w * 64 + 16 * m + 4 * g + j] = v; }
        __syncthreads();
        if (tid < 64) { float s = 0.f;
#pragma unroll
            for (int k = 0; k < 8; ++k) s += RED[k * 64 + tid];
            FIN[tid] = rsqrtf(s * (1.0f / DV) + EPS); }
        __syncthreads();
    }
#pragma unroll
    for (int m = 0; m < 4; ++m)
#pragma unroll
        for (int n = 0; n < NTV; ++n)
#pragma unroll
            for (int j = 0; j < 4; ++j) { const int row = 16 * m + 4 * g + j, col = c0 + 16 * n + l15; float v = y[m][n][j];
                if (MODE == 0) { const float gt = bf2f(it.G[(size_t)row * it.ldv + col]); v = v * FIN[row] * (gt * fsigmoid(gt)); }
                else if (MODE == 1) { v = v * FIN[row] * cx.in[17][col] * 0.8f; }
                it.O[(size_t)row * it.ldo + col] = f2bf(v); }
    __syncthreads();
}


#define TR8(lo, hh, addr, base) asm volatile( \
    "ds_read_b64_tr_b16 %0, %8 offset:%c9\n\tds_read_b64_tr_b16 %4, %8 offset:%c10\n\t" \
    "ds_read_b64_tr_b16 %1, %8 offset:%c11\n\tds_read_b64_tr_b16 %5, %8 offset:%c12\n\t" \
    "ds_read_b64_tr_b16 %2, %8 offset:%c13\n\tds_read_b64_tr_b16 %6, %8 offset:%c14\n\t" \
    "ds_read_b64_tr_b16 %3, %8 offset:%c15\n\tds_read_b64_tr_b16 %7, %8 offset:%c16\n\ts_waitcnt lgkmcnt(0)" \
    : "=&v"(lo[0]), "=&v"(lo[1]), "=&v"(lo[2]), "=&v"(lo[3]), "=&v"(hh[0]), "=&v"(hh[1]), "=&v"(hh[2]), "=&v"(hh[3]) \
    : "v"(addr), "i"((base)), "i"((base) + 512), "i"((base) + 1024), "i"((base) + 1536), "i"((base) + 2048), "i"((base) + 2560), "i"((base) + 3072), "i"((base) + 3584) : "memory")
typedef float f32x16 __attribute__((ext_vector_type(16)));
struct FaUnit {
    const bf16_t* Q; int ldq;
    const bf16_t* K; int ldk;
    const bf16_t* V; int ldv;
    bf16_t* O; int ldo;
    int nt;
    int vis0;
    float c, mc, lam;
};
__device__ __forceinline__ int crow(int r, int hi) { return (r & 3) + 8 * (r >> 2) + 4 * hi; }
#define FA_WAIT_BAR() asm volatile("s_waitcnt vmcnt(0) lgkmcnt(0)\n\ts_barrier" ::: "memory")

template <int NM, int DQ, int NDVB, int MODE, int NPASS, bool QLDS>
__device__ __forceinline__ void fa_unit(LAS unsigned char* lds, const FaUnit& U, const Ctx& cx, int WV) {
    constexpr int NKP = NM * DQ / 8;
    constexpr int NVP = NDVB * 4;
    constexpr int KB = NKP * 1024, VB = NVP * 1024, SLOT = KB + VB;
    constexpr int OFF_WS = 2 * SLOT;
    constexpr int OFF_QL = OFF_WS + 8 * NM * 32 * 4;
    constexpr int NQF = NM * (DQ / 16);
    static_assert(OFF_QL + (QLDS ? NQF * 8192 : 0) <= ATT_BYTES, "fa LDS");
    static_assert(QLDS ? (8 * 32 * (NDVB * 64) <= NQF * 8192) : (8 * 32 * (NDVB * 64) <= OFF_WS), "fa stage");
    int tid = TID_OF(WV); asm volatile("" : "+v"(tid));
    const int w = __builtin_amdgcn_readfirstlane(tid >> 6), l = tid & 63, r32 = l & 31, hi = l >> 5;
    const unsigned kvo = (unsigned)(l * U.ldk * 2), vvo = (unsigned)((l >> 2) * U.ldv * 2 + (l & 3) * 16);
    const size_t ktile = (size_t)64 * U.ldk * 2, vtile = (size_t)64 * U.ldv * 2;
#define FA_DMA(t, slot) do { \
        const char* kb_ = (const char*)U.K + (size_t)(t) * ktile; const char* vb_ = (const char*)U.V + (size_t)(t) * vtile + ps * (64 * NDVB); \
        unsigned kvo_ = kvo, vvo_ = vvo; asm volatile("" : "+v"(kvo_), "+v"(vvo_));   \
        _Pragma("unroll") for (int i_ = 0; i_ < NKP / 8; ++i_) { const int ck = w + 8 * i_; \
            __builtin_amdgcn_global_load_lds((const unsigned*)(kb_ + ck * 16 + kvo_), (LAS unsigned*)(lds + (slot) * SLOT + ck * 1024), 16, 0, 0); } \
        _Pragma("unroll") for (int i_ = 0; i_ < NVP / 8; ++i_) { const int pv_ = w + 8 * i_, dvb_ = pv_ >> 2, kg_ = pv_ & 3; \
            __builtin_amdgcn_global_load_lds((const unsigned*)(vb_ + (size_t)(16 * kg_) * U.ldv * 2 + 64 * dvb_ + vvo_), (LAS unsigned*)(lds + (slot) * SLOT + KB + pv_ * 1024), 16, 0, 0); } \
    } while (0)
    bf16x8 qr[NM][DQ / 16];
    LAS unsigned char* qls = lds + OFF_QL + tid * 16;
    { const bf16_t* qp = U.Q + (size_t)(32 * w + r32) * U.ldq + 8 * hi;
#pragma unroll
      for (int r = 0; r < NM; ++r)
#pragma unroll
          for (int d0 = 0; d0 < DQ / 16; ++d0) { const bf16x8 v = *(const bf16x8*)(qp + r * DQ + 16 * d0);
              if (QLDS) *(LAS bf16x8*)(qls + (r * (DQ / 16) + d0) * 8192) = v; else qr[r][d0] = v; } }
#pragma unroll 1
    for (int ps = 0; ps < NPASS; ++ps) {
    FA_DMA(0, 0);
    float zf_ = 0.f; asm volatile("" : "+v"(zf_));
    f32x16 o[NM][NDVB];
#pragma unroll
    for (int r = 0; r < NM; ++r)
#pragma unroll
        for (int d = 0; d < NDVB; ++d)
#pragma unroll
            for (int i = 0; i < 16; ++i) o[r][d][i] = zf_;
    float lsum[NM];
#pragma unroll
    for (int r = 0; r < NM; ++r) lsum[r] = 0.f;
    const int vis = U.vis0 + (w >> 1);
    const int kfo = hi * 1024 + r32 * 16;
    const int vfo = (4 * hi + ((l & 15) >> 2)) * 64 + ((l >> 4) & 1) * 32 + (l & 3) * 8;
    FA_WAIT_BAR();
    for (int t = 0; t < U.nt; ++t) {
        const int slot = t & 1;
        if (t + 1 < U.nt) FA_DMA(t + 1, slot ^ 1);
        if (t <= vis) {
            const LAS unsigned char* kb = lds + slot * SLOT + kfo;
            const unsigned vba = (unsigned)(size_t)(lds + slot * SLOT + KB + vfo);
#pragma unroll
            for (int r = 0; r < NM; ++r) {
                bf16x8 pw[4]; float ls = 0.f;
#pragma unroll
                for (int kh = 0; kh < 2; ++kh) {
                    f32x16 p;
#pragma unroll
                    for (int i = 0; i < 16; ++i) p[i] = 0.f;
#pragma unroll
                    for (int d0 = 0; d0 < DQ / 16; ++d0) {
                        const bf16x8 a0 = *(const LAS bf16x8*)(kb + (r * (DQ / 8) + 2 * d0) * 1024 + kh * 512);
                        bf16x8 qf; if (QLDS) qf = *(const LAS bf16x8*)(qls + (r * (DQ / 16) + d0) * 8192); else qf = qr[r][d0];
                        p = __builtin_amdgcn_mfma_f32_32x32x16_bf16(a0, qf, p, 0, 0, 0);
                    }
#pragma unroll
                    for (int i = 0; i < 16; ++i) { p[i] = __builtin_amdgcn_exp2f(__builtin_fmaf(p[i], U.c, -U.mc)); ls += p[i]; }
                    u32x4 t0, t1;
                    t0.x = cvt_pk_bf16(p[0], p[1]); t0.y = cvt_pk_bf16(p[2], p[3]); t0.z = cvt_pk_bf16(p[4], p[5]); t0.w = cvt_pk_bf16(p[6], p[7]);
                    t1.x = cvt_pk_bf16(p[8], p[9]); t1.y = cvt_pk_bf16(p[10], p[11]); t1.z = cvt_pk_bf16(p[12], p[13]); t1.w = cvt_pk_bf16(p[14], p[15]);
                    pw[2 * kh] = __builtin_bit_cast(bf16x8, t0); pw[2 * kh + 1] = __builtin_bit_cast(bf16x8, t1);
                }
                lsum[r] += ls;
#pragma unroll
                for (int d = 0; d < NDVB; ++d) {
                    s16x4 lo[4], hh[4];
                    TR8(lo, hh, vba, d * 4096);
                    __builtin_amdgcn_sched_barrier(0);
#pragma unroll
                    for (int ks = 0; ks < 4; ++ks) {
                        const bf16x8 vf = (bf16x8){lo[ks][0], lo[ks][1], lo[ks][2], lo[ks][3], hh[ks][0], hh[ks][1], hh[ks][2], hh[ks][3]};
                        o[r][d] = __builtin_amdgcn_mfma_f32_32x32x16_bf16(pw[ks], vf, o[r][d], 0, 0, 0); }
                }
            }
        }
        FA_WAIT_BAR();
    }
#ifdef FA_NOEPI
    { float acc_ = lsum[0]; for (int r = 0; r < NM; ++r) for (int d = 0; d < NDVB; ++d) for (int i = 0; i < 16; ++i) acc_ += o[r][d][i]; U.O[tid] = f2bf(acc_); }
#else
    LAS float* wsf = (LAS float*)(lds + OFF_WS) + w * (NM * 32);
#pragma unroll
    for (int r = 0; r < NM; ++r) { const float v = sum_xor32(lsum[r]); if (hi == 0) wsf[r * 32 + r32] = __builtin_amdgcn_rcpf(v); }
    asm volatile("s_waitcnt lgkmcnt(0)" ::: "memory");
    char* ob = (char*)U.O + ((size_t)(32 * w) * U.ldo + ps * (32 * NDVB)) * 2;
    constexpr int SPITCH = NDVB * 64; LAS unsigned char* stg = lds + (QLDS ? OFF_QL : 0) + w * (32 * SPITCH);
    float wv[NDVB];
#pragma unroll
    for (int d = 0; d < NDVB; ++d) wv[d] = (MODE == 1) ? cx.in[17][32 * d + r32] * 0.8f : 1.0f;
#pragma unroll
    for (int i = 0; i < 16; ++i) {
        const int q = crow(i, hi); const float li0 = wsf[q]; float y[NDVB];
        if (MODE == 1) { const float li1 = wsf[(NM - 1) * 32 + q] * U.lam; float s2 = 0.f;
#pragma unroll
            for (int d = 0; d < NDVB; ++d) { y[d] = o[0][d][i] * li0 - o[NM - 1][d][i] * li1; s2 += y[d] * y[d]; }
            s2 = row32_sum(s2);
            const float rn = __builtin_amdgcn_rsqf(s2 * (1.0f / (32 * NDVB)) + EPS);
#pragma unroll
            for (int d = 0; d < NDVB; ++d) y[d] = y[d] * rn * wv[d]; }
        else {
#pragma unroll
            for (int d = 0; d < NDVB; ++d) y[d] = o[0][d][i] * li0; }
#pragma unroll
        for (int d = 0; d < NDVB; ++d) *(LAS bf16_t*)(stg + q * SPITCH + (32 * d + r32) * 2) = f2bf(y[d]);
    }
    asm volatile("s_waitcnt lgkmcnt(0)" ::: "memory");
#pragma unroll
    for (int it = 0; it < NDVB * 2; ++it) { const int c = it * 64 + l, row = c / (NDVB * 4), ch = c % (NDVB * 4);
        const u32x4 v = *(const LAS u32x4*)(stg + row * SPITCH + ch * 16);
        *(u32x4*)(ob + ((size_t)row * U.ldo + ch * 8) * 2) = v; }
#endif
    FA_WAIT_BAR();
    }
#undef FA_DMA
}


struct RetUnit {
    const bf16_t* Q; const bf16_t* K; const bf16_t* V;
    const bf16_t* G; bf16_t* O;
    int nt;
    int c0;
    float lg;
};
__device__ __forceinline__ void fa_ret_unit(LAS unsigned char* lds, const RetUnit& U, int WV) {
    constexpr int LDQ = 512, LDK = 512, LDV = 1024, LDO = 1024;
    constexpr int KB = 16384, SLOT = 49152, OFF_QP = 2 * SLOT, OFF_WS = OFF_QP + 4 * 14 * 1024;
    static_assert(OFF_WS + 8 * 32 * 4 <= ATT_BYTES, "ret LDS");
    int tid = TID_OF(WV); asm volatile("" : "+v"(tid));
    const int w = __builtin_amdgcn_readfirstlane(tid >> 6), l = tid & 63, r32 = l & 31, hi = l >> 5, rb = w >> 1, dh = w & 1;
    const unsigned kvo = (unsigned)((l & 31) * LDK * 2 + (l >> 5) * 16), vvo = (unsigned)((l >> 2) * LDV * 2 + (l & 3) * 16);
#define RT_DMA(t, slot) do { \
        const char* kb_ = (const char*)U.K + (size_t)(t) * (32 * LDK * 2); const char* vb_ = (const char*)U.V + (size_t)(t) * (32 * LDV * 2); \
        unsigned kvo_ = kvo, vvo_ = vvo; asm volatile("" : "+v"(kvo_), "+v"(vvo_)); \
        _Pragma("unroll") for (int i_ = 0; i_ < 2; ++i_) { const int cp = w + 8 * i_; \
            __builtin_amdgcn_global_load_lds((const unsigned*)(kb_ + cp * 32 + kvo_), (LAS unsigned*)(lds + (slot) * SLOT + cp * 1024), 16, 0, 0); } \
        _Pragma("unroll") for (int i_ = 0; i_ < 4; ++i_) { const int pv_ = w + 8 * i_, dvb_ = pv_ >> 1, kg_ = pv_ & 1; \
            __builtin_amdgcn_global_load_lds((const unsigned*)(vb_ + kg_ * (16 * LDV * 2) + 64 * dvb_ + vvo_), (LAS unsigned*)(lds + (slot) * SLOT + KB + pv_ * 1024), 16, 0, 0); } \
    } while (0)
    RT_DMA(0, 0);
    bf16x8 q0r, q1r;
    { const bf16_t* qp = U.Q + (size_t)(32 * rb + r32) * LDQ + 8 * hi; LAS unsigned char* qpk = lds + OFF_QP + rb * 14336 + l * 16;
      q0r = *(const bf16x8*)(qp); q1r = *(const bf16x8*)(qp + 16);
      if (dh == 0) {
#pragma unroll
          for (int d0 = 2; d0 < 16; ++d0) *(LAS bf16x8*)(qpk + (d0 - 2) * 1024) = *(const bf16x8*)(qp + 16 * d0); } }
    f32x16 o[8];
#pragma unroll
    for (int d = 0; d < 8; ++d)
#pragma unroll
        for (int i = 0; i < 16; ++i) o[d][i] = 0.f;
    const int cw = U.c0 + (rb >> 1);
    const int kfo = hi * 512 + r32 * 16;
    const int vfo = (4 * hi + ((l & 15) >> 2)) * 64 + ((l >> 4) & 1) * 32 + (l & 3) * 8;
    const LAS unsigned char* qpk = lds + OFF_QP + rb * 14336 + l * 16;
    const float qpos = (float)(64 * U.c0 + 32 * rb + r32);
    FA_WAIT_BAR();
    for (int t = 0; t < U.nt; ++t) {
        const int slot = t & 1;
        if (t + 1 < U.nt) RT_DMA(t + 1, slot ^ 1);
        if ((t >> 1) <= cw) {
            const LAS unsigned char* kb = lds + slot * SLOT + kfo;
            const unsigned vba = (unsigned)(size_t)(lds + slot * SLOT + KB + dh * 16384 + vfo);
            f32x16 p;
#pragma unroll
            for (int i = 0; i < 16; ++i) p[i] = 0.f;
            {
                bf16x8 ka[2][4], qa[2][4];
#define RT_LOADB(buf, b_) do { _Pragma("unroll") for (int j = 0; j < 4; ++j) { const int d0 = 4 * (b_) + j; ka[buf][j] = *(const LAS bf16x8*)(kb + d0 * 1024); \
                    if (d0 == 0) qa[buf][j] = q0r; else if (d0 == 1) qa[buf][j] = q1r; else qa[buf][j] = *(const LAS bf16x8*)(qpk + (d0 - 2) * 1024); } } while (0)
                RT_LOADB(0, 0);
#pragma unroll
                for (int b_ = 0; b_ < 4; ++b_) {
                    if (b_ < 3) RT_LOADB((b_ + 1) & 1, b_ + 1);
                    __builtin_amdgcn_sched_barrier(0);
#pragma unroll
                    for (int j = 0; j < 4; ++j) p = __builtin_amdgcn_mfma_f32_32x32x16_bf16(ka[b_ & 1][j], qa[b_ & 1][j], p, 0, 0, 0);
                    __builtin_amdgcn_sched_barrier(0);
                }
#undef RT_LOADB
            }
            const float dq = qpos - (float)(32 * t + 4 * hi);
#pragma unroll
            for (int i = 0; i < 16; ++i) { const float dd = dq - (float)((i & 3) + 8 * (i >> 2)); p[i] *= __builtin_amdgcn_exp2f(U.lg * __builtin_fabsf(dd)); }
            bf16x8 pw0, pw1;
            { u32x4 t0, t1;
              t0.x = cvt_pk_bf16(p[0], p[1]); t0.y = cvt_pk_bf16(p[2], p[3]); t0.z = cvt_pk_bf16(p[4], p[5]); t0.w = cvt_pk_bf16(p[6], p[7]);
              t1.x = cvt_pk_bf16(p[8], p[9]); t1.y = cvt_pk_bf16(p[10], p[11]); t1.z = cvt_pk_bf16(p[12], p[13]); t1.w = cvt_pk_bf16(p[14], p[15]);
              pw0 = __builtin_bit_cast(bf16x8, t0); pw1 = __builtin_bit_cast(bf16x8, t1); }
            {
#pragma unroll
                for (int dp = 0; dp < 4; ++dp) {
                    s16x4 lo[4], hh[4];
                    TR8(lo, hh, vba, dp * 4096);
                    __builtin_amdgcn_sched_barrier(0);
#pragma unroll
                    for (int j = 0; j < 4; ++j) {
                        const bf16x8 vf = (bf16x8){lo[j][0], lo[j][1], lo[j][2], lo[j][3], hh[j][0], hh[j][1], hh[j][2], hh[j][3]};
                        o[dp * 2 + (j >> 1)] = __builtin_amdgcn_mfma_f32_32x32x16_bf16((j & 1) ? pw1 : pw0, vf, o[dp * 2 + (j >> 1)], 0, 0, 0); }
                }
            }
        }
        FA_WAIT_BAR();
    }
#undef RT_DMA
    LAS float* wsf = (LAS float*)(lds + OFF_WS);
    float ssr[16];
#pragma unroll
    for (int i = 0; i < 16; ++i) { float s2 = 0.f;
#pragma unroll
        for (int d = 0; d < 8; ++d) s2 += o[d][i] * o[d][i];
        s2 = row32_sum(s2);
        ssr[i] = s2; if (r32 == 0) wsf[w * 32 + crow(i, hi)] = s2; }
    FA_WAIT_BAR();
    const size_t gbase = (size_t)(32 * rb) * LDO + 256 * dh + r32;
#pragma unroll
    for (int i = 0; i < 16; ++i) {
        const int q = crow(i, hi); const float rn = rsqrtf((ssr[i] + wsf[(w ^ 1) * 32 + q]) * (1.0f / 512.0f) + EPS);
        const size_t ro = gbase + (size_t)q * LDO;
#pragma unroll
        for (int d = 0; d < 8; ++d) { const float gt = bf2f(U.G[ro + 32 * d]); U.O[ro + 32 * d] = f2bf(o[d][i] * rn * (gt * fsigmoid(gt))); }
        __builtin_amdgcn_sched_barrier(0);
    }
    FA_WAIT_BAR();
}


struct Ret2Unit {
    const bf16_t* Q; const bf16_t* K; const bf16_t* V;
    const bf16_t* G; bf16_t* O; float* SS;
    int nt, c0; float lg;
};
__device__ __forceinline__ void fa_ret2_unit(LAS unsigned char* lds, const Ret2Unit& U, int WV) {
    constexpr int LDQ = 512, LDK = 512, LDV = 1024, LDO = 1024;
    constexpr int KB = 16384, SLOT = 32768, NS = 3, OFF_WS = NS * SLOT;
    static_assert(OFF_WS + 8 * 32 * 4 <= ATT_BYTES, "ret2 LDS");
    int tid = TID_OF(WV); asm volatile("" : "+v"(tid));
    const int w = __builtin_amdgcn_readfirstlane(tid >> 6), l = tid & 63, r32 = l & 31, hi = l >> 5, rb = w >> 1, dq = w & 1;
    const unsigned kvo = (unsigned)((l & 31) * LDK * 2 + (l >> 5) * 16), vvo = (unsigned)((l >> 2) * LDV * 2 + (l & 3) * 16);
#define R2_DMA(t, slot) do { \
        const char* kb_ = (const char*)U.K + (size_t)(t) * (32 * LDK * 2); const char* vb_ = (const char*)U.V + (size_t)(t) * (32 * LDV * 2); \
        unsigned kvo_ = kvo, vvo_ = vvo; asm volatile("" : "+v"(kvo_), "+v"(vvo_)); \
        _Pragma("unroll") for (int i_ = 0; i_ < 2; ++i_) { const int cp = w + 8 * i_; \
            __builtin_amdgcn_global_load_lds((const unsigned*)(kb_ + cp * 32 + kvo_), (LAS unsigned*)(lds + (slot) * SLOT + cp * 1024), 16, 0, 0); } \
        _Pragma("unroll") for (int i_ = 0; i_ < 2; ++i_) { const int pv_ = w + 8 * i_, dvb_ = pv_ >> 1, kg_ = pv_ & 1; \
            __builtin_amdgcn_global_load_lds((const unsigned*)(vb_ + kg_ * (16 * LDV * 2) + 64 * dvb_ + vvo_), (LAS unsigned*)(lds + (slot) * SLOT + KB + pv_ * 1024), 16, 0, 0); } \
    } while (0)
    R2_DMA(0, 0);
    if (U.nt > 1) R2_DMA(1, 1);
    bf16x8 qr[16];
    { const bf16_t* qp = U.Q + (size_t)(32 * rb + r32) * LDQ + 8 * hi;
#pragma unroll
      for (int d0 = 0; d0 < 16; ++d0) qr[d0] = *(const bf16x8*)(qp + 16 * d0); }
    f32x16 o[4];
    { float z = 0.f; asm volatile("" : "+v"(z));
#pragma unroll
    for (int d = 0; d < 4; ++d)
#pragma unroll
        for (int i = 0; i < 16; ++i) o[d][i] = z; }
    const int cw = U.c0 + (rb >> 1);
    const int kfo = hi * 512 + r32 * 16;
    const int vfo = (4 * hi + ((l & 15) >> 2)) * 64 + ((l >> 4) & 1) * 32 + (l & 3) * 8;
    const float qpos = (float)(64 * U.c0 + 32 * rb + r32);
    float cf[16];
#pragma unroll
    for (int i = 0; i < 16; ++i) cf[i] = __builtin_amdgcn_exp2f(-U.lg * (float)((i & 3) + 8 * (i >> 2)));
    asm volatile("s_waitcnt vmcnt(0) lgkmcnt(0)\n\ts_barrier" ::: "memory");
    int slot = 0;
    for (int t = 0; t < U.nt; ++t) {
        const int s2 = (slot >= 1) ? slot - 1 : 2;
        const bool more = (t + 2 < U.nt);
        if ((t >> 1) <= cw) {
            const LAS unsigned char* kb = lds + slot * SLOT + kfo;
            const unsigned vba = (unsigned)(size_t)(lds + slot * SLOT + KB + dq * 8192 + vfo);
            f32x16 p;
#pragma unroll
            for (int i = 0; i < 16; ++i) p[i] = 0.f;
            {   bf16x8 ka[2][4];
#define R2_LOADB(buf, b_) do { _Pragma("unroll") for (int j = 0; j < 4; ++j) ka[buf][j] = *(const LAS bf16x8*)(kb + (4 * (b_) + j) * 1024); } while (0)
                R2_LOADB(0, 0);
#pragma unroll
                for (int b_ = 0; b_ < 4; ++b_) {
                    if (b_ < 3) R2_LOADB((b_ + 1) & 1, b_ + 1);
                    __builtin_amdgcn_sched_barrier(0);
#pragma unroll
                    for (int j = 0; j < 4; ++j) p = __builtin_amdgcn_mfma_f32_32x32x16_bf16(ka[b_ & 1][j], qr[4 * b_ + j], p, 0, 0, 0);
                    __builtin_amdgcn_sched_barrier(0);
                }
#undef R2_LOADB
            }
            const float dqp = qpos - (float)(32 * t + 4 * hi);
            if ((t >> 1) < cw) {
                const float rowf = __builtin_amdgcn_exp2f(U.lg * dqp);
#pragma unroll
                for (int i = 0; i < 16; ++i) p[i] *= rowf * cf[i];
            } else {
#pragma unroll
                for (int i = 0; i < 16; ++i) { const float dd = dqp - (float)((i & 3) + 8 * (i >> 2)); p[i] *= __builtin_amdgcn_exp2f(U.lg * __builtin_fabsf(dd)); }
            }
            bf16x8 pw0, pw1;
            { u32x4 t0, t1;
              t0.x = cvt_pk_bf16(p[0], p[1]); t0.y = cvt_pk_bf16(p[2], p[3]); t0.z = cvt_pk_bf16(p[4], p[5]); t0.w = cvt_pk_bf16(p[6], p[7]);
              t1.x = cvt_pk_bf16(p[8], p[9]); t1.y = cvt_pk_bf16(p[10], p[11]); t1.z = cvt_pk_bf16(p[12], p[13]); t1.w = cvt_pk_bf16(p[14], p[15]);
              pw0 = __builtin_bit_cast(bf16x8, t0); pw1 = __builtin_bit_cast(bf16x8, t1); }
            {
                const LAS unsigned char* vbp = lds + slot * SLOT + KB + dq * 8192 + vfo;
#pragma unroll
                for (int dp = 0; dp < 2; ++dp)
#pragma unroll
                    for (int j = 0; j < 4; ++j) {
                        const s16x4 lo = ds_tr16(vbp + (dp * 4 + j) * 1024), hh = ds_tr16(vbp + (dp * 4 + j) * 1024 + 512);
                        const bf16x8 vf = (bf16x8){lo[0], lo[1], lo[2], lo[3], hh[0], hh[1], hh[2], hh[3]};
                        o[dp * 2 + (j >> 1)] = __builtin_amdgcn_mfma_f32_32x32x16_bf16((j & 1) ? pw1 : pw0, vf, o[dp * 2 + (j >> 1)], 0, 0, 0); }
            }
        }
        if (more) R2_DMA(t + 2, s2);
        if (more) asm volatile("s_waitcnt vmcnt(4) lgkmcnt(0)\n\ts_barrier" ::: "memory");
        else asm volatile("s_waitcnt vmcnt(0) lgkmcnt(0)\n\ts_barrier" ::: "memory");
        slot = (slot == 2) ? 0 : slot + 1;
    }
#undef R2_DMA
    LAS float* wsf = (LAS float*)(lds + OFF_WS);
    float ssr[16];
#pragma unroll
    for (int i = 0; i < 16; ++i) { float s2v = 0.f;
#pragma unroll
        for (int d = 0; d < 4; ++d) s2v += o[d][i] * o[d][i];
        s2v = row32_sum(s2v);
        ssr[i] = s2v; if (r32 == 0) wsf[w * 32 + crow(i, hi)] = s2v; }
    FA_WAIT_BAR();
    if (dq == 0 && r32 == 0) {
#pragma unroll
        for (int i = 0; i < 16; ++i) { const int q = crow(i, hi); U.SS[(size_t)(32 * rb + q) * 8] = ssr[i] + wsf[(w ^ 1) * 32 + q]; } }
    const size_t gbase = (size_t)(32 * rb) * LDO + 128 * dq + r32;
#pragma unroll
    for (int i = 0; i < 16; ++i) {
        const size_t ro = gbase + (size_t)crow(i, hi) * LDO;
#pragma unroll
        for (int d = 0; d < 4; ++d) { const float gt = bf2f(U.G[ro + 32 * d]); U.O[ro + 32 * d] = f2bf(o[d][i] * (gt * fsigmoid(gt))); }
        __builtin_amdgcn_sched_barrier(0);
    }
    FA_WAIT_BAR();
}

struct Ret3Unit {
    const bf16_t* Q; const bf16_t* K; const bf16_t* V;
    const bf16_t* G; bf16_t* O; float* SS;
    const bf16_t* ST;
    int nst, nt, c0; float lg;
};
__device__ __forceinline__ void fa_ret3_unit(LAS unsigned char* lds, const Ret3Unit& U, int WV) {
    constexpr int LDQ = 512, LDK = 512, LDV = 1024, LDO = 1024;
    constexpr int KB = 16384, SLOT = 32768, NS = 3, OFF_WS = NS * SLOT;
    static_assert(OFF_WS + 8 * 32 * 4 <= ATT_BYTES, "ret2 LDS");
    int tid = TID_OF(WV); asm volatile("" : "+v"(tid));
    const int w = __builtin_amdgcn_readfirstlane(tid >> 6), l = tid & 63, r32 = l & 31, hi = l >> 5, rb = w >> 1, dq = w & 1;
    const unsigned kvo = (unsigned)((l & 31) * LDK * 2 + (l >> 5) * 16), vvo = (unsigned)((l >> 2) * LDV * 2 + (l & 3) * 16);
#define R3_DMA(t, slot) do { \
        const char* kb_ = (const char*)U.K + (size_t)(t) * (32 * LDK * 2); const char* vb_ = (const char*)U.V + (size_t)(t) * (32 * LDV * 2); \
        unsigned kvo_ = kvo, vvo_ = vvo; asm volatile("" : "+v"(kvo_), "+v"(vvo_)); \
        _Pragma("unroll") for (int i_ = 0; i_ < 2; ++i_) { const int cp = w + 8 * i_; \
            __builtin_amdgcn_global_load_lds((const unsigned*)(kb_ + cp * 32 + kvo_), (LAS unsigned*)(lds + (slot) * SLOT + cp * 1024), 16, 0, 0); } \
        _Pragma("unroll") for (int i_ = 0; i_ < 2; ++i_) { const int pv_ = w + 8 * i_, dvb_ = pv_ >> 1, kg_ = pv_ & 1; \
            __builtin_amdgcn_global_load_lds((const unsigned*)(vb_ + kg_ * (16 * LDV * 2) + 64 * dvb_ + vvo_), (LAS unsigned*)(lds + (slot) * SLOT + KB + pv_ * 1024), 16, 0, 0); } \
    } while (0)
    const unsigned svo = (unsigned)(l * 512);
#define R3_DMAS(ts, slot) do { const char* sb_ = (const char*)U.ST + (size_t)((ts) >> 2) * (512 * 256 * 2) + ((ts) & 3) * 128; unsigned svo_ = svo; asm volatile("" : "+v"(svo_)); \
        _Pragma("unroll") for (int i_ = 0; i_ < 4; ++i_) { const int p_ = w + 8 * i_, c_ = p_ >> 2, dvq_ = p_ & 3; \
            __builtin_amdgcn_global_load_lds((const unsigned*)(sb_ + dvq_ * (64 * 512) + c_ * 16 + svo_), (LAS unsigned*)(lds + (slot) * SLOT + p_ * 1024), 16, 0, 0); } \
    } while (0)
#define R3_ANY(tt, slot) do { if ((tt) < nst) R3_DMAS((tt), (slot)); else R3_DMA((tt) - nst, (slot)); } while (0)
    const int nst = U.nst;
    R3_ANY(0, 0);
    R3_ANY(1, 1);
    bf16x8 qr[16];
    { const bf16_t* qp = U.Q + (size_t)(32 * rb + r32) * LDQ + 8 * hi;
#pragma unroll
      for (int d0 = 0; d0 < 16; ++d0) qr[d0] = *(const bf16x8*)(qp + 16 * d0); }
    f32x16 o[4];
    { float z = 0.f; asm volatile("" : "+v"(z));
#pragma unroll
    for (int d = 0; d < 4; ++d)
#pragma unroll
        for (int i = 0; i < 16; ++i) o[d][i] = z; }
    const int cw = U.c0 + (rb >> 1);
    const int kfo = hi * 512 + r32 * 16;
    const int vfo = (4 * hi + ((l & 15) >> 2)) * 64 + ((l >> 4) & 1) * 32 + (l & 3) * 8;
    const float qpos = (float)(64 * U.c0 + 32 * rb + r32);
    float cf[16];
#pragma unroll
    for (int i = 0; i < 16; ++i) cf[i] = __builtin_amdgcn_exp2f(-U.lg * (float)((i & 3) + 8 * (i >> 2)));
    asm volatile("s_waitcnt vmcnt(0) lgkmcnt(0)\n\ts_barrier" ::: "memory");
    int slot = 0;
    if (nst) {
        const float g512 = __builtin_amdgcn_exp2f(U.lg * 512.0f);
        const int ngrp = nst >> 2;
        for (int grp = 0; grp < ngrp; ++grp) {
            if (grp) {
#pragma unroll
                for (int d = 0; d < 4; ++d)
#pragma unroll
                    for (int i = 0; i < 16; ++i) o[d][i] *= g512; }
#pragma unroll
            for (int ts = 0; ts < 4; ++ts) {
                const LAS unsigned char* sb = lds + slot * SLOT + hi * 4096 + (128 * dq + r32) * 16;
#pragma unroll
                for (int d0l = 0; d0l < 4; ++d0l) {
                    bf16x8 sf[4];
#pragma unroll
                    for (int d = 0; d < 4; ++d) sf[d] = *(const LAS bf16x8*)(sb + d0l * 8192 + d * 512);
#pragma unroll
                    for (int d = 0; d < 4; ++d) o[d] = __builtin_amdgcn_mfma_f32_32x32x16_bf16(qr[4 * ts + d0l], sf[d], o[d], 0, 0, 0);
                }
                const int s2 = (slot >= 1) ? slot - 1 : 2;
                R3_ANY(4 * grp + ts + 2, s2);
                asm volatile("s_waitcnt vmcnt(4) lgkmcnt(0)\n\ts_barrier" ::: "memory");
                slot = (slot == 2) ? 0 : slot + 1;
            }
        }
#pragma unroll
        for (int i = 0; i < 16; ++i) { const float rf = __builtin_amdgcn_exp2f(U.lg * (float)(64 * U.c0 + 32 * rb + crow(i, hi) + 1));
#pragma unroll
            for (int d = 0; d < 4; ++d) o[d][i] *= rf; }
    }
    for (int t = 0; t < U.nt; ++t) {
        const int s2 = (slot >= 1) ? slot - 1 : 2;
        const bool more = (t + 2 < U.nt);
        if ((t >> 1) <= cw) {
            const LAS unsigned char* kb = lds + slot * SLOT + kfo;
            const unsigned vba = (unsigned)(size_t)(lds + slot * SLOT + KB + dq * 8192 + vfo);
            f32x16 p;
#pragma unroll
            for (int i = 0; i < 16; ++i) p[i] = 0.f;
            {   bf16x8 ka[2][4];
#define R3_LOADB(buf, b_) do { _Pragma("unroll") for (int j = 0; j < 4; ++j) ka[buf][j] = *(const LAS bf16x8*)(kb + (4 * (b_) + j) * 1024); } while (0)
                R3_LOADB(0, 0);
#pragma unroll
                for (int b_ = 0; b_ < 4; ++b_) {
                    if (b_ < 3) R3_LOADB((b_ + 1) & 1, b_ + 1);
                    __builtin_amdgcn_sched_barrier(0);
#pragma unroll
                    for (int j = 0; j < 4; ++j) p = __builtin_amdgcn_mfma_f32_32x32x16_bf16(ka[b_ & 1][j], qr[4 * b_ + j], p, 0, 0, 0);
                    __builtin_amdgcn_sched_barrier(0);
                }
#undef R3_LOADB
            }
            const float dqp = qpos - (float)(32 * t + 4 * hi);
            if ((t >> 1) < cw) {
                const float rowf = __builtin_amdgcn_exp2f(U.lg * dqp);
#pragma unroll
                for (int i = 0; i < 16; ++i) p[i] *= rowf * cf[i];
            } else {
#pragma unroll
                for (int i = 0; i < 16; ++i) { const float dd = dqp - (float)((i & 3) + 8 * (i >> 2)); p[i] *= __builtin_amdgcn_exp2f(U.lg * __builtin_fabsf(dd)); }
            }
            bf16x8 pw0, pw1;
            { u32x4 t0, t1;
              t0.x = cvt_pk_bf16(p[0], p[1]); t0.y = cvt_pk_bf16(p[2], p[3]); t0.z = cvt_pk_bf16(p[4], p[5]); t0.w = cvt_pk_bf16(p[6], p[7]);
              t1.x = cvt_pk_bf16(p[8], p[9]); t1.y = cvt_pk_bf16(p[10], p[11]); t1.z = cvt_pk_bf16(p[12], p[13]); t1.w = cvt_pk_bf16(p[14], p[15]);
              pw0 = __builtin_bit_cast(bf16x8, t0); pw1 = __builtin_bit_cast(bf16x8, t1); }
            {
                const LAS unsigned char* vbp = lds + slot * SLOT + KB + dq * 8192 + vfo;
#pragma unroll
                for (int dp = 0; dp < 2; ++dp)
#pragma unroll
                    for (int j = 0; j < 4; ++j) {
                        const s16x4 lo = ds_tr16(vbp + (dp * 4 + j) * 1024), hh = ds_tr16(vbp + (dp * 4 + j) * 1024 + 512);
                        const bf16x8 vf = (bf16x8){lo[0], lo[1], lo[2], lo[3], hh[0], hh[1], hh[2], hh[3]};
                        o[dp * 2 + (j >> 1)] = __builtin_amdgcn_mfma_f32_32x32x16_bf16((j & 1) ? pw1 : pw0, vf, o[dp * 2 + (j >> 1)], 0, 0, 0); }
            }
        }
        if (more) R3_DMA(t + 2, s2);
        if (more) asm volatile("s_waitcnt vmcnt(4) lgkmcnt(0)\n\ts_barrier" ::: "memory");
        else asm volatile("s_waitcnt vmcnt(0) lgkmcnt(0)\n\ts_barrier" ::: "memory");
        slot = (slot == 2) ? 0 : slot + 1;
    }
#undef R3_DMA
#undef R3_DMAS
#undef R3_ANY
    LAS float* wsf = (LAS float*)(lds + OFF_WS);
    float ssr[16];
#pragma unroll
    for (int i = 0; i < 16; ++i) { float s2v = 0.f;
#pragma unroll
        for (int d = 0; d < 4; ++d) s2v += o[d][i] * o[d][i];
        s2v = row32_sum(s2v);
        ssr[i] = s2v; if (r32 == 0) wsf[w * 32 + crow(i, hi)] = s2v; }
    FA_WAIT_BAR();
    if (dq == 0 && r32 == 0) {
#pragma unroll
        for (int i = 0; i < 16; ++i) { const int q = crow(i, hi); U.SS[(size_t)(32 * rb + q) * 8] = ssr[i] + wsf[(w ^ 1) * 32 + q]; } }
    { LAS unsigned char* stg = lds + w * 8192; const char* gb = (const char*)U.G + ((size_t)(32 * rb) * LDO + 128 * dq) * 2; char* obp = (char*)U.O + ((size_t)(32 * rb) * LDO + 128 * dq) * 2;
      u32x4 gq[8];
#pragma unroll
      for (int it = 0; it < 8; ++it) { const int c = it * 64 + l, row = c >> 4, ch = c & 15; gq[it] = *(const u32x4*)(gb + ((size_t)row * LDO + ch * 8) * 2); }
#pragma unroll
      for (int it = 0; it < 8; ++it) { const int c = it * 64 + l, row = c >> 4, ch = c & 15; *(LAS u32x4*)(stg + row * 256 + ch * 16) = gq[it]; }
      asm volatile("s_waitcnt lgkmcnt(0)" ::: "memory");
#pragma unroll
      for (int i = 0; i < 16; ++i) { const int q = crow(i, hi);
#pragma unroll
          for (int d = 0; d < 4; ++d) { LAS bf16_t* sp = (LAS bf16_t*)(stg + q * 256 + (32 * d + r32) * 2); const float gt = bf2f(*sp); *sp = f2bf(o[d][i] * (gt * fsigmoid(gt))); } }
      asm volatile("s_waitcnt lgkmcnt(0)" ::: "memory");
#pragma unroll
      for (int it = 0; it < 8; ++it) { const int c = it * 64 + l, row = c >> 4, ch = c & 15; *(u32x4*)(obp + ((size_t)row * LDO + ch * 8) * 2) = *(const LAS u32x4*)(stg + row * 256 + ch * 16); } }
    FA_WAIT_BAR();
}


struct StJob { const bf16_t* K; const bf16_t* V; bf16_t* ST; int nt; float lg; };
__device__ __forceinline__ void st_job(LAS unsigned char* lds, const StJob& J, int WV) {
    constexpr int LDK = 512, LDV = 1024, VB = 16384, SLOT = 49152;
    static_assert(2 * SLOT <= ATT_BYTES, "st LDS");
    int tid = TID_OF(WV); asm volatile("" : "+v"(tid));
    const int w = __builtin_amdgcn_readfirstlane(tid >> 6), l = tid & 63, r32 = l & 31, hi = l >> 5, wm = w >> 1, wn = w & 1;
    const unsigned vvo = (unsigned)((l >> 2) * LDV * 2 + (l & 3) * 16), kvo = (unsigned)((l >> 2) * LDK * 2 + (l & 3) * 16);
#define ST_DMA(t, slot) do { const char* vb_ = (const char*)J.V + (size_t)(t) * (64 * LDV * 2); const char* kb_ = (const char*)J.K + (size_t)(t) * (64 * LDK * 2); \
        unsigned vvo_ = vvo, kvo_ = kvo; asm volatile("" : "+v"(vvo_), "+v"(kvo_)); \
        _Pragma("unroll") for (int i_ = 0; i_ < 2; ++i_) { const int p_ = w + 8 * i_, blk_ = p_ >> 2, kg_ = p_ & 3; \
            __builtin_amdgcn_global_load_lds((const unsigned*)(vb_ + kg_ * (16 * LDV * 2) + 64 * blk_ + vvo_), (LAS unsigned*)(lds + (slot) * SLOT + p_ * 1024), 16, 0, 0); } \
        _Pragma("unroll") for (int i_ = 0; i_ < 4; ++i_) { const int p_ = w + 8 * i_, blk_ = p_ >> 2, kg_ = p_ & 3; \
            __builtin_amdgcn_global_load_lds((const unsigned*)(kb_ + kg_ * (16 * LDK * 2) + 64 * blk_ + kvo_), (LAS unsigned*)(lds + (slot) * SLOT + VB + p_ * 1024), 16, 0, 0); } \
    } while (0)
    ST_DMA(0, 0);
    f32x16 acc[4];
    { float z = 0.f; asm volatile("" : "+v"(z));
#pragma unroll
    for (int d = 0; d < 4; ++d)
#pragma unroll
        for (int i = 0; i < 16; ++i) acc[d][i] = z; }
    float gj[8], gs[4];
#pragma unroll
    for (int j = 0; j < 8; ++j) gj[j] = __builtin_amdgcn_exp2f(-J.lg * (float)(8 * (j >> 2) + (j & 3)));
#pragma unroll
    for (int sI = 0; sI < 4; ++sI) gs[sI] = __builtin_amdgcn_exp2f(J.lg * (float)(63 - 16 * sI - 4 * hi));
    const float g64 = __builtin_amdgcn_exp2f(J.lg * 64.0f);
    const int tfo = (4 * hi + ((l & 15) >> 2)) * 64 + ((l >> 4) & 1) * 32 + (l & 3) * 8;
    FA_WAIT_BAR();
    for (int t = 0; t < J.nt; ++t) {
        const int slot = t & 1;
        if (t + 1 < J.nt) ST_DMA(t + 1, slot ^ 1);
#pragma unroll
        for (int d = 0; d < 4; ++d)
#pragma unroll
            for (int i = 0; i < 16; ++i) acc[d][i] *= g64;
        const unsigned va = (unsigned)(size_t)(lds + slot * SLOT + wm * 4096 + tfo);
        const unsigned ka = (unsigned)(size_t)(lds + slot * SLOT + VB + wn * 16384 + tfo);
#pragma unroll
        for (int sI = 0; sI < 4; ++sI) {
            s16x4 vlo, vhh, klo[4], khh[4];
            asm volatile("ds_read_b64_tr_b16 %0, %10 offset:%c12\n\tds_read_b64_tr_b16 %1, %10 offset:%c13\n\t"
                         "ds_read_b64_tr_b16 %2, %11 offset:%c14\n\tds_read_b64_tr_b16 %3, %11 offset:%c15\n\t"
                         "ds_read_b64_tr_b16 %4, %11 offset:%c16\n\tds_read_b64_tr_b16 %5, %11 offset:%c17\n\t"
                         "ds_read_b64_tr_b16 %6, %11 offset:%c18\n\tds_read_b64_tr_b16 %7, %11 offset:%c19\n\t"
                         "ds_read_b64_tr_b16 %8, %11 offset:%c20\n\tds_read_b64_tr_b16 %9, %11 offset:%c21\n\ts_waitcnt lgkmcnt(0)"
                         : "=&v"(vlo), "=&v"(vhh), "=&v"(klo[0]), "=&v"(khh[0]), "=&v"(klo[1]), "=&v"(khh[1]), "=&v"(klo[2]), "=&v"(khh[2]), "=&v"(klo[3]), "=&v"(khh[3])
                         : "v"(va), "v"(ka), "i"(sI * 1024), "i"(sI * 1024 + 512),
                           "i"(0 * 4096 + sI * 1024), "i"(0 * 4096 + sI * 1024 + 512), "i"(1 * 4096 + sI * 1024), "i"(1 * 4096 + sI * 1024 + 512),
                           "i"(2 * 4096 + sI * 1024), "i"(2 * 4096 + sI * 1024 + 512), "i"(3 * 4096 + sI * 1024), "i"(3 * 4096 + sI * 1024 + 512) : "memory");
            __builtin_amdgcn_sched_barrier(0);
            float x[8];
#pragma unroll
            for (int j = 0; j < 4; ++j) { x[j] = bf2f((unsigned short)vlo[j]) * (gs[sI] * gj[j]); x[4 + j] = bf2f((unsigned short)vhh[j]) * (gs[sI] * gj[4 + j]); }
            u32x4 aw; aw.x = cvt_pk_bf16(x[0], x[1]); aw.y = cvt_pk_bf16(x[2], x[3]); aw.z = cvt_pk_bf16(x[4], x[5]); aw.w = cvt_pk_bf16(x[6], x[7]);
            const bf16x8 af = __builtin_bit_cast(bf16x8, aw);
#pragma unroll
            for (int d = 0; d < 4; ++d) { const bf16x8 kf = (bf16x8){klo[d][0], klo[d][1], klo[d][2], klo[d][3], khh[d][0], khh[d][1], khh[d][2], khh[d][3]};
                acc[d] = __builtin_amdgcn_mfma_f32_32x32x16_bf16(af, kf, acc[d], 0, 0, 0); }
        }
        FA_WAIT_BAR();
    }
#undef ST_DMA
    const int odd = l & 1;
    unsigned* op = (unsigned*)(J.ST + (size_t)(32 * wm) * 256 + 128 * wn + (r32 & ~1));
#pragma unroll
    for (int i = 0; i < 16; ++i) {
#pragma unroll
        for (int dp = 0; dp < 2; ++dp) {
            const float mine = odd ? acc[2 * dp + 1][i] : acc[2 * dp][i], give = odd ? acc[2 * dp][i] : acc[2 * dp + 1][i];
            const float got = dppf<0xB1>(give);
            const unsigned w2 = odd ? cvt_pk_bf16(got, mine) : cvt_pk_bf16(mine, got);
            __hip_atomic_store(op + ((size_t)crow(i, hi) * 256 + 32 * (2 * dp + odd)) / 2, w2, __ATOMIC_RELAXED, __HIP_MEMORY_SCOPE_AGENT);
        }
        __builtin_amdgcn_sched_barrier(0);
    }
    FA_WAIT_BAR();
}

__device__ __forceinline__ unsigned pk2(float lo, float hi) { return cvt_pk_bf16(lo, hi); }
__device__ __forceinline__ int win_src(int r) {
    if (r < 2048) {
        const int sec = r >> 10, rr = r & 1023, t = rr >> 8, p = rr & 255, bj = p >> 7, wc = (p >> 5) & 3, fq = (p >> 3) & 3, ne = p & 7;
        const int d = (fq == 0) ? (8 * bj + ne) : (16 * fq + 8 * bj + ne);
        return 6144 + sec * 1024 + t * 256 + 64 * wc + d; }
    if (r < 3072) return 8192 + (r - 2048);
    if (r < 4096) return 9216 + (r - 3072);
    if (r < 5120) return 10240 + 1024 + (r - 4096);
    if (r < 6144) return 10240 + 2048 + (r - 5120);
    if (r < 6656) return (r - 6144);
    if (r < 7168) return 1024 + (r - 6656);
    if (r < 8192) return 2048 + (r - 7168);
    if (r < 9216) return 4096 + (r - 8192);
    if (r < 9728) return 512 + (r - 9216);
    if (r < 10240) return 1536 + (r - 9728);
    if (r < 11264) return 3072 + (r - 10240);
    if (r < 12288) return 5120 + (r - 11264);
    return 10240 + (r - 12288);
}
__device__ __forceinline__ void p0_item(int kind, const float* W, const float* W2, int Nsrc, const float* scale, bf16_t* WT, int K, int Nout, LAS float* scr, int item, int lane) {
    const int nblk = Nout / 32, kb = item / nblk, nb = item % nblk, k0 = 64 * kb, n0 = 32 * nb;
    const int kr = lane >> 3, c4 = lane & 7, rr = n0 + 4 * c4; const float* src = W; int sc;
    if (kind == 0) sc = rr; else if (kind == 1) sc = win_src(rr); else { const int t = rr >> 8, p = rr & 255; if (p < 128) sc = 128 * t + p; else { sc = 128 * t + p - 128; src = W2; } }
    f32x4 v[8];
#pragma unroll
    for (int i = 0; i < 8; ++i) v[i] = *(const f32x4*)(src + (size_t)(k0 + 8 * i + kr) * Nsrc + sc);
#pragma unroll
    for (int i = 0; i < 8; ++i) { const int kk = 8 * i + kr; f32x4 x = v[i]; if (scale) x = x * scale[k0 + kk];
        scr[kk * 33 + 4 * c4 + 0] = x[0]; scr[kk * 33 + 4 * c4 + 1] = x[1]; scr[kk * 33 + 4 * c4 + 2] = x[2]; scr[kk * 33 + 4 * c4 + 3] = x[3]; }
    asm volatile("s_waitcnt lgkmcnt(0)" ::: "memory");
    const int c = lane & 7;
#pragma unroll
    for (int j = 0; j < 4; ++j) { const int n = (lane >> 3) + 8 * j; const LAS float* s = scr + (8 * c) * 33 + n;
        u32x4 o; o.x = pk2(s[0 * 33], s[1 * 33]); o.y = pk2(s[2 * 33], s[3 * 33]); o.z = pk2(s[4 * 33], s[5 * 33]); o.w = pk2(s[6 * 33], s[7 * 33]);
        *(u32x4*)(WT + (size_t)(n0 + n) * K + k0 + 8 * c) = o; }
    asm volatile("s_waitcnt lgkmcnt(0)" ::: "memory");
}

struct Args { InTab in; float* out; unsigned char* ws; int ph_lo, ph_hi; };

__global__ void __launch_bounds__(512, 2) mk_fwd(const Args args) {
    extern __shared__ __attribute__((aligned(16))) unsigned char lds_raw[];
    LAS unsigned char* lds = (LAS unsigned char*)lds_raw;
    volatile LAS unsigned* MISC = (volatile LAS unsigned*)(lds + MISC_OFF);
    const int tid0 = threadIdx.x;
    const int WV = __builtin_amdgcn_readfirstlane(tid0 >> 6);
    const int G = gridDim.x, bx = blockIdx.x; const int vcu = (G % 8 == 0) ? (bx % 8) * (G / 8) + bx / 8 : bx;
    Ctx cx;
    cx.in.tab = (const __attribute__((address_space(4))) InTab*)__builtin_amdgcn_kernarg_segment_ptr();
    cx.out = args.out; cx.ws = args.ws;
    for (int u = tid0; u < (LDS_BYTES - MISC_OFF) / 4; u += 512) ((LAS unsigned*)(lds + MISC_OFF))[u] = 0u;
    __syncthreads();
    unsigned* ctl = WSP(unsigned, WS_CTL);
    XcdBarrier bar; bar.bar = ctl + 4096; bar.x = 0; bar.st = nullptr;
    const bool multi = (args.ph_hi - args.ph_lo) > 1;
    if (multi) bar = xcd_barrier_post(ctl + 4096, MISC + 8, tid0 == 0);
    const int NGW = G * 8;

#define PHASE_IDS const int lane = lane_id(), wave = WV, tid = wave * 64 + lane, gw = vcu * 8 + wave; (void)tid; (void)gw
    if (args.ph_lo <= PH_PRO && PH_PRO < args.ph_hi) { PHASE_IDS;
            LAS float* scr = (LAS float*)(lds + wave * 16384);
            int base = 0;
#define RUNJOB(kind, W, W2, Nsrc, scale, dst, K_, Nout) do { const int nit = ((K_) / 64) * ((Nout) / 32); const int first = (gw - (base % NGW) + NGW) % NGW; \
                for (int itx = first; itx < nit; itx += NGW) p0_item(kind, W, W2, Nsrc, scale, WSP(bf16_t, dst), K_, Nout, scr, itx, lane); base += nit; } while (0)
            RUNJOB(1, CX_F(8), nullptr, DIN, CX_F(7), WS_WIN, 1024, DIN);
            RUNJOB(2, CX_F(4), CX_F(5), DFF, CX_F(3), WS_W1GU, 1024, 2 * DFF);
            RUNJOB(0, CX_F(6), nullptr, D, nullptr, WS_W1D, DFF, D);
            RUNJOB(2, CX_F(26), CX_F(27), DFF, CX_F(25), WS_W2GU, 1024, 2 * DFF);
            RUNJOB(0, CX_F(28), nullptr, D, nullptr, WS_W2D, DFF, D);
            RUNJOB(0, CX_F(10), nullptr, D, nullptr, WS_WRO, 512, D);
            RUNJOB(0, CX_F(10) + (size_t)512 * 1024, nullptr, D, nullptr, WS_WRO + (size_t)1 * 1024 * 512 * 2, 512, D);
            RUNJOB(0, CX_F(10) + (size_t)1024 * 1024, nullptr, D, nullptr, WS_WRO + (size_t)2 * 1024 * 512 * 2, 512, D);
            RUNJOB(0, CX_F(10) + (size_t)1536 * 1024, nullptr, D, nullptr, WS_WRO + (size_t)3 * 1024 * 512 * 2, 512, D);
            RUNJOB(0, CX_F(18), nullptr, D, nullptr, WS_WDO, 1024, D);
            RUNJOB(0, CX_F(23), nullptr, D, nullptr, WS_WMO, 1024, D);
            RUNJOB(0, CX_F(24), nullptr, D, nullptr, WS_WOUT, 1024, D);
            RUNJOB(0, CX_F(20), nullptr, 2048, nullptr, WS_WMKV, 1024, 2048);
#undef RUNJOB
            float* part0 = WSP(float, WS_PART); bf16_t* XB = WSP(bf16_t, WS_XB);
            for (int m = gw; m < T; m += NGW) {
                const f32x4* xr = (const f32x4*)(CX_F(0) + (size_t)m * D) + lane; float s = 0.f; unsigned long long* o8 = (unsigned long long*)(XB + (size_t)m * D) + lane;
#pragma unroll
                for (int j = 0; j < 4; ++j) { const f32x4 v = xr[64 * j]; s += (v[0] * v[0] + v[1] * v[1]) + (v[2] * v[2] + v[3] * v[3]);
                    o8[64 * j] = (unsigned long long)pk2(v[0], v[1]) | ((unsigned long long)pk2(v[2], v[3]) << 32); }
                s = wave_sum(s);
                if (lane < 16) part0[(size_t)m * 16 + lane] = (lane == 0) ? s : 0.f;
            }
            bf16_t* MN = WSP(bf16_t, WS_MEMN);
            for (int m = gw; m < TM; m += NGW) {
                const f32x4* xr = (const f32x4*)(CX_F(1) + (size_t)m * D) + lane; const f32x4* wr_ = (const f32x4*)CX_F(19) + lane; f32x4 v[4]; float s = 0.f;
#pragma unroll
                for (int j = 0; j < 4; ++j) { v[j] = xr[64 * j]; s += (v[j][0] * v[j][0] + v[j][1] * v[j][1]) + (v[j][2] * v[j][2] + v[j][3] * v[j][3]); }
                const float ri = rsqrtf(wave_sum(s) * (1.0f / D) + EPS); unsigned long long* o8 = (unsigned long long*)(MN + (size_t)m * D) + lane;
#pragma unroll
                for (int j = 0; j < 4; ++j) { const f32x4 wv = wr_[64 * j]; const f32x4 y = v[j] * ri * wv;
                    o8[64 * j] = (unsigned long long)pk2(y[0], y[1]) | ((unsigned long long)pk2(y[2], y[3]) << 32); }
            }
            float* rope = WSP(float, WS_DROPE); const int* pos = (const int*)CX_F(2);
            for (int e = gw * 64 + lane; e < T * 8; e += NGW * 64) { const int m = e >> 3, i = e & 7;
                const float inv = 1.0f / powf(500000.0f, (float)(2 * i) / 16.0f); const float ang = (float)pos[m] * inv; const float sn = sinf(ang), cs = cosf(ang);
                rope[(size_t)e * 2] = cs; rope[(size_t)e * 2 + 1] = sn; }
            if (bx == 0 && tid < 128) { const float tt = (float)tid / 127.0f; WSP(float, WS_RINV)[tid] = 1.0f / powf(10000.0f, tt); }
        if (multi) xcd_barrier(bar, WV == 0 && lane_id() == 0);
    }
#ifndef PHASE_SEQ
#define PHASE_SEQ 1,2,3,4,5,6,8,9,11,12,13,14,15
#endif
    constexpr int seq_[] = {PHASE_SEQ}; constexpr int nseq = sizeof(seq_) / sizeof(int);
    for (int si = 0; si < nseq; ++si) {
        int ph = 0;
#pragma unroll
        for (int k = 0; k < nseq; ++k) ph = (si == k) ? seq_[k] : ph;
        if (ph < args.ph_lo || ph >= args.ph_hi) continue;
        switch (ph) {
        case PH_F1GU: case PH_F1D: case PH_IN_DM: case PH_MG1: case PH_IN_R0: case PH_IN_R1: case PH_MG2: case PH_WOUT: case PH_F2GU: case PH_F2D: {
#ifndef NO_GEMM
            GemmSched S; S.ph = ph; S.c = bx; S.G = G; S.cxp = &cx;
            gemm_phase(lds, S, cx, WV);
#endif
        } break;
        case PH_ATT_DM: { PHASE_IDS;
            float lam, mcd;
            { float a = CX_F(13)[lane] * CX_F(14)[lane], b = CX_F(15)[lane] * CX_F(16)[lane], mq_ = fabsf(CX_F(11)[lane]), mk_ = fabsf(CX_F(12)[lane]);
              a = wave_sum(a); b = wave_sum(b); mq_ = wave_max(mq_); mk_ = wave_max(mk_);
              lam = uni(expf(a) - expf(b) + 0.2f); mcd = uni(8.0f * mq_ * mk_ * LOG2E); }
            bf16_t* DQ = WSP(bf16_t, WS_DQ); const bf16_t* DK = WSP(bf16_t, WS_DK); const bf16_t* DV_ = WSP(bf16_t, WS_DV);
            for (int id = vcu; id < 256; id += G) {
                const int bh = id >> 2, p = id & 3, b = bh >> 3, h = bh & 7;
#pragma unroll 1
                for (int half = 0; half < 2; ++half) { const int qb = half ? 7 - p : p;
                    FaUnit U; const size_t r0 = (size_t)b * SEQ + qb * 256;
                    U.Q = DQ + r0 * 1024 + h * 128; U.ldq = 1024; U.K = DK + (size_t)b * SEQ * 1024 + h * 128; U.ldk = 1024; U.V = DV_ + (size_t)b * SEQ * 1024 + h * 128; U.ldv = 1024;
                    U.O = DQ + r0 * 1024 + h * 128; U.ldo = 1024; U.nt = 4 * qb + 4; U.vis0 = 4 * qb; U.c = 0.125f * LOG2E; U.mc = mcd; U.lam = lam;
#ifndef NO_FADIFF
                    fa_unit<2, 64, 4, 1, 1, true>(lds, U, cx, WV);
#endif
                }
            }
            float mcm;
            { const int ln = lane_id(); float nq = 0.f, nk = 0.f;
#pragma unroll
              for (int j = 0; j < 4; ++j) { nq = fmaxf(nq, fabsf(CX_F(21)[ln + 64 * j])); nk = fmaxf(nk, fabsf(CX_F(22)[ln + 64 * j])); }
              nq = wave_max(nq); nk = wave_max(nk); mcm = uni(16.0f * nq * nk * LOG2E); }
            bf16_t* MQ = WSP(bf16_t, WS_MQ); const bf16_t* MK = WSP(bf16_t, WS_MK); const bf16_t* MV = WSP(bf16_t, WS_MV);
            for (int id = vcu; id < 256; id += G) {
                const int bh = id >> 3, qb = id & 7, b = bh >> 2, h = bh & 3;
                { FaUnit U; const size_t r0 = (size_t)b * SEQ + qb * 256;
                    U.Q = MQ + r0 * 1024 + h * 256; U.ldq = 1024; U.K = MK + (size_t)b * MEML * 1024 + h * 256; U.ldk = 1024; U.V = MV + (size_t)b * MEML * 1024 + h * 256; U.ldv = 1024;
                    U.O = MQ + r0 * 1024 + h * 256; U.ldo = 1024; U.nt = 4; U.vis0 = 4; U.c = 0.0625f * LOG2E; U.mc = mcm; U.lam = 0.f;
#ifndef NO_FAMEM
                    fa_unit<1, 256, 4, 2, 2, false>(lds, U, cx, WV);
#endif
                }
            }
        } break;
        case PH_ATT_R0: case PH_ATT_R1: {
            const int hg = (ph == PH_ATT_R1);
            const bf16_t* RQ = WSP(bf16_t, WS_RQ); const bf16_t* RK = WSP(bf16_t, WS_RK); const bf16_t* RV = WSP(bf16_t, WS_RV); bf16_t* RG = WSP(bf16_t, hg ? WS_RG1 : WS_RG0);
#ifndef RET_V0
            unsigned* stc = WSP(unsigned, WS_CTL) + 12288 + hg * 512;
            for (int id = vcu; id < 192; id += G) {
                const int bh = id / 12, r = id - 12 * bh, up = r >> 2, dvq = r & 3, b = bh >> 1, hl = bh & 1, h = 2 * hg + hl;
                StJob J; J.K = RK + ((size_t)b * SEQ + 512 * up) * 512 + hl * 256; J.V = RV + ((size_t)b * SEQ + 512 * up) * 1024 + hl * 512 + dvq * 128;
                J.ST = WSP(bf16_t, WS_ST) + ((size_t)(bh * 3 + up) * 512 + dvq * 128) * 256; J.nt = 8; J.lg = log2f(1.0f - exp2f(-5.0f - (float)h));
                st_job(lds, J, WV);
                if (WV == 0 && lane_id() == 0) __hip_atomic_fetch_add(stc + bh * 16, 1u, __ATOMIC_RELAXED, __HIP_MEMORY_SCOPE_AGENT);
            }
            for (int id = vcu; id < 256; id += G) {
                int bh, sc, pr, dvh;
                if (id >= 192) { const int j = id - 192; bh = j >> 2; sc = 0; pr = (j >> 1) & 1; dvh = j & 1; }
                else { bh = id / 12; const int r = id - 12 * bh; sc = 1 + (r >> 2); pr = (r >> 1) & 1; dvh = r & 1; }
                const int b = bh >> 1, hl = bh & 1, h = 2 * hg + hl;
                const float lg = log2f(1.0f - exp2f(-5.0f - (float)h));
                if (sc > 0) {
                    if (WV == 0) { unsigned sp = 0;
                        while ((unsigned)__builtin_amdgcn_readfirstlane(__hip_atomic_load(stc + bh * 16, __ATOMIC_RELAXED, __HIP_MEMORY_SCOPE_AGENT)) < 12u) { __builtin_amdgcn_s_sleep(2); if (++sp > (1u << 22)) break; }
                        __builtin_amdgcn_fence(__ATOMIC_ACQUIRE, "agent");
                        asm volatile("s_waitcnt vmcnt(0)" ::: "memory"); }
                    asm volatile("s_waitcnt vmcnt(0) lgkmcnt(0)\n\ts_barrier" ::: "memory");
                }
#pragma unroll 1
                for (int half = 0; half < 2; ++half) { const int v = half ? 3 - pr : pr, u = 4 * sc + v;
                    Ret3Unit U; const size_t r0 = (size_t)b * SEQ + u * 128, k0 = (size_t)b * SEQ + sc * 512;
                    U.Q = RQ + r0 * 512 + hl * 256; U.K = RK + k0 * 512 + hl * 256; U.V = RV + k0 * 1024 + hl * 512 + dvh * 256;
                    U.G = RG + r0 * 1024 + hl * 512 + dvh * 256; U.O = RG + r0 * 1024 + hl * 512 + dvh * 256; U.SS = WSP(float, WS_RSS) + r0 * 8 + h * 2 + dvh;
                    U.ST = WSP(bf16_t, WS_ST) + ((size_t)(bh * 3) * 512 + dvh * 256) * 256;
                    U.nst = 4 * sc; U.nt = 2 * (2 * v + 2); U.c0 = 2 * v; U.lg = lg;
                    fa_ret3_unit(lds, U, WV); }
            }
#else
            for (int id = vcu; id < 256; id += G) {
                const int bh = id >> 4, p = id & 15, b = bh >> 1, hl = bh & 1, h = 2 * hg + hl;
                const float lg = log2f(1.0f - exp2f(-5.0f - (float)h));
#pragma unroll 1
                for (int half = 0; half < 2; ++half) { const int n = half ? 31 - p : p;
                    AttItem it; const size_t r0 = (size_t)b * SEQ + n * 64;
                    it.Q = RQ + r0 * 512 + hl * 256; it.ldq = 512; it.K = RK + (size_t)b * SEQ * 512 + hl * 256; it.ldk = 512; it.V = RV + (size_t)b * SEQ * 1024 + hl * 512; it.ldv = 1024;
                    it.G = RG + r0 * 1024 + hl * 512; it.O = RG + r0 * 1024 + hl * 512; it.ldo = 1024; it.nt = n + 1; it.q0 = n * 64; it.p0 = lg; it.p1 = 0.f; it.p2 = 0.f;
                    attn_item<1, 256, 512, 0>(lds, it, cx, WV); }
            }
#endif
        } break;
        default: break;
        }
        if (multi && si + 1 < nseq) xcd_barrier(bar, WV == 0 && lane_id() == 0);
    }
    if (false) { PHASE_IDS;
            const float* part3 = WSP(float, WS_PART) + (size_t)3 * T * 16;
            for (int m = gw; m < T; m += NGW) {
                const float ri = row_rinv(part3, m); f32x4* xr = (f32x4*)(cx.out + (size_t)m * D) + lane; const f32x4* wr_ = (const f32x4*)CX_F(29) + lane;
#pragma unroll
                for (int j = 0; j < 4; ++j) { const f32x4 v = xr[64 * j]; xr[64 * j] = v * ri * wr_[64 * j]; }
            }
    }
}

extern "C" void kernel_launch(void* const* d_in, const int* in_sizes, int n_in, void* d_out, int out_size, void* d_ws, size_t ws_size, hipStream_t stream) {
    static int grid = 0;
    if (grid == 0) {
        if (n_in != 30 || out_size != T * D || ws_size < WS_END) { fprintf(stderr, "kernel_launch: unexpected shapes (n_in %d out %d ws %zu)\n", n_in, out_size, ws_size); grid = -1; return; }
        int dev = 0, cus = 0, per_cu = 0;
        if (hipGetDevice(&dev) != hipSuccess || hipDeviceGetAttribute(&cus, hipDeviceAttributeMultiprocessorCount, dev) != hipSuccess) { grid = -1; return; }
        if (hipFuncSetAttribute((const void*)mk_fwd, hipFuncAttributeMaxDynamicSharedMemorySize, LDS_BYTES) != hipSuccess) { fprintf(stderr, "kernel_launch: hipFuncSetAttribute failed\n"); grid = -1; return; }
        if (hipOccupancyMaxActiveBlocksPerMultiprocessor(&per_cu, (const void*)mk_fwd, 512, LDS_BYTES) != hipSuccess || per_cu < 1) { fprintf(stderr, "kernel_launch: occupancy query says %d\n", per_cu); }
        (void)hipGetLastError();
        grid = cus;
    }
    if (grid < 0) return;
    (void)hipMemsetAsync((char*)d_ws + WS_CTL, 0, CTL_ZERO_BYTES, stream);
    Args a{};
    for (int i = 0; i < 30; ++i) a.in.p[i] = (const float*)d_in[i];
    a.out = (float*)d_out; a.ws = (unsigned char*)d_ws;
#if MK_N_LAUNCHES == 1
    a.ph_lo = 0; a.ph_hi = PH_COUNT;
    hipLaunchKernelGGL(mk_fwd, dim3(grid), dim3(512), LDS_BYTES, stream, a);
#else
    for (int ph = 0; ph < PH_COUNT; ++ph) { a.ph_lo = ph; a.ph_hi = ph + 1; hipLaunchKernelGGL(mk_fwd, dim3(grid), dim3(512), LDS_BYTES, stream, a); }
#endif
}
```

```cpp
#include <hip/hip_runtime.h>
#include <cstdio>
#include <cstdint>

#ifndef MK_N_LAUNCHES
#define MK_N_LAUNCHES 1
#endif

#define LAS __attribute__((address_space(3)))
#define GAS __attribute__((address_space(1)))
typedef unsigned short bf16_t;
typedef short bf16x8 __attribute__((ext_vector_type(8)));
typedef short s16x4 __attribute__((ext_vector_type(4)));
typedef float f32x4 __attribute__((ext_vector_type(4)));
typedef float f32x2 __attribute__((ext_vector_type(2)));
typedef unsigned u32x4 __attribute__((ext_vector_type(4)));
typedef unsigned u32x2 __attribute__((ext_vector_type(2)));

constexpr int D = 1024, NB = 8, SEQ = 2048, T = NB * SEQ, DFF = 2816, MEML = 256, TM = NB * MEML;
constexpr int DIN = 13312;
constexpr float EPS = 1e-6f;
constexpr float LOG2E = 1.4426950408889634f;

constexpr size_t MiB = 1u << 20;
constexpr size_t HALFMiB = 1u << 19;
constexpr size_t WS_WIN = 0;
constexpr size_t WS_W2GU = 26 * MiB;
constexpr size_t WS_W2D = 37 * MiB;
constexpr size_t WS_WDO = 42 * MiB + HALFMiB;
constexpr size_t WS_WMO = 44 * MiB + HALFMiB;
constexpr size_t WS_WOUT = 46 * MiB + HALFMiB;
constexpr size_t WS_WRO = 48 * MiB + HALFMiB;
constexpr size_t WS_WMKV = 52 * MiB + HALFMiB;
constexpr size_t WS_XB = 56 * MiB + HALFMiB;
constexpr size_t WS_W1GU = 88 * MiB + HALFMiB;
constexpr size_t WS_W1D = 99 * MiB + HALFMiB;
constexpr size_t WS_ACT = 105 * MiB;
constexpr size_t WS_MEMN = 236 * MiB;
constexpr size_t WS_MK = 240 * MiB;
constexpr size_t WS_MV = 244 * MiB;
constexpr size_t WS_DQ = 88 * MiB + HALFMiB;
constexpr size_t WS_DK = 120 * MiB + HALFMiB;
constexpr size_t WS_DV = 152 * MiB + HALFMiB;
constexpr size_t WS_MQ = 184 * MiB + HALFMiB;
constexpr size_t WS_SG = WS_DK;
constexpr size_t WS_M = WS_DV;
constexpr size_t WS_RQ = 88 * MiB + HALFMiB;
constexpr size_t WS_RK = 104 * MiB + HALFMiB;
constexpr size_t WS_RV = 120 * MiB + HALFMiB;
constexpr size_t WS_RG0 = 184 * MiB + HALFMiB;
constexpr size_t WS_RG1 = 216 * MiB + HALFMiB;
constexpr size_t WS_SG2 = 88 * MiB + HALFMiB;
constexpr size_t WS_ST = 0;
constexpr size_t WS_SGB = 216 * MiB + HALFMiB;
constexpr size_t WS_PART = 250 * MiB;
constexpr size_t WS_DROPE = 254 * MiB;
constexpr size_t WS_CTL = 255 * MiB;
constexpr size_t CTL_ZERO_BYTES = 64 * 1024;
constexpr size_t WS_RINV = 255 * MiB + 768 * 1024;
constexpr size_t WS_RSS = 255 * MiB + 128 * 1024;
constexpr size_t WS_END = 256 * MiB;

constexpr int RING_BYTES = 131072;
constexpr int ATT_BYTES = 157696;
constexpr int EPI_OFF = 131072;
constexpr int MISC_OFF = ATT_BYTES;
constexpr int LDS_BYTES = ATT_BYTES + 512;

#define RLX_AGENT __ATOMIC_RELAXED, __HIP_MEMORY_SCOPE_AGENT
typedef __bf16 bf16x2_t __attribute__((ext_vector_type(2)));
__device__ __forceinline__ unsigned cvt_pk_bf16(float lo, float hi) { f32x2 v = {lo, hi}; bf16x2_t b = __builtin_convertvector(v, bf16x2_t); return __builtin_bit_cast(unsigned, b); }
__device__ __forceinline__ float bf2f(unsigned short b) { return __uint_as_float((unsigned)b << 16); }
__device__ __forceinline__ float bflo(unsigned w) { return __uint_as_float(w << 16); }
__device__ __forceinline__ float bfhi(unsigned w) { return __uint_as_float(w & 0xffff0000u); }
__device__ __forceinline__ unsigned short f2bf(float f) { return (unsigned short)(cvt_pk_bf16(f, 0.f) & 0xffffu); }
__device__ __forceinline__ int lane_id() { int r; asm volatile("v_mbcnt_lo_u32_b32 %0, -1, 0\n\tv_mbcnt_hi_u32_b32 %0, -1, %0" : "=v"(r)); return r; }
#define TID_OF(wv) ((wv) * 64 + lane_id())

template <int K> __device__ __forceinline__ float xor_f(float v) {
    if (K == 32) { auto r = __builtin_amdgcn_permlane32_swap(__float_as_uint(v), __float_as_uint(v), false, false); return (lane_id() & 32) ? __uint_as_float(r[0]) : __uint_as_float(r[1]); }
    return __int_as_float(__builtin_amdgcn_ds_swizzle(__float_as_int(v), 0x1F | (K << 10)));
}
__device__ __forceinline__ float sum_xor32(float v) { auto r = __builtin_amdgcn_permlane32_swap(__float_as_uint(v), __float_as_uint(v), false, false); return __uint_as_float(r[0]) + __uint_as_float(r[1]); }
template <int CTRL> __device__ __forceinline__ float dppf(float v) { return __int_as_float(__builtin_amdgcn_update_dpp(0, __float_as_int(v), CTRL, 0xF, 0xF, true)); }
__device__ __forceinline__ float row32_sum(float v) {
    v += dppf<0xB1>(v); v += dppf<0x4E>(v); v += dppf<0x141>(v); v += dppf<0x140>(v);
    auto r = __builtin_amdgcn_permlane16_swap(__float_as_uint(v), __float_as_uint(v), false, false);
    return __uint_as_float(r[0]) + __uint_as_float(r[1]);
}
__device__ __forceinline__ float wave_sum(float v) {
    v += xor_f<1>(v); v += xor_f<2>(v); v += xor_f<4>(v); v += xor_f<8>(v); v += xor_f<16>(v);
    return sum_xor32(v);
}
__device__ __forceinline__ float wave_max(float v) {
    v = fmaxf(v, xor_f<1>(v)); v = fmaxf(v, xor_f<2>(v)); v = fmaxf(v, xor_f<4>(v)); v = fmaxf(v, xor_f<8>(v)); v = fmaxf(v, xor_f<16>(v));
    auto r = __builtin_amdgcn_permlane32_swap(__float_as_uint(v), __float_as_uint(v), false, false); return fmaxf(__uint_as_float(r[0]), __uint_as_float(r[1]));
}
__device__ __forceinline__ float uni(float v) { return __uint_as_float(__builtin_amdgcn_readfirstlane(__float_as_uint(v))); }

#define XB_TMO      128
#define XB_XCNT(j)  (256  + 64 * (j))
#define XB_XSUB(j)  (1280 + 64 * (j))
#define XB_XGEN(j)  (2304 + 64 * (j))
#define XB_TOP      3328
#define XB_TOPGEN   3392
#define XCD_BAR_WORDS 3456
#define XB_SPIN_CAP (1u << 22)
__device__ __forceinline__ unsigned xb_ld(unsigned* p)              { return __hip_atomic_load(p, __ATOMIC_RELAXED, __HIP_MEMORY_SCOPE_AGENT); }
__device__ __forceinline__ unsigned xb_add(unsigned* p, unsigned v) { return __hip_atomic_fetch_add(p, v, __ATOMIC_RELAXED, __HIP_MEMORY_SCOPE_AGENT); }
__device__ __forceinline__ unsigned xb_xcc_id() { return (unsigned)__builtin_amdgcn_s_getreg((3 << 11) | 20) & 0xFu; }
#define XB_SPIN(cond, bar) do { unsigned _sp = 0; while (cond) { __builtin_amdgcn_s_sleep(1); \
    if ((++_sp & 255u) == 0u) { if (xb_ld(&(bar)[XB_TMO])) break; if (_sp > XB_SPIN_CAP) { atomicAdd(&(bar)[XB_TMO], 1u); break; } } } } while (0)
struct XcdBarrier { unsigned* bar; unsigned x; volatile LAS unsigned* st; };
__device__ __forceinline__ XcdBarrier xcd_barrier_post(unsigned* bar, volatile LAS unsigned* st, bool t0) {
    XcdBarrier b; b.bar = bar; b.x = xb_xcc_id(); b.st = st;
    if (t0) (void)xb_add(&bar[XB_XCNT(b.x)], 1u);
    return b;
}
__device__ __forceinline__ void xcd_barrier_complete(unsigned* bar, unsigned x, unsigned& nloc, unsigned& nx) {
    const unsigned G = gridDim.x * gridDim.y * gridDim.z;
    unsigned sum, cnt, mine, sp = 0u;
    for (;;) {
        sum = 0u; cnt = 0u; mine = 0u;
#pragma unroll
        for (unsigned j = 0; j < 16; ++j) { const unsigned c = xb_ld(&bar[XB_XCNT(j)]); sum += c; cnt += (c > 0u) ? 1u : 0u; mine = (j == x) ? c : mine; }
        if (sum == G) break;
        __builtin_amdgcn_s_sleep(1);
        if ((++sp & 255u) == 0u) { if (xb_ld(&bar[XB_TMO])) break; if (sp > XB_SPIN_CAP) { atomicAdd(&bar[XB_TMO], 1u); break; } }
    }
    nloc = mine > 0u ? mine : 1u; nx = cnt > 0u ? cnt : 1u;
}
__device__ __forceinline__ void xcd_barrier(const XcdBarrier& b, bool t0) {
    asm volatile("s_waitcnt vmcnt(0)" ::: "memory");
    __syncthreads();
    if (t0) {
        unsigned* bar = b.bar;
        __builtin_amdgcn_s_waitcnt(0);
        unsigned nloc = b.st[0], nx = b.st[1];
        if (nloc == 0u) { xcd_barrier_complete(bar, b.x, nloc, nx); b.st[0] = nloc; b.st[1] = nx; }
        const unsigned old = xb_add(&bar[XB_XSUB(b.x)], 1u);
        const unsigned gen = old / nloc;
        if (old + 1u == (gen + 1u) * nloc) {
            __builtin_amdgcn_fence(__ATOMIC_RELEASE, "agent");
            asm volatile("s_waitcnt vmcnt(0)" ::: "memory");
            const unsigned og = xb_add(&bar[XB_TOP], 1u);
            const unsigned tg = og / nx;
            if (og + 1u == (tg + 1u) * nx) xb_add(&bar[XB_TOPGEN], 1u);
            else XB_SPIN(xb_ld(&bar[XB_TOPGEN]) == tg, bar);
            __builtin_amdgcn_fence(__ATOMIC_ACQUIRE, "agent");
            xb_add(&bar[XB_XGEN(b.x)], 1u);
            asm volatile("s_waitcnt vmcnt(0)" ::: "memory");
        } else {
            XB_SPIN(xb_ld(&bar[XB_XGEN(b.x)]) == gen, bar);
            __builtin_amdgcn_fence(__ATOMIC_ACQUIRE, "agent");
            asm volatile("s_waitcnt vmcnt(0)" ::: "memory");
        }
    }
    __syncthreads();
}

struct InTab { const float* p[30]; };
struct CtxIn {
    const __attribute__((address_space(4))) InTab* tab;
    __device__ __forceinline__ const float* operator[](int i) const { typedef const float* cfp; return *(volatile const __attribute__((address_space(4))) cfp*)&tab->p[i]; }
};
struct Ctx {
    CtxIn in;
    float* out;
    unsigned char* ws;
};
#define CX_F(i) (cx.in[i])
#define WSP(T_, off) ((T_*)(cx.ws + (off)))

namespace pg8 {
constexpr int BM = 256, BK = 64, HALF = 128, HTB = HALF * BK * 2, STAGE_BYTES = 8 * HTB, NXCD = 8, WGM = 8;
__device__ __forceinline__ int lds_byte(int r, int c) { const int st = (r >> 4) * 2 + (c >> 5), rr = r & 15, cc = c & 31, ob = rr * 64 + cc * 2; return st * 1024 + (ob ^ (((ob >> 9) & 1) << 5)); }
__device__ __forceinline__ void stage_rc(int b, int& R, int& C) { const int st = b / 1024, sb = b % 1024, swz = sb ^ (((sb >> 9) & 1) << 5); R = (st >> 1) * 16 + swz / 64; C = (st & 1) * 32 + (swz % 64) / 2; }
__device__ __forceinline__ int perm32(int rho) { const int n = rho >> 4, i = rho & 15; return 8 * (i >> 2) + 4 * n + (i & 3); }
__device__ __forceinline__ void tile_of(int L, int nM, int nN, int& pm, int& pn) {
    const int nwg = nM * nN; int wgid = L;
    { const int q = nwg / NXCD, r = nwg % NXCD, xcd = wgid % NXCD, off = wgid / NXCD; wgid = (xcd < r ? xcd * (q + 1) : r * (q + 1) + (xcd - r) * q) + off; }
    const int nig = WGM * nN, gid = wgid / nig, fm = gid * WGM, gsz = (nM - fm) < WGM ? (nM - fm) : WGM;
    pm = fm + ((wgid % nig) % gsz); pn = (wgid % nig) / gsz;
}
}

enum { EP_GU = 0, EP_MK, EP_MV, EP_RES, EP_DQK, EP_PLAIN, EP_MQ, EP_ROT, EP_SG, EP_PM, EP_RSC };
struct Unit { const bf16_t* A; const bf16_t* Bt; int K, lda; int pm, pn; int epi, aux, po; int kjt; long kjump; int rs; };

enum { PH_PRO = 0, PH_F1GU, PH_F1D, PH_IN_DM, PH_ATT_DM, PH_MG1, PH_IN_R0, PH_ST0, PH_ATT_R0, PH_IN_R1, PH_ST1, PH_ATT_R1,
       PH_MG2, PH_WOUT, PH_F2GU, PH_F2D, PH_FIN, PH_COUNT };

struct GemmSched {
    int ph, c, G;
    const Ctx* cxp;
    __device__ __forceinline__ bool next(int i, Unit& u) const { u.lda = 0; const bool ok = next_(i, u); if (u.lda == 0) u.lda = u.K; return ok; }
    __device__ __forceinline__ bool next_(int i, Unit& u) const {
        const Ctx& cx = *cxp;
        const int L = i * G + c;
        u.kjt = 1 << 30; u.kjump = 0; u.rs = 0;
        switch (ph) {
        case PH_F1GU: case PH_F2GU: {
            const int f2 = (ph == PH_F2GU);
            if (L < 64 * 22) { pg8::tile_of(L, 64, 22, u.pm, u.pn); u.A = WSP(bf16_t, WS_XB); u.Bt = WSP(bf16_t, f2 ? WS_W2GU : WS_W1GU); u.K = 1024; u.epi = EP_GU; u.aux = f2; u.po = u.pn; return true; }
            if (f2) return false;
            const int j = L - 64 * 22; if (j >= 64) return false;
            pg8::tile_of(j, 8, 8, u.pm, u.pn); u.A = WSP(bf16_t, WS_MEMN); u.Bt = WSP(bf16_t, WS_WMKV); u.K = 1024;
            if (u.pn < 4) { u.epi = EP_MK; u.po = u.pn; } else { u.epi = EP_MV; u.po = u.pn - 4; }
            u.aux = 0; return true; }
        case PH_F1D: case PH_F2D: {
            if (L >= 256) return false; pg8::tile_of(L, 64, 4, u.pm, u.pn);
            u.A = WSP(bf16_t, WS_ACT); u.Bt = WSP(bf16_t, ph == PH_F1D ? WS_W1D : WS_W2D); u.K = DFF; u.epi = EP_RES; u.aux = (ph == PH_F1D) ? 0 : 2; u.po = u.pn; return true; }
        case PH_IN_DM: {
            if (L >= 64 * 16) return false; pg8::tile_of(L, 64, 16, u.pm, u.pn);
            u.A = WSP(bf16_t, WS_XB); u.Bt = WSP(bf16_t, WS_WIN); u.K = 1024;
            const int s = u.pn >> 2; u.po = u.pn & 3;
            if (s == 0) { u.epi = EP_DQK; u.aux = 0; } else if (s == 1) { u.epi = EP_DQK; u.aux = 1; } else if (s == 2) { u.epi = EP_PLAIN; u.aux = 0; } else { u.epi = EP_MQ; u.aux = 0; }
            return true; }
        case PH_MG1: {
            const int kind = i & 3, tl = c + G * (i >> 2); if (tl >= 256) return false; pg8::tile_of(tl, 64, 4, u.pm, u.pn); u.K = 1024; u.po = u.pn;
            if (kind == 0) { u.A = WSP(bf16_t, WS_XB); u.Bt = WSP(bf16_t, WS_WIN); u.pn += 16; u.epi = EP_SG; u.aux = 1; }
            else if (kind == 1) { u.A = WSP(bf16_t, WS_DQ); u.Bt = WSP(bf16_t, WS_WDO); u.epi = EP_PM; u.aux = 0; }
            else if (kind == 2) { u.A = WSP(bf16_t, WS_XB); u.Bt = WSP(bf16_t, WS_WIN); u.pn += 20; u.epi = EP_SG; u.aux = 2; }
            else { u.A = WSP(bf16_t, WS_MQ); u.Bt = WSP(bf16_t, WS_WMO); u.epi = EP_PM; u.aux = 1 | 4; }
            return true; }
        case PH_MG2: {
            const int kind = i % 5, tl = c + G * (i / 5); if (tl >= 256) return false; pg8::tile_of(tl, 64, 4, u.pm, u.pn); u.po = u.pn;
            if (kind == 0) { u.A = WSP(bf16_t, WS_XB); u.Bt = WSP(bf16_t, WS_WIN); u.K = 1024; u.pn += 48; u.epi = EP_SG; u.aux = 0; }
            else { const int h = kind - 1; u.A = WSP(bf16_t, (h < 2) ? WS_RG0 : WS_RG1) + (h & 1) * 512; u.lda = 1024; u.Bt = WSP(bf16_t, WS_WRO) + (size_t)h * 1024 * 512; u.K = 512;
                   if (h < 3) { u.epi = EP_RSC; u.aux = h + 1; } else { u.epi = EP_PM; u.aux = 1 | 2; u.rs = 1; } }
            return true; }
        case PH_IN_R0: case PH_IN_R1: {
            if (L >= 64 * 12) return false; pg8::tile_of(L, 64, 12, u.pm, u.pn);
            const int hg = (ph == PH_IN_R1); const int t = u.pn;
            u.A = WSP(bf16_t, WS_XB); u.Bt = WSP(bf16_t, WS_WIN); u.K = 1024; u.pn = 24 + 12 * hg + t;
            if (t < 2) { u.epi = EP_ROT; u.aux = 0; u.po = t; } else if (t < 4) { u.epi = EP_ROT; u.aux = 1; u.po = t - 2; }
            else if (t < 8) { u.epi = EP_PLAIN; u.aux = 1; u.po = t - 4; } else { u.epi = EP_PLAIN; u.aux = 2 + hg; u.po = t - 8; }
            return true; }
        case PH_WOUT: {
            if (L >= 256) return false; pg8::tile_of(L, 64, 4, u.pm, u.pn);
            u.A = WSP(bf16_t, WS_M); u.Bt = WSP(bf16_t, WS_WOUT); u.K = 1024; u.epi = EP_RES; u.aux = 1; u.po = u.pn; return true; }
        default: return false;
        }
    }
};

__device__ __forceinline__ float row_rinv(const float* part, int row) {
    const f32x4* p = (const f32x4*)(part + (size_t)row * 16);
    const f32x4 a = p[0], b = p[1], c = p[2], d = p[3];
    const float s = ((a[0] + a[1]) + (a[2] + a[3])) + ((b[0] + b[1]) + (b[2] + b[3])) + ((c[0] + c[1]) + (c[2] + c[3])) + ((d[0] + d[1]) + (d[2] + d[3]));
    return __builtin_amdgcn_rsqf(s * (1.0f / 1024.0f) + EPS);
}
__device__ __forceinline__ float fsigmoid(float v) { return __builtin_amdgcn_rcpf(1.0f + __builtin_amdgcn_exp2f(v * (-LOG2E))); }
__device__ __forceinline__ f32x4 exp2_4(f32x4 v) { return (f32x4){__builtin_amdgcn_exp2f(v[0]), __builtin_amdgcn_exp2f(v[1]), __builtin_amdgcn_exp2f(v[2]), __builtin_amdgcn_exp2f(v[3])}; }
__device__ __forceinline__ f32x4 rcp_4(f32x4 v) { return (f32x4){__builtin_amdgcn_rcpf(v[0]), __builtin_amdgcn_rcpf(v[1]), __builtin_amdgcn_rcpf(v[2]), __builtin_amdgcn_rcpf(v[3])}; }
__device__ __forceinline__ float ret_rms2(const float* ss, int row, int h);
__device__ __forceinline__ void rescale_rows(const Ctx& cx, f32x4 (&acc)[2][2][4][2], int rowb, int hn);

__device__ __forceinline__ void epilogue(const Ctx& cx, const Unit& u, f32x4 (&acc)[2][2][4][2], int wr, int wc, int fr, int fq, LAS unsigned char* lds) {
    const int rowb = u.pm * 256 + wr * 64 + fr;
    const int colw = wc * 32 + 8 * fq;
    float* PART = WSP(float, WS_PART);
#ifdef EPI_ONLY
    if (u.epi != EPI_ONLY) return;
#endif
    LAS float* rl = (LAS float*)(lds + EPI_OFF + 8192);
    LAS float* pl = (LAS float*)(lds + EPI_OFF + 9216);
    LAS unsigned char* ropl = lds + EPI_OFF + 10240;
    {
        const float* rp = nullptr;
        if (u.epi == EP_GU) rp = PART + (size_t)(u.aux ? 2 : 0) * T * 16;
        else if (u.epi == EP_PLAIN || u.epi == EP_DQK || u.epi == EP_MQ || u.epi == EP_ROT || u.epi == EP_SG) rp = PART + (size_t)1 * T * 16;
        if (rp) {
            const int lt = (wr * 4 + wc) * 64 + fq * 16 + fr, r = lt >> 1, hf = lt & 1;
            const f32x4* p = (const f32x4*)(rp + (size_t)(u.pm * 256 + r) * 16 + hf * 8);
            const f32x4 a = p[0], b = p[1];
            f32x4 c0 = (f32x4){0.f, 0.f, 0.f, 0.f}, c1 = c0; float pf = 0.f;
            if (u.epi == EP_DQK) { const f32x4* q = (const f32x4*)(WSP(float, WS_DROPE) + (size_t)(u.pm * 256 + r) * 16 + hf * 8); c0 = q[0]; c1 = q[1]; }
            if (u.epi == EP_ROT) pf = (float)((const int*)cx.in[2])[u.pm * 256 + (lt & 255)];
            float s = ((a[0] + a[1]) + (a[2] + a[3])) + ((b[0] + b[1]) + (b[2] + b[3]));
            s += dppf<0xB1>(s);
            if (hf == 0) rl[r] = __builtin_amdgcn_rsqf(s * (1.0f / 1024.0f) + EPS);
            if (u.epi == EP_DQK) { *(LAS f32x4*)(ropl + r * 64 + hf * 32) = c0; *(LAS f32x4*)(ropl + r * 64 + hf * 32 + 16) = c1; }
            if (u.epi == EP_ROT && lt < 256) pl[lt] = pf;
            asm volatile("s_waitcnt vmcnt(0) lgkmcnt(0)" ::: "memory"); __builtin_amdgcn_s_barrier(); asm volatile("" ::: "memory");
        }
    }
    const int lrb = wr * 64 + fr;
    switch (u.epi) {
    case EP_GU: {
        bf16_t* O = WSP(bf16_t, WS_ACT);
#pragma unroll
        for (int ai = 0; ai < 2; ++ai)
#pragma unroll
            for (int m = 0; m < 4; ++m) {
                const int row = rowb + ai * 128 + m * 16; const float ri = rl[lrb + ai * 128 + m * 16];
                const float k1 = -ri * LOG2E, ri2 = ri * ri; f32x4 ov[2];
#pragma unroll
                for (int n = 0; n < 2; ++n) { const f32x4 gq = acc[ai][0][m][n], uq = acc[ai][1][m][n];
                    const f32x4 den = exp2_4(gq * k1) + 1.0f; ov[n] = (gq * uq) * (rcp_4(den) * ri2); }
                u32x4 w; w.x = cvt_pk_bf16(ov[0][0], ov[0][1]); w.y = cvt_pk_bf16(ov[0][2], ov[0][3]); w.z = cvt_pk_bf16(ov[1][0], ov[1][1]); w.w = cvt_pk_bf16(ov[1][2], ov[1][3]);
                *(u32x4*)(O + (size_t)row * DFF + u.po * 128 + colw) = w;
            }
    } break;
    case EP_MV: case EP_PLAIN: {
        bf16_t* O; int ld; const bool part = (u.epi != EP_MV);
        if (u.epi == EP_MV) { O = WSP(bf16_t, WS_MV); ld = 1024; }
        else { ld = 1024; O = WSP(bf16_t, u.aux == 0 ? WS_DV : u.aux == 1 ? WS_RV : u.aux == 2 ? WS_RG0 : WS_RG1); }
#pragma unroll
        for (int ai = 0; ai < 2; ++ai)
#pragma unroll
            for (int m = 0; m < 4; ++m) {
                const int row = rowb + ai * 128 + m * 16; const float ri = part ? rl[lrb + ai * 128 + m * 16] : 1.0f;
#pragma unroll
                for (int bj = 0; bj < 2; ++bj) { const f32x4 v0 = acc[ai][bj][m][0] * ri, v1 = acc[ai][bj][m][1] * ri;
                    u32x4 w; w.x = cvt_pk_bf16(v0[0], v0[1]); w.y = cvt_pk_bf16(v0[2], v0[3]); w.z = cvt_pk_bf16(v1[0], v1[1]); w.w = cvt_pk_bf16(v1[2], v1[3]);
                    *(u32x4*)(O + (size_t)row * ld + u.po * 256 + bj * 128 + colw) = w; }
            }
    } break;
    case EP_RES: if (u.aux == 2) {
        float* part = PART + (size_t)3 * T * 16; unsigned* cnt = WSP(unsigned, WS_CTL) + 8192 + 64 * u.pm; const float* wn = cx.in[29]; const bf16_t* XB = WSP(bf16_t, WS_XB);
        LAS unsigned* flag = (LAS unsigned*)(lds + EPI_OFF);
#pragma unroll
        for (int ai = 0; ai < 2; ++ai) {
            u32x4 xv[4][2];
#pragma unroll
            for (int m = 0; m < 4; ++m)
#pragma unroll
                for (int bj = 0; bj < 2; ++bj) xv[m][bj] = *(const u32x4*)(XB + (size_t)(rowb + ai * 128 + m * 16) * D + u.po * 256 + bj * 128 + colw);
#pragma unroll
            for (int m = 0; m < 4; ++m) {
                const int row = rowb + ai * 128 + m * 16; float ss = 0.f;
#pragma unroll
                for (int bj = 0; bj < 2; ++bj) { const u32x4 xq = xv[m][bj];
                    const f32x4 x0 = (f32x4){bflo(xq.x), bfhi(xq.x), bflo(xq.y), bfhi(xq.y)}, x1 = (f32x4){bflo(xq.z), bfhi(xq.z), bflo(xq.w), bfhi(xq.w)};
                    const f32x4 y0 = x0 + acc[ai][bj][m][0] * 0.5f, y1 = x1 + acc[ai][bj][m][1] * 0.5f;
                    ss += (y0[0] * y0[0] + y0[1] * y0[1]) + (y0[2] * y0[2] + y0[3] * y0[3]) + (y1[0] * y1[0] + y1[1] * y1[1]) + (y1[2] * y1[2] + y1[3] * y1[3]); }
                ss += xor_f<16>(ss); ss = sum_xor32(ss);
                if (fq == 0) __hip_atomic_store(part + (size_t)row * 16 + u.po * 4 + wc, ss, __ATOMIC_RELAXED, __HIP_MEMORY_SCOPE_AGENT);
            }
        }
        asm volatile("s_waitcnt vmcnt(0)" ::: "memory");
        if (fr == 0 && fq == 0) __hip_atomic_fetch_add(cnt, 1u, __ATOMIC_RELAXED, __HIP_MEMORY_SCOPE_AGENT);
        if (wr == 0 && wc == 0) {
            unsigned sp = 0;
            while ((unsigned)__builtin_amdgcn_readfirstlane(__hip_atomic_load(cnt, __ATOMIC_RELAXED, __HIP_MEMORY_SCOPE_AGENT)) < 32u) { __builtin_amdgcn_s_sleep(2); if (++sp > (1u << 22)) break; }
            __builtin_amdgcn_fence(__ATOMIC_ACQUIRE, "agent");
            asm volatile("s_waitcnt vmcnt(0)" ::: "memory");
            if (fr == 0 && fq == 0) flag[0] = 1u;
        }
        asm volatile("s_waitcnt vmcnt(0) lgkmcnt(0)" ::: "memory"); __builtin_amdgcn_s_barrier(); asm volatile("" ::: "memory");
        int rowb2 = rowb, colw2 = colw; asm volatile("" : "+v"(rowb2), "+v"(colw2));
#pragma unroll
        for (int q4 = 0; q4 < 4; ++q4) {
            const int ai = q4 >> 1, m0 = (q4 & 1) * 2;
            u32x4 xv[2][2]; float ri[2];
#pragma unroll
            for (int mm = 0; mm < 2; ++mm) { const int row = rowb2 + ai * 128 + (m0 + mm) * 16; ri[mm] = row_rinv(part, row);
#pragma unroll
                for (int bj = 0; bj < 2; ++bj) xv[mm][bj] = *(const u32x4*)(XB + (size_t)row * D + u.po * 256 + bj * 128 + colw2); }
            __builtin_amdgcn_sched_barrier(0);
#pragma unroll
            for (int mm = 0; mm < 2; ++mm) { const int row = rowb2 + ai * 128 + (m0 + mm) * 16;
#pragma unroll
                for (int bj = 0; bj < 2; ++bj) { const size_t off = (size_t)row * D + u.po * 256 + bj * 128 + colw2; const u32x4 xq = xv[mm][bj];
                    const f32x4 x0 = (f32x4){bflo(xq.x), bfhi(xq.x), bflo(xq.y), bfhi(xq.y)}, x1 = (f32x4){bflo(xq.z), bfhi(xq.z), bflo(xq.w), bfhi(xq.w)};
                    const f32x4 w0 = *(const f32x4*)(wn + u.po * 256 + bj * 128 + colw2), w1 = *(const f32x4*)(wn + u.po * 256 + bj * 128 + colw2 + 4);
                    *(f32x4*)(cx.out + off) = (x0 + acc[ai][bj][m0 + mm][0] * 0.5f) * ri[mm] * w0; *(f32x4*)(cx.out + off + 4) = (x1 + acc[ai][bj][m0 + mm][1] * 0.5f) * ri[mm] * w1; } }
            __builtin_amdgcn_sched_barrier(0);
        }
    } else {
        float* part = PART + (size_t)(u.aux + 1) * T * 16; bf16_t* XB = WSP(bf16_t, WS_XB);
#pragma unroll
        for (int ai = 0; ai < 2; ++ai) {
            f32x4 xv[4][2][2];
            if (u.aux == 0) {
#pragma unroll
                for (int m = 0; m < 4; ++m)
#pragma unroll
                    for (int bj = 0; bj < 2; ++bj) { const size_t off = (size_t)(rowb + ai * 128 + m * 16) * D + u.po * 256 + bj * 128 + colw;
                        xv[m][bj][0] = *(const f32x4*)(cx.in[0] + off) ; xv[m][bj][1] = *(const f32x4*)(cx.in[0] + off + 4); }
            } else {
                u32x4 xb[4][2];
#pragma unroll
                for (int m = 0; m < 4; ++m)
#pragma unroll
                    for (int bj = 0; bj < 2; ++bj) xb[m][bj] = *(const u32x4*)(XB + (size_t)(rowb + ai * 128 + m * 16) * D + u.po * 256 + bj * 128 + colw);
#pragma unroll
                for (int m = 0; m < 4; ++m)
#pragma unroll
                    for (int bj = 0; bj < 2; ++bj) { const u32x4 xq = xb[m][bj];
                        xv[m][bj][0] = (f32x4){bflo(xq.x), bfhi(xq.x), bflo(xq.y), bfhi(xq.y)}; xv[m][bj][1] = (f32x4){bflo(xq.z), bfhi(xq.z), bflo(xq.w), bfhi(xq.w)}; }
            }
            __builtin_amdgcn_sched_barrier(0);
            const float sc = (u.aux == 1) ? 1.0f : 0.5f;
#pragma unroll
            for (int m = 0; m < 4; ++m) {
                const int row = rowb + ai * 128 + m * 16; float ss = 0.f;
#pragma unroll
                for (int bj = 0; bj < 2; ++bj) { const size_t off = (size_t)row * D + u.po * 256 + bj * 128 + colw;
                    const f32x4 y0 = xv[m][bj][0] + acc[ai][bj][m][0] * sc, y1 = xv[m][bj][1] + acc[ai][bj][m][1] * sc;
                    ss += (y0[0] * y0[0] + y0[1] * y0[1]) + (y0[2] * y0[2] + y0[3] * y0[3]) + (y1[0] * y1[0] + y1[1] * y1[1]) + (y1[2] * y1[2] + y1[3] * y1[3]);
                    u32x4 w; w.x = cvt_pk_bf16(y0[0], y0[1]); w.y = cvt_pk_bf16(y0[2], y0[3]); w.z = cvt_pk_bf16(y1[0], y1[1]); w.w = cvt_pk_bf16(y1[2], y1[3]);
                    *(u32x4*)(XB + off) = w; }
                ss += xor_f<16>(ss); ss = sum_xor32(ss);
                if (fq == 0) part[(size_t)row * 16 + u.po * 4 + wc] = ss;
            }
            __builtin_amdgcn_sched_barrier(0);
        }
    } break;
    case EP_DQK: {
        const float* wn = cx.in[u.aux ? 12 : 11];
        bf16_t* O = WSP(bf16_t, u.aux ? WS_DK : WS_DQ);
        f32x4 wv[2][2];
#pragma unroll
        for (int bj = 0; bj < 2; ++bj)
#pragma unroll
            for (int n = 0; n < 2; ++n) wv[bj][n] = *(const f32x4*)(wn + 16 * fq + 8 * bj + 4 * n);
#pragma unroll
        for (int ai = 0; ai < 2; ++ai)
#pragma unroll
            for (int m = 0; m < 4; ++m) {
                const int row = rowb + ai * 128 + m * 16; const float ri = rl[lrb + ai * 128 + m * 16];
                f32x4 v[2][2]; float ss = 0.f;
#pragma unroll
                for (int bj = 0; bj < 2; ++bj)
#pragma unroll
                    for (int n = 0; n < 2; ++n) { v[bj][n] = acc[ai][bj][m][n] * ri; ss += (v[bj][n][0] * v[bj][n][0] + v[bj][n][1] * v[bj][n][1]) + (v[bj][n][2] * v[bj][n][2] + v[bj][n][3] * v[bj][n][3]); }
                ss += xor_f<16>(ss); ss = sum_xor32(ss);
                const float r2 = __builtin_amdgcn_rsqf(ss * (1.0f / 64.0f) + EPS);
#pragma unroll
                for (int bj = 0; bj < 2; ++bj)
#pragma unroll
                    for (int n = 0; n < 2; ++n) v[bj][n] = v[bj][n] * r2 * wv[bj][n];
                if (fq == 0) {
                    const LAS f32x4* rp = (const LAS f32x4*)(ropl + (lrb + ai * 128 + m * 16) * 64);
#pragma unroll
                    for (int n = 0; n < 2; ++n) { const f32x4 cs0 = rp[2 * n], cs1 = rp[2 * n + 1];
                        const float c_[4] = {cs0[0], cs0[2], cs1[0], cs1[2]}, s_[4] = {cs0[1], cs0[3], cs1[1], cs1[3]};
#pragma unroll
                        for (int e = 0; e < 4; ++e) { const float x1 = v[0][n][e], x2 = v[1][n][e]; v[0][n][e] = x1 * c_[e] - x2 * s_[e]; v[1][n][e] = x2 * c_[e] + x1 * s_[e]; } }
                }
#pragma unroll
                for (int bj = 0; bj < 2; ++bj) { u32x4 w; w.x = cvt_pk_bf16(v[bj][0][0], v[bj][0][1]); w.y = cvt_pk_bf16(v[bj][0][2], v[bj][0][3]); w.z = cvt_pk_bf16(v[bj][1][0], v[bj][1][1]); w.w = cvt_pk_bf16(v[bj][1][2], v[bj][1][3]);
                    *(u32x4*)(O + (size_t)row * 1024 + u.po * 256 + wc * 64 + bj * 32 + 8 * fq) = w; }
            }
    } break;
    case EP_MQ: case EP_MK: {
        const bool part = (u.epi == EP_MQ); const float* wn = cx.in[u.epi == EP_MQ ? 21 : 22];
        bf16_t* O = WSP(bf16_t, u.epi == EP_MQ ? WS_MQ : WS_MK);
        LAS float* red = (LAS float*)(lds + EPI_OFF);
        float ri[2][4];
#pragma unroll
        for (int ai = 0; ai < 2; ++ai)
#pragma unroll
            for (int m = 0; m < 4; ++m) {
                ri[ai][m] = part ? rl[lrb + ai * 128 + m * 16] : 1.0f; float ss = 0.f;
#pragma unroll
                for (int bj = 0; bj < 2; ++bj)
#pragma unroll
                    for (int n = 0; n < 2; ++n) { const f32x4 v = acc[ai][bj][m][n] * ri[ai][m]; ss += (v[0] * v[0] + v[1] * v[1]) + (v[2] * v[2] + v[3] * v[3]); }
                ss += xor_f<16>(ss); ss = sum_xor32(ss);
                if (fq == 0) red[(ai * 128 + wr * 64 + m * 16 + fr) * 4 + wc] = ss;
            }
        asm volatile("s_waitcnt lgkmcnt(0)" ::: "memory"); __builtin_amdgcn_s_barrier(); asm volatile("" ::: "memory");
        f32x4 wv[2][2];
#pragma unroll
        for (int bj = 0; bj < 2; ++bj)
#pragma unroll
            for (int n = 0; n < 2; ++n) wv[bj][n] = *(const f32x4*)(wn + bj * 128 + colw + 4 * n);
#pragma unroll
        for (int ai = 0; ai < 2; ++ai)
#pragma unroll
            for (int m = 0; m < 4; ++m) {
                const int row = rowb + ai * 128 + m * 16; const int lr = ai * 128 + wr * 64 + m * 16 + fr;
                const float tot = (red[lr * 4 + 0] + red[lr * 4 + 1]) + (red[lr * 4 + 2] + red[lr * 4 + 3]);
                const float r2 = __builtin_amdgcn_rsqf(tot * (1.0f / 256.0f) + EPS) * ri[ai][m];
#pragma unroll
                for (int bj = 0; bj < 2; ++bj) { const f32x4 v0 = acc[ai][bj][m][0] * r2 * wv[bj][0], v1 = acc[ai][bj][m][1] * r2 * wv[bj][1];
                    u32x4 w; w.x = cvt_pk_bf16(v0[0], v0[1]); w.y = cvt_pk_bf16(v0[2], v0[3]); w.z = cvt_pk_bf16(v1[0], v1[1]); w.w = cvt_pk_bf16(v1[2], v1[3]);
                    *(u32x4*)(O + (size_t)row * 1024 + u.po * 256 + bj * 128 + colw) = w; }
            }
        asm volatile("s_waitcnt lgkmcnt(0)" ::: "memory"); __builtin_amdgcn_s_barrier(); asm volatile("" ::: "memory");
    } break;
    case EP_ROT: {
        const float* rinvf = WSP(float, WS_RINV);
        bf16_t* O = WSP(bf16_t, u.aux ? WS_RK : WS_RQ); const float ksc = u.aux ? 0.0625f : 1.0f;
        f32x4 fr4[2];
#pragma unroll
        for (int bj = 0; bj < 2; ++bj) fr4[bj] = *(const f32x4*)(rinvf + (bj * 128 + colw) / 2);
#pragma unroll
        for (int ai = 0; ai < 2; ++ai)
#pragma unroll
            for (int m = 0; m < 4; ++m) {
                const int row = rowb + ai * 128 + m * 16; const float ri = rl[lrb + ai * 128 + m * 16] * ksc; const float pf = pl[lrb + ai * 128 + m * 16];
#pragma unroll
                for (int bj = 0; bj < 2; ++bj) { float o[8];
#pragma unroll
                    for (int p = 0; p < 4; ++p) { const float ang = pf * fr4[bj][p];
                        const float rh = ang * 0.15915494309189535f; const float rl = __builtin_fmaf(ang, 0.15915494309189535f, -rh) + ang * (-1.2154201256553420e-10f);
                        float fr_ = rh - floorf(rh); fr_ += rl;
                        const float sn = __builtin_amdgcn_sinf(fr_), cs = __builtin_amdgcn_cosf(fr_);
                        const float xe = acc[ai][bj][m][p >> 1][(p & 1) * 2] * ri, xo = acc[ai][bj][m][p >> 1][(p & 1) * 2 + 1] * ri;
                        o[2 * p] = xe * cs - xo * sn; o[2 * p + 1] = xo * cs + xe * sn; }
                    u32x4 w; w.x = cvt_pk_bf16(o[0], o[1]); w.y = cvt_pk_bf16(o[2], o[3]); w.z = cvt_pk_bf16(o[4], o[5]); w.w = cvt_pk_bf16(o[6], o[7]);
                    *(u32x4*)(O + (size_t)row * 512 + u.po * 256 + bj * 128 + colw) = w; }
            }
    } break;
    case EP_SG: {
        const float* bg = cx.in[9] + u.aux * 1024 + u.po * 256;
        bf16_t* O = WSP(bf16_t, u.aux == 0 ? WS_SG2 : u.aux == 1 ? WS_SG : WS_SGB);
        f32x4 bv[2][2];
#pragma unroll
        for (int bj = 0; bj < 2; ++bj)
#pragma unroll
            for (int n = 0; n < 2; ++n) bv[bj][n] = *(const f32x4*)(bg + bj * 128 + colw + 4 * n);
#pragma unroll
        for (int ai = 0; ai < 2; ++ai)
#pragma unroll
            for (int m = 0; m < 4; ++m) {
                const int row = rowb + ai * 128 + m * 16; const float ri = rl[lrb + ai * 128 + m * 16];
#pragma unroll
                for (int bj = 0; bj < 2; ++bj) { f32x4 ov[2];
#pragma unroll
                    for (int n = 0; n < 2; ++n) ov[n] = rcp_4(exp2_4((acc[ai][bj][m][n] * ri + bv[bj][n]) * (-LOG2E)) + 1.0f);
                    u32x4 w; w.x = cvt_pk_bf16(ov[0][0], ov[0][1]); w.y = cvt_pk_bf16(ov[0][2], ov[0][3]); w.z = cvt_pk_bf16(ov[1][0], ov[1][1]); w.w = cvt_pk_bf16(ov[1][2], ov[1][3]);
                    *(u32x4*)(O + (size_t)row * 1024 + u.po * 256 + bj * 128 + colw) = w; }
            }
    } break;
    case EP_PM: {
        const bf16_t* SG = WSP(bf16_t, (u.aux & 2) ? WS_SG2 : (u.aux & 4) ? WS_SGB : WS_SG); bf16_t* Mb = WSP(bf16_t, WS_M); const bool accum = (u.aux & 1);
#pragma unroll
        for (int ai = 0; ai < 2; ++ai) {
            u32x4 gv[4][2], pv[4][2]; float rs[4];
#pragma unroll
            for (int m = 0; m < 4; ++m) { const int row = rowb + ai * 128 + m * 16; rs[m] = u.rs ? rsqrtf(ret_rms2(WSP(float, WS_RSS), row, 3)) : 1.0f;
#pragma unroll
                for (int bj = 0; bj < 2; ++bj) { const size_t off = (size_t)row * 1024 + u.po * 256 + bj * 128 + colw;
                    gv[m][bj] = *(const u32x4*)(SG + off); pv[m][bj] = (u32x4){0u, 0u, 0u, 0u}; if (accum) pv[m][bj] = *(const u32x4*)(Mb + off); } }
            __builtin_amdgcn_sched_barrier(0);
#pragma unroll
            for (int m = 0; m < 4; ++m) { const int row = rowb + ai * 128 + m * 16;
#pragma unroll
                for (int bj = 0; bj < 2; ++bj) { const size_t off = (size_t)row * 1024 + u.po * 256 + bj * 128 + colw;
                    const u32x4 g = gv[m][bj], pm = pv[m][bj];
                    const f32x4 a0 = acc[ai][bj][m][0] * rs[m], a1 = acc[ai][bj][m][1] * rs[m];
                    float o[8];
                    o[0] = bflo(g.x) * a0[0] + bflo(pm.x); o[1] = bfhi(g.x) * a0[1] + bfhi(pm.x); o[2] = bflo(g.y) * a0[2] + bflo(pm.y); o[3] = bfhi(g.y) * a0[3] + bfhi(pm.y);
                    o[4] = bflo(g.z) * a1[0] + bflo(pm.z); o[5] = bfhi(g.z) * a1[1] + bfhi(pm.z); o[6] = bflo(g.w) * a1[2] + bflo(pm.w); o[7] = bfhi(g.w) * a1[3] + bfhi(pm.w);
                    u32x4 w; w.x = cvt_pk_bf16(o[0], o[1]); w.y = cvt_pk_bf16(o[2], o[3]); w.z = cvt_pk_bf16(o[4], o[5]); w.w = cvt_pk_bf16(o[6], o[7]);
                    *(u32x4*)(Mb + off) = w; } }
            __builtin_amdgcn_sched_barrier(0);
        }
    } break;
    default: break;
    }
}


__device__ __forceinline__ float ret_rms2(const float* ss, int row, int h) { const f32x2 v = *(const f32x2*)(ss + (size_t)row * 8 + 2 * h); return (v[0] + v[1]) * (1.0f / 512.0f) + EPS; }
__device__ __forceinline__ void rescale_rows(const Ctx& cx, f32x4 (&acc)[2][2][4][2], int rowb, int hn) {
    const float* ss = WSP(float, WS_RSS);
#pragma unroll
    for (int ai = 0; ai < 2; ++ai)
#pragma unroll
        for (int m = 0; m < 4; ++m) { const int row = rowb + ai * 128 + m * 16; const float f = sqrtf(ret_rms2(ss, row, hn) / ret_rms2(ss, row, hn - 1));
#pragma unroll
            for (int bj = 0; bj < 2; ++bj)
#pragma unroll
                for (int n = 0; n < 2; ++n) acc[ai][bj][m][n] = acc[ai][bj][m][n] * f; }
}
__device__ __forceinline__ void gemm_phase(LAS unsigned char* lds, const GemmSched& S, const Ctx& cx, int WV) {
    using namespace pg8;
    int tid = TID_OF(WV); asm volatile("" : "+v"(tid));
    const int wid = __builtin_amdgcn_readfirstlane(tid >> 6), lane = tid & 63, wr = wid >> 2, wc = wid & 3, fr = lane & 15, fq = lane >> 4;
    int RA, RB, CC;
    { int R, C; stage_rc(tid * 16, R, C); RA = R * 2; RB = ((R & ~31) + perm32(R & 31)) * 2; CC = C * 2; }
    const size_t kstep = (size_t)(BK * 2);
    const unsigned ldsw = (unsigned)wid * 1024u;
    const int aoff = lds_byte(wr * 64 + fr, fq * 8), boff = lds_byte(wc * 32 + fr, fq * 8);
#define PG8_SA(b, h) (((b) * 2 + (h)) * HTB)
#define PG8_SB(b, h) ((4 + (b) * 2 + (h)) * HTB)
#define PG8_STAGE(bufoff, gbase, voff, hs) do { \
        __builtin_amdgcn_global_load_lds((const unsigned*)((const char*)(gbase) + (voff)), (LAS unsigned*)(lds + (bufoff) + ldsw), 16, 0, 0); \
        __builtin_amdgcn_global_load_lds((const unsigned*)((const char*)(gbase) + ((hs) >> 1) + (voff)), (LAS unsigned*)(lds + (bufoff) + ldsw + 8192), 16, 0, 0); } while (0)
#define PG8_LDA(dst, b, h) do { _Pragma("unroll") for (int m = 0; m < 4; ++m) _Pragma("unroll") for (int k = 0; k < 2; ++k) dst[m][k] = *(const LAS bf16x8*)(lds + PG8_SA(b, h) + aoff + m * 2048 + k * 1024); } while (0)
#define PG8_LDB(dst, b, h) do { _Pragma("unroll") for (int n = 0; n < 2; ++n) _Pragma("unroll") for (int k = 0; k < 2; ++k) dst[n][k] = *(const LAS bf16x8*)(lds + PG8_SB(b, h) + boff + n * 2048 + k * 1024); } while (0)
#define PG8_MMA(ai, bj, At, Bt) do { __builtin_amdgcn_s_setprio(1); _Pragma("unroll") for (int m = 0; m < 4; ++m) _Pragma("unroll") for (int n = 0; n < 2; ++n) _Pragma("unroll") for (int k = 0; k < 2; ++k) \
        acc[ai][bj][m][n] = __builtin_amdgcn_mfma_f32_16x16x32_bf16(Bt[n][k], At[m][k], acc[ai][bj][m][n], 0, 0, 0); __builtin_amdgcn_s_setprio(0); } while (0)
#define PG8_WAIT_V(n) asm volatile("s_waitcnt vmcnt(" #n ")" ::: "memory")
#define PG8_WAIT_L(n) asm volatile("s_waitcnt lgkmcnt(" #n ")" ::: "memory")
#define PG8_BAR __builtin_amdgcn_s_barrier()
#define PG8_SCHED __builtin_amdgcn_sched_barrier(0)
    Unit cur, nxt; int ui = 0;
    if (!S.next(0, cur)) return;
    f32x4 acc[2][2][4][2];
    { float z = 0.f; asm volatile("" : "+v"(z));
#pragma unroll
    for (int a = 0; a < 2; ++a)
#pragma unroll
        for (int b = 0; b < 2; ++b)
#pragma unroll
            for (int m = 0; m < 4; ++m)
#pragma unroll
                for (int n = 0; n < 2; ++n) acc[a][b][m][n] = (f32x4){z, z, z, z}; }
    bf16x8 At[4][2], B0[2][2], B1[2][2];
    int Kc = cur.K; size_t hsAc = (size_t)HALF * cur.lda * 2, hsBc = (size_t)HALF * Kc * 2;
    unsigned vAc = (unsigned)(RA * cur.lda + CC), vBc = (unsigned)(RB * Kc + CC);
    const char* cA = (const char*)cur.A + (size_t)cur.pm * 2 * hsAc; const char* cB = (const char*)cur.Bt + (size_t)cur.pn * 2 * hsBc;
    PG8_STAGE(PG8_SB(0, 0), cB, vBc, hsBc); PG8_STAGE(PG8_SB(0, 1), cB + hsBc, vBc, hsBc); PG8_STAGE(PG8_SA(0, 0), cA, vAc, hsAc); PG8_STAGE(PG8_SA(0, 1), cA + hsAc, vAc, hsAc);
    if (wr == 1) PG8_BAR;
    PG8_WAIT_V(2); PG8_BAR;
    PG8_STAGE(PG8_SB(1, 0), cB + kstep, vBc, hsBc); PG8_STAGE(PG8_SA(1, 0), cA + kstep, vAc, hsAc); PG8_STAGE(PG8_SB(1, 1), cB + hsBc + kstep, vBc, hsBc);
    PG8_WAIT_V(6); PG8_BAR;
    for (;;) {
        const bool has_next = S.next(ui + 1, nxt);
        const int Kn = has_next ? nxt.K : Kc; const int ldan = has_next ? nxt.lda : cur.lda; const size_t hsAn = (size_t)HALF * ldan * 2, hsBn = (size_t)HALF * Kn * 2;
        const unsigned vAn = (unsigned)(RA * ldan + CC), vBn = (unsigned)(RB * Kn + CC);
        const char* nA = has_next ? (const char*)nxt.A + (size_t)nxt.pm * 2 * hsAn : cA; const char* nB = has_next ? (const char*)nxt.Bt + (size_t)nxt.pn * 2 * hsBn : cB;
        const int nt = Kc / BK; const int kjt = cur.kjt; const size_t kj = (size_t)cur.kjump;
#define PG8_AOFF(tt) ((size_t)(tt) * kstep + (((tt) >= kjt) ? kj : (size_t)0))
        for (int t = 0; t < nt; t += 2) {
            const bool last = (t == nt - 2);
            const char* a1 = cA + PG8_AOFF(t + 1);
            const char* a2 = last ? nA : cA + PG8_AOFF(t + 2); const char* b2 = last ? nB : cB + (size_t)(t + 2) * kstep;
            const char* a3 = last ? nA + kstep : cA + PG8_AOFF(t + 3); const char* b3 = b2 + kstep;
            const size_t hsA2 = last ? hsAn : hsAc, hsB2 = last ? hsBn : hsBc;
            const unsigned vA2 = last ? vAn : vAc, vB2 = last ? vBn : vBc;
            PG8_LDB(B0, 0, 0); PG8_LDB(B1, 0, 1); PG8_SCHED; PG8_LDA(At, 0, 0); PG8_STAGE(PG8_SA(1, 1), a1 + hsAc, vAc, hsAc);
            PG8_WAIT_V(8); PG8_WAIT_L(0); PG8_BAR; PG8_MMA(0, 0, At, B0); PG8_MMA(0, 1, At, B1); PG8_BAR; PG8_SCHED;
            PG8_LDA(At, 0, 1); PG8_STAGE(PG8_SB(0, 0), b2, vB2, hsB2); PG8_STAGE(PG8_SB(0, 1), b2 + hsB2, vB2, hsB2); PG8_STAGE(PG8_SA(0, 0), a2, vA2, hsA2);
            PG8_WAIT_V(8); PG8_WAIT_L(0); PG8_BAR; PG8_MMA(1, 0, At, B0); PG8_MMA(1, 1, At, B1); PG8_BAR; PG8_SCHED;
            PG8_LDB(B0, 1, 0); PG8_LDB(B1, 1, 1); PG8_SCHED; PG8_LDA(At, 1, 0); PG8_STAGE(PG8_SA(0, 1), a2 + hsA2, vA2, hsA2);
            PG8_WAIT_V(8); PG8_WAIT_L(0); PG8_BAR; PG8_MMA(0, 0, At, B0); PG8_MMA(0, 1, At, B1); PG8_BAR; PG8_SCHED;
            PG8_LDA(At, 1, 1); PG8_STAGE(PG8_SB(1, 0), b3, vB2, hsB2); PG8_STAGE(PG8_SB(1, 1), b3 + hsB2, vB2, hsB2); PG8_STAGE(PG8_SA(1, 0), a3, vA2, hsA2);
            PG8_WAIT_V(8); PG8_WAIT_L(0); PG8_BAR; PG8_MMA(1, 0, At, B0); PG8_MMA(1, 1, At, B1); PG8_BAR; PG8_SCHED;
        }
#undef PG8_AOFF
        if (wr == 0) PG8_BAR;
        { int fr_ = fr, fq_ = fq; asm volatile("" : "+v"(fr_), "+v"(fq_));
          epilogue(cx, cur, acc, wr, wc, fr_, fq_, lds); }
        if (!has_next) break;
        {
            const bool rsc = (cur.epi == EP_RSC); const int hn = rsc ? cur.aux : 1; const float* ss = WSP(float, WS_RSS); const int rowb = cur.pm * 256 + wr * 64 + fr;
#pragma unroll
            for (int a = 0; a < 2; ++a)
#pragma unroll
                for (int m = 0; m < 4; ++m) { const int row = rowb + a * 128 + m * 16; float f = 0.0f; if (rsc) f = sqrtf(ret_rms2(ss, row, hn) / ret_rms2(ss, row, hn - 1));
#pragma unroll
                    for (int b = 0; b < 2; ++b)
#pragma unroll
                        for (int n = 0; n < 2; ++n) acc[a][b][m][n] = acc[a][b][m][n] * f; }
        }
        cur = nxt; cA = nA; cB = nB; Kc = Kn; hsAc = hsAn; hsBc = hsBn; vAc = vAn; vBc = vBn;
        ++ui;
        if (wr == 1) PG8_BAR;
    }
    PG8_WAIT_V(0);
    PG8_BAR;
#undef PG8_SA
#undef PG8_SB
#undef PG8_STAGE
#undef PG8_LDA
#undef PG8_LDB
#undef PG8_MMA
#undef PG8_WAIT_V
#undef PG8_WAIT_L
#undef PG8_BAR
#undef PG8_SCHED
}

struct AttItem {
    const bf16_t* Q; int ldq;
    const bf16_t* K; int ldk;
    const bf16_t* V; int ldv;
    bf16_t* O; int ldo;
    const bf16_t* G;
    int nt;
    int q0;
    float p0, p1, p2;
};
__device__ __forceinline__ s16x4 ds_tr16(const LAS unsigned char* p) { return __builtin_bit_cast(s16x4, __builtin_amdgcn_ds_read_tr16_b64_v4i16((LAS s16x4*)p)); }

template <int NM, int DQ, int DV, int MODE>
__device__ __forceinline__ void attn_item(LAS unsigned char* lds, const AttItem& it, const Ctx& cx, int WV) {
    constexpr int QW = NM * DQ, QP = (QW + 8) * 2  , VP = (DV + 8) * 2, PP = 72 * 2;
    constexpr int OFF_Q = 0, OFF_K = OFF_Q + 64 * QP, OFF_V = OFF_K + 64 * QP, OFF_P = OFF_V + 64 * VP, OFF_R = OFF_P + NM * 64 * PP;
    static_assert(OFF_R + 8 * 64 * 4 + 2 * 64 * 4 <= ATT_BYTES, "attention LDS");
    int tid = TID_OF(WV); asm volatile("" : "+v"(tid));
    const int w = __builtin_amdgcn_readfirstlane(tid >> 6), l = tid & 63, l15 = l & 15, g = l >> 4;
    const int rb = w >> 1, ch = w & 1;
    constexpr int NTV = DV / 128;
    const int c0 = w * (DV / 8);
    LAS float* RED = (LAS float*)(lds + OFF_R);
    LAS float* FIN = RED + 8 * 64;
    for (int i = tid; i < 64 * (QW / 8); i += 512) { const int r = i / (QW / 8), c = i % (QW / 8);
        *(LAS u32x4*)(lds + OFF_Q + r * QP + c * 16) = *(const u32x4*)(it.Q + (size_t)r * it.ldq + c * 8); }
    f32x4 o[NM][4][NTV];
#pragma unroll
    for (int r = 0; r < NM; ++r)
#pragma unroll
        for (int m = 0; m < 4; ++m)
#pragma unroll
            for (int n = 0; n < NTV; ++n) o[r][m][n] = (f32x4){0.f, 0.f, 0.f, 0.f};
    float lsum[NM][4];
#pragma unroll
    for (int r = 0; r < NM; ++r)
#pragma unroll
        for (int j = 0; j < 4; ++j) lsum[r][j] = 0.f;
    for (int kt = 0; kt < it.nt; ++kt) {
        for (int i = tid; i < 64 * (QW / 8); i += 512) { const int r = i / (QW / 8), c = i % (QW / 8);
            *(LAS u32x4*)(lds + OFF_K + r * QP + c * 16) = *(const u32x4*)(it.K + (size_t)(kt * 64 + r) * it.ldk + c * 8); }
        for (int i = tid; i < 64 * (DV / 8); i += 512) { const int r = i / (DV / 8), c = i % (DV / 8);
            *(LAS u32x4*)(lds + OFF_V + r * VP + c * 16) = *(const u32x4*)(it.V + (size_t)(kt * 64 + r) * it.ldv + c * 8); }
        __syncthreads();
#pragma unroll
        for (int r = 0; r < NM; ++r) {
            f32x4 s[2]; s[0] = (f32x4){0.f, 0.f, 0.f, 0.f}; s[1] = s[0];
#pragma unroll
            for (int ks = 0; ks < DQ / 32; ++ks) {
                const bf16x8 a = *(const LAS bf16x8*)(lds + OFF_Q + (16 * rb + l15) * QP + (r * DQ + 32 * ks + 8 * g) * 2);
#pragma unroll
                for (int n = 0; n < 2; ++n) { const bf16x8 b = *(const LAS bf16x8*)(lds + OFF_K + (32 * ch + 16 * n + l15) * QP + (r * DQ + 32 * ks + 8 * g) * 2);
                    s[n] = __builtin_amdgcn_mfma_f32_16x16x32_bf16(a, b, s[n], 0, 0, 0); }
            }
#pragma unroll
            for (int n = 0; n < 2; ++n)
#pragma unroll
                for (int j = 0; j < 4; ++j) {
                    const int row = 16 * rb + 4 * g + j, key = 32 * ch + 16 * n + l15; float p;
                    if (MODE == 0) { const int dist = (it.q0 + row) - (kt * 64 + key); p = s[n][j] * __builtin_amdgcn_exp2f(it.p0 * (float)(dist < 0 ? -dist : dist)); }
                    else { p = __builtin_amdgcn_exp2f(s[n][j] * it.p0 - it.p1); lsum[r][j] += p; }
                    *(LAS unsigned short*)(lds + OFF_P + r * 64 * PP + row * PP + key * 2) = f2bf(p);
                }
        }
        __syncthreads();
#pragma unroll
        for (int ks = 0; ks < 2; ++ks) {
            bf16x8 bv[NTV];
#pragma unroll
            for (int n = 0; n < NTV; ++n) {
                const int q = (l & 15) >> 2, p = l & 3;
                const LAS unsigned char* base = lds + OFF_V + (32 * ks + 8 * g + q) * VP + (c0 + 16 * n + 4 * p) * 2;
                const s16x4 t0 = ds_tr16(base), t1 = ds_tr16(base + 4 * VP);
                bv[n] = (bf16x8){t0[0], t0[1], t0[2], t0[3], t1[0], t1[1], t1[2], t1[3]};
            }
#pragma unroll
            for (int r = 0; r < NM; ++r)
#pragma unroll
                for (int m = 0; m < 4; ++m) {
                    const bf16x8 a = *(const LAS bf16x8*)(lds + OFF_P + r * 64 * PP + (16 * m + l15) * PP + (32 * ks + 8 * g) * 2);
#pragma unroll
                    for (int n = 0; n < NTV; ++n) o[r][m][n] = __builtin_amdgcn_mfma_f32_16x16x32_bf16(a, bv[n], o[r][m][n], 0, 0, 0);
                }
        }
        __syncthreads();
    }
    if (MODE != 0) {
#pragma unroll
        for (int r = 0; r < NM; ++r)
#pragma unroll
            for (int j = 0; j < 4; ++j) { float v = lsum[r][j]; v += xor_f<1>(v); v += xor_f<2>(v); v += xor_f<4>(v); v += xor_f<8>(v);
                if (l15 == 0) RED[(r * 2 + ch) * 64 + 16 * rb + 4 * g + j] = v; }
        __syncthreads();
        if (tid < NM * 64) { const int r = tid >> 6, row = tid & 63; FIN[r * 64 + row] = 1.0f / (RED[(r * 2 + 0) * 64 + row] + RED[(r * 2 + 1) * 64 + row]); }
        __syncthreads();
    }
    f32x4 y[4][NTV];
#pragma unroll
    for (int m = 0; m < 4; ++m)
#pragma unroll
        for (int n = 0; n < NTV; ++n)
#pragma unroll
            for (int j = 0; j < 4; ++j) { const int row = 16 * m + 4 * g + j;
                if (MODE == 0) y[m][n][j] = o[0][m][n][j];
                else if (MODE == 1) y[m][n][j] = o[0][m][n][j] * FIN[row] - it.p2 * (o[NM - 1][m][n][j] * FIN[(NM - 1) * 64 + row]);
                else y[m][n][j] = o[0][m][n][j] * FIN[row]; }
    if (MODE != 2) {
        __syncthreads();
#pragma unroll
        for (int m = 0; m < 4; ++m)
#pragma unroll
            for (int j = 0; j < 4; ++j) { float v = 0.f;
#pragma unroll
                for (int n = 0; n < NTV; ++n) v += y[m][n][j] * y[m][n][j];
                v += xor_f<1>(v); v += xor_f<2>(v); v += xor_f<4>(v); v += xor_f<8>(v);
                if (l15 == 0) RED[w * 64 + 16 * m + 4 * g + j] = v; }
        __syncthreads();
        if (tid < 64) { float s = 0.f;
#pragma unroll
            for (int k = 0; k < 8; ++k) s += RED[k * 64 + tid];
            FIN[tid] = rsqrtf(s * (1.0f / DV) + EPS); }
        __syncthreads();
    }
#pragma unroll
    for (int m = 0; m < 4; ++m)
#pragma unroll
        for (int n = 0; n < NTV; ++n)
#pragma unroll
            for (int j = 0; j < 4; ++j) { const int row = 16 * m + 4 * g + j, col = c0 + 16 * n + l15; float v = y[m][n][j];
                if (MODE == 0) { const float gt = bf2f(it.G[(size_t)row * it.ldv + col]); v = v * FIN[row] * (gt * fsigmoid(gt)); }
                else if (MODE == 1) { v = v * FIN[row] * cx.in[17][col] * 0.8f; }
                it.O[(size_t)row * it.ldo + col] = f2bf(v); }
    __syncthreads();
}


#define TR8(lo, hh, addr, base) asm volatile( \
    "ds_read_b64_tr_b16 %0, %8 offset:%c9\n\tds_read_b64_tr_b16 %4, %8 offset:%c10\n\t" \
    "ds_read_b64_tr_b16 %1, %8 offset:%c11\n\tds_read_b64_tr_b16 %5, %8 offset:%c12\n\t" \
    "ds_read_b64_tr_b16 %2, %8 offset:%c13\n\tds_read_b64_tr_b16 %6, %8 offset:%c14\n\t" \
    "ds_read_b64_tr_b16 %3, %8 offset:%c15\n\tds_read_b64_tr_b16 %7, %8 offset:%c16\n\ts_waitcnt lgkmcnt(0)" \
    : "=&v"(lo[0]), "=&v"(lo[1]), "=&v"(lo[2]), "=&v"(lo[3]), "=&v"(hh[0]), "=&v"(hh[1]), "=&v"(hh[2]), "=&v"(hh[3]) \
    : "v"(addr), "i"((base)), "i"((base) + 512), "i"((base) + 1024), "i"((base) + 1536), "i"((base) + 2048), "i"((base) + 2560), "i"((base) + 3072), "i"((base) + 3584) : "memory")
typedef float f32x16 __attribute__((ext_vector_type(16)));
struct FaUnit {
    const bf16_t* Q; int ldq;
    const bf16_t* K; int ldk;
    const bf16_t* V; int ldv;
    bf16_t* O; int ldo;
    int nt;
    int vis0;
    float c, mc, lam;
};
__device__ __forceinline__ int crow(int r, int hi) { return (r & 3) + 8 * (r >> 2) + 4 * hi; }
#define FA_WAIT_BAR() asm volatile("s_waitcnt vmcnt(0) lgkmcnt(0)\n\ts_barrier" ::: "memory")

template <int NM, int DQ, int NDVB, int MODE, int NPASS, bool QLDS>
__device__ __forceinline__ void fa_unit(LAS unsigned char* lds, const FaUnit& U, const Ctx& cx, int WV) {
    constexpr int NKP = NM * DQ / 8;
    constexpr int NVP = NDVB * 4;
    constexpr int KB = NKP * 1024, VB = NVP * 1024, SLOT = KB + VB;
    constexpr int OFF_WS = 2 * SLOT;
    constexpr int OFF_QL = OFF_WS + 8 * NM * 32 * 4;
    constexpr int NQF = NM * (DQ / 16);
    static_assert(OFF_QL + (QLDS ? NQF * 8192 : 0) <= ATT_BYTES, "fa LDS");
    static_assert(QLDS ? (8 * 32 * (NDVB * 64) <= NQF * 8192) : (8 * 32 * (NDVB * 64) <= OFF_WS), "fa stage");
    int tid = TID_OF(WV); asm volatile("" : "+v"(tid));
    const int w = __builtin_amdgcn_readfirstlane(tid >> 6), l = tid & 63, r32 = l & 31, hi = l >> 5;
    const unsigned kvo = (unsigned)(l * U.ldk * 2), vvo = (unsigned)((l >> 2) * U.ldv * 2 + (l & 3) * 16);
    const size_t ktile = (size_t)64 * U.ldk * 2, vtile = (size_t)64 * U.ldv * 2;
#define FA_DMA(t, slot) do { \
        const char* kb_ = (const char*)U.K + (size_t)(t) * ktile; const char* vb_ = (const char*)U.V + (size_t)(t) * vtile + ps * (64 * NDVB); \
        unsigned kvo_ = kvo, vvo_ = vvo; asm volatile("" : "+v"(kvo_), "+v"(vvo_));   \
        _Pragma("unroll") for (int i_ = 0; i_ < NKP / 8; ++i_) { const int ck = w + 8 * i_; \
            __builtin_amdgcn_global_load_lds((const unsigned*)(kb_ + ck * 16 + kvo_), (LAS unsigned*)(lds + (slot) * SLOT + ck * 1024), 16, 0, 0); } \
        _Pragma("unroll") for (int i_ = 0; i_ < NVP / 8; ++i_) { const int pv_ = w + 8 * i_, dvb_ = pv_ >> 2, kg_ = pv_ & 3; \
            __builtin_amdgcn_global_load_lds((const unsigned*)(vb_ + (size_t)(16 * kg_) * U.ldv * 2 + 64 * dvb_ + vvo_), (LAS unsigned*)(lds + (slot) * SLOT + KB + pv_ * 1024), 16, 0, 0); } \
    } while (0)
    bf16x8 qr[NM][DQ / 16];
    LAS unsigned char* qls = lds + OFF_QL + tid * 16;
    { const bf16_t* qp = U.Q + (size_t)(32 * w + r32) * U.ldq + 8 * hi;
#pragma unroll
      for (int r = 0; r < NM; ++r)
#pragma unroll
          for (int d0 = 0; d0 < DQ / 16; ++d0) { const bf16x8 v = *(const bf16x8*)(qp + r * DQ + 16 * d0);
              if (QLDS) *(LAS bf16x8*)(qls + (r * (DQ / 16) + d0) * 8192) = v; else qr[r][d0] = v; } }
#pragma unroll 1
    for (int ps = 0; ps < NPASS; ++ps) {
    FA_DMA(0, 0);
    float zf_ = 0.f; asm volatile("" : "+v"(zf_));
    f32x16 o[NM][NDVB];
#pragma unroll
    for (int r = 0; r < NM; ++r)
#pragma unroll
        for (int d = 0; d < NDVB; ++d)
#pragma unroll
            for (int i = 0; i < 16; ++i) o[r][d][i] = zf_;
    float lsum[NM];
#pragma unroll
    for (int r = 0; r < NM; ++r) lsum[r] = 0.f;
    const int vis = U.vis0 + (w >> 1);
    const int kfo = hi * 1024 + r32 * 16;
    const int vfo = (4 * hi + ((l & 15) >> 2)) * 64 + ((l >> 4) & 1) * 32 + (l & 3) * 8;
    FA_WAIT_BAR();
    for (int t = 0; t < U.nt; ++t) {
        const int slot = t & 1;
        if (t + 1 < U.nt) FA_DMA(t + 1, slot ^ 1);
        if (t <= vis) {
            const LAS unsigned char* kb = lds + slot * SLOT + kfo;
            const unsigned vba = (unsigned)(size_t)(lds + slot * SLOT + KB + vfo);
#pragma unroll
            for (int r = 0; r < NM; ++r) {
                bf16x8 pw[4]; float ls = 0.f;
#pragma unroll
                for (int kh = 0; kh < 2; ++kh) {
                    f32x16 p;
#pragma unroll
                    for (int i = 0; i < 16; ++i) p[i] = 0.f;
#pragma unroll
                    for (int d0 = 0; d0 < DQ / 16; ++d0) {
                        const bf16x8 a0 = *(const LAS bf16x8*)(kb + (r * (DQ / 8) + 2 * d0) * 1024 + kh * 512);
                        bf16x8 qf; if (QLDS) qf = *(const LAS bf16x8*)(qls + (r * (DQ / 16) + d0) * 8192); else qf = qr[r][d0];
                        p = __builtin_amdgcn_mfma_f32_32x32x16_bf16(a0, qf, p, 0, 0, 0);
                    }
#pragma unroll
                    for (int i = 0; i < 16; ++i) { p[i] = __builtin_amdgcn_exp2f(__builtin_fmaf(p[i], U.c, -U.mc)); ls += p[i]; }
                    u32x4 t0, t1;
                    t0.x = cvt_pk_bf16(p[0], p[1]); t0.y = cvt_pk_bf16(p[2], p[3]); t0.z = cvt_pk_bf16(p[4], p[5]); t0.w = cvt_pk_bf16(p[6], p[7]);
                    t1.x = cvt_pk_bf16(p[8], p[9]); t1.y = cvt_pk_bf16(p[10], p[11]); t1.z = cvt_pk_bf16(p[12], p[13]); t1.w = cvt_pk_bf16(p[14], p[15]);
                    pw[2 * kh] = __builtin_bit_cast(bf16x8, t0); pw[2 * kh + 1] = __builtin_bit_cast(bf16x8, t1);
                }
                lsum[r] += ls;
#pragma unroll
                for (int d = 0; d < NDVB; ++d) {
                    s16x4 lo[4], hh[4];
                    TR8(lo, hh, vba, d * 4096);
                    __builtin_amdgcn_sched_barrier(0);
#pragma unroll
                    for (int ks = 0; ks < 4; ++ks) {
                        const bf16x8 vf = (bf16x8){lo[ks][0], lo[ks][1], lo[ks][2], lo[ks][3], hh[ks][0], hh[ks][1], hh[ks][2], hh[ks][3]};
                        o[r][d] = __builtin_amdgcn_mfma_f32_32x32x16_bf16(pw[ks], vf, o[r][d], 0, 0, 0); }
                }
            }
        }
        FA_WAIT_BAR();
    }
#ifdef FA_NOEPI
    { float acc_ = lsum[0]; for (int r = 0; r < NM; ++r) for (int d = 0; d < NDVB; ++d) for (int i = 0; i < 16; ++i) acc_ += o[r][d][i]; U.O[tid] = f2bf(acc_); }
#else
    LAS float* wsf = (LAS float*)(lds + OFF_WS) + w * (NM * 32);
#pragma unroll
    for (int r = 0; r < NM; ++r) { const float v = sum_xor32(lsum[r]); if (hi == 0) wsf[r * 32 + r32] = __builtin_amdgcn_rcpf(v); }
    asm volatile("s_waitcnt lgkmcnt(0)" ::: "memory");
    char* ob = (char*)U.O + ((size_t)(32 * w) * U.ldo + ps * (32 * NDVB)) * 2;
    constexpr int SPITCH = NDVB * 64; LAS unsigned char* stg = lds + (QLDS ? OFF_QL : 0) + w * (32 * SPITCH);
    float wv[NDVB];
#pragma unroll
    for (int d = 0; d < NDVB; ++d) wv[d] = (MODE == 1) ? cx.in[17][32 * d + r32] * 0.8f : 1.0f;
#pragma unroll
    for (int i = 0; i < 16; ++i) {
        const int q = crow(i, hi); const float li0 = wsf[q]; float y[NDVB];
        if (MODE == 1) { const float li1 = wsf[(NM - 1) * 32 + q] * U.lam; float s2 = 0.f;
#pragma unroll
            for (int d = 0; d < NDVB; ++d) { y[d] = o[0][d][i] * li0 - o[NM - 1][d][i] * li1; s2 += y[d] * y[d]; }
            s2 = row32_sum(s2);
            const float rn = __builtin_amdgcn_rsqf(s2 * (1.0f / (32 * NDVB)) + EPS);
#pragma unroll
            for (int d = 0; d < NDVB; ++d) y[d] = y[d] * rn * wv[d]; }
        else {
#pragma unroll
            for (int d = 0; d < NDVB; ++d) y[d] = o[0][d][i] * li0; }
#pragma unroll
        for (int d = 0; d < NDVB; ++d) *(LAS bf16_t*)(stg + q * SPITCH + (32 * d + r32) * 2) = f2bf(y[d]);
    }
    asm volatile("s_waitcnt lgkmcnt(0)" ::: "memory");
#pragma unroll
    for (int it = 0; it < NDVB * 2; ++it) { const int c = it * 64 + l, row = c / (NDVB * 4), ch = c % (NDVB * 4);
        const u32x4 v = *(const LAS u32x4*)(stg + row * SPITCH + ch * 16);
        *(u32x4*)(ob + ((size_t)row * U.ldo + ch * 8) * 2) = v; }
#endif
    FA_WAIT_BAR();
    }
#undef FA_DMA
}


struct RetUnit {
    const bf16_t* Q; const bf16_t* K; const bf16_t* V;
    const bf16_t* G; bf16_t* O;
    int nt;
    int c0;
    float lg;
};
__device__ __forceinline__ void fa_ret_unit(LAS unsigned char* lds, const RetUnit& U, int WV) {
    constexpr int LDQ = 512, LDK = 512, LDV = 1024, LDO = 1024;
    constexpr int KB = 16384, SLOT = 49152, OFF_QP = 2 * SLOT, OFF_WS = OFF_QP + 4 * 14 * 1024;
    static_assert(OFF_WS + 8 * 32 * 4 <= ATT_BYTES, "ret LDS");
    int tid = TID_OF(WV); asm volatile("" : "+v"(tid));
    const int w = __builtin_amdgcn_readfirstlane(tid >> 6), l = tid & 63, r32 = l & 31, hi = l >> 5, rb = w >> 1, dh = w & 1;
    const unsigned kvo = (unsigned)((l & 31) * LDK * 2 + (l >> 5) * 16), vvo = (unsigned)((l >> 2) * LDV * 2 + (l & 3) * 16);
#define RT_DMA(t, slot) do { \
        const char* kb_ = (const char*)U.K + (size_t)(t) * (32 * LDK * 2); const char* vb_ = (const char*)U.V + (size_t)(t) * (32 * LDV * 2); \
        unsigned kvo_ = kvo, vvo_ = vvo; asm volatile("" : "+v"(kvo_), "+v"(vvo_)); \
        _Pragma("unroll") for (int i_ = 0; i_ < 2; ++i_) { const int cp = w + 8 * i_; \
            __builtin_amdgcn_global_load_lds((const unsigned*)(kb_ + cp * 32 + kvo_), (LAS unsigned*)(lds + (slot) * SLOT + cp * 1024), 16, 0, 0); } \
        _Pragma("unroll") for (int i_ = 0; i_ < 4; ++i_) { const int pv_ = w + 8 * i_, dvb_ = pv_ >> 1, kg_ = pv_ & 1; \
            __builtin_amdgcn_global_load_lds((const unsigned*)(vb_ + kg_ * (16 * LDV * 2) + 64 * dvb_ + vvo_), (LAS unsigned*)(lds + (slot) * SLOT + KB + pv_ * 1024), 16, 0, 0); } \
    } while (0)
    RT_DMA(0, 0);
    bf16x8 q0r, q1r;
    { const bf16_t* qp = U.Q + (size_t)(32 * rb + r32) * LDQ + 8 * hi; LAS unsigned char* qpk = lds + OFF_QP + rb * 14336 + l * 16;
      q0r = *(const bf16x8*)(qp); q1r = *(const bf16x8*)(qp + 16);
      if (dh == 0) {
#pragma unroll
          for (int d0 = 2; d0 < 16; ++d0) *(LAS bf16x8*)(qpk + (d0 - 2) * 1024) = *(const bf16x8*)(qp + 16 * d0); } }
    f32x16 o[8];
#pragma unroll
    for (int d = 0; d < 8; ++d)
#pragma unroll
        for (int i = 0; i < 16; ++i) o[d][i] = 0.f;
    const int cw = U.c0 + (rb >> 1);
    const int kfo = hi * 512 + r32 * 16;
    const int vfo = (4 * hi + ((l & 15) >> 2)) * 64 + ((l >> 4) & 1) * 32 + (l & 3) * 8;
    const LAS unsigned char* qpk = lds + OFF_QP + rb * 14336 + l * 16;
    const float qpos = (float)(64 * U.c0 + 32 * rb + r32);
    FA_WAIT_BAR();
    for (int t = 0; t < U.nt; ++t) {
        const int slot = t & 1;
        if (t + 1 < U.nt) RT_DMA(t + 1, slot ^ 1);
        if ((t >> 1) <= cw) {
            const LAS unsigned char* kb = lds + slot * SLOT + kfo;
            const unsigned vba = (unsigned)(size_t)(lds + slot * SLOT + KB + dh * 16384 + vfo);
            f32x16 p;
#pragma unroll
            for (int i = 0; i < 16; ++i) p[i] = 0.f;
            {
                bf16x8 ka[2][4], qa[2][4];
#define RT_LOADB(buf, b_) do { _Pragma("unroll") for (int j = 0; j < 4; ++j) { const int d0 = 4 * (b_) + j; ka[buf][j] = *(const LAS bf16x8*)(kb + d0 * 1024); \
                    if (d0 == 0) qa[buf][j] = q0r; else if (d0 == 1) qa[buf][j] = q1r; else qa[buf][j] = *(const LAS bf16x8*)(qpk + (d0 - 2) * 1024); } } while (0)
                RT_LOADB(0, 0);
#pragma unroll
                for (int b_ = 0; b_ < 4; ++b_) {
                    if (b_ < 3) RT_LOADB((b_ + 1) & 1, b_ + 1);
                    __builtin_amdgcn_sched_barrier(0);
#pragma unroll
                    for (int j = 0; j < 4; ++j) p = __builtin_amdgcn_mfma_f32_32x32x16_bf16(ka[b_ & 1][j], qa[b_ & 1][j], p, 0, 0, 0);
                    __builtin_amdgcn_sched_barrier(0);
                }
#undef RT_LOADB
            }
            const float dq = qpos - (float)(32 * t + 4 * hi);
#pragma unroll
            for (int i = 0; i < 16; ++i) { const float dd = dq - (float)((i & 3) + 8 * (i >> 2)); p[i] *= __builtin_amdgcn_exp2f(U.lg * __builtin_fabsf(dd)); }
            bf16x8 pw0, pw1;
            { u32x4 t0, t1;
              t0.x = cvt_pk_bf16(p[0], p[1]); t0.y = cvt_pk_bf16(p[2], p[3]); t0.z = cvt_pk_bf16(p[4], p[5]); t0.w = cvt_pk_bf16(p[6], p[7]);
              t1.x = cvt_pk_bf16(p[8], p[9]); t1.y = cvt_pk_bf16(p[10], p[11]); t1.z = cvt_pk_bf16(p[12], p[13]); t1.w = cvt_pk_bf16(p[14], p[15]);
              pw0 = __builtin_bit_cast(bf16x8, t0); pw1 = __builtin_bit_cast(bf16x8, t1); }
            {
#pragma unroll
                for (int dp = 0; dp < 4; ++dp) {
                    s16x4 lo[4], hh[4];
                    TR8(lo, hh, vba, dp * 4096);
                    __builtin_amdgcn_sched_barrier(0);
#pragma unroll
                    for (int j = 0; j < 4; ++j) {
                        const bf16x8 vf = (bf16x8){lo[j][0], lo[j][1], lo[j][2], lo[j][3], hh[j][0], hh[j][1], hh[j][2], hh[j][3]};
                        o[dp * 2 + (j >> 1)] = __builtin_amdgcn_mfma_f32_32x32x16_bf16((j & 1) ? pw1 : pw0, vf, o[dp * 2 + (j >> 1)], 0, 0, 0); }
                }
            }
        }
        FA_WAIT_BAR();
    }
#undef RT_DMA
    LAS float* wsf = (LAS float*)(lds + OFF_WS);
    float ssr[16];
#pragma unroll
    for (int i = 0; i < 16; ++i) { float s2 = 0.f;
#pragma unroll
        for (int d = 0; d < 8; ++d) s2 += o[d][i] * o[d][i];
        s2 = row32_sum(s2);
        ssr[i] = s2; if (r32 == 0) wsf[w * 32 + crow(i, hi)] = s2; }
    FA_WAIT_BAR();
    const size_t gbase = (size_t)(32 * rb) * LDO + 256 * dh + r32;
#pragma unroll
    for (int i = 0; i < 16; ++i) {
        const int q = crow(i, hi); const float rn = rsqrtf((ssr[i] + wsf[(w ^ 1) * 32 + q]) * (1.0f / 512.0f) + EPS);
        const size_t ro = gbase + (size_t)q * LDO;
#pragma unroll
        for (int d = 0; d < 8; ++d) { const float gt = bf2f(U.G[ro + 32 * d]); U.O[ro + 32 * d] = f2bf(o[d][i] * rn * (gt * fsigmoid(gt))); }
        __builtin_amdgcn_sched_barrier(0);
    }
    FA_WAIT_BAR();
}


struct Ret2Unit {
    const bf16_t* Q; const bf16_t* K; const bf16_t* V;
    const bf16_t* G; bf16_t* O; float* SS;
    int nt, c0; float lg;
};
__device__ __forceinline__ void fa_ret2_unit(LAS unsigned char* lds, const Ret2Unit& U, int WV) {
    constexpr int LDQ = 512, LDK = 512, LDV = 1024, LDO = 1024;
    constexpr int KB = 16384, SLOT = 32768, NS = 3, OFF_WS = NS * SLOT;
    static_assert(OFF_WS + 8 * 32 * 4 <= ATT_BYTES, "ret2 LDS");
    int tid = TID_OF(WV); asm volatile("" : "+v"(tid));
    const int w = __builtin_amdgcn_readfirstlane(tid >> 6), l = tid & 63, r32 = l & 31, hi = l >> 5, rb = w >> 1, dq = w & 1;
    const unsigned kvo = (unsigned)((l & 31) * LDK * 2 + (l >> 5) * 16), vvo = (unsigned)((l >> 2) * LDV * 2 + (l & 3) * 16);
#define R2_DMA(t, slot) do { \
        const char* kb_ = (const char*)U.K + (size_t)(t) * (32 * LDK * 2); const char* vb_ = (const char*)U.V + (size_t)(t) * (32 * LDV * 2); \
        unsigned kvo_ = kvo, vvo_ = vvo; asm volatile("" : "+v"(kvo_), "+v"(vvo_)); \
        _Pragma("unroll") for (int i_ = 0; i_ < 2; ++i_) { const int cp = w + 8 * i_; \
            __builtin_amdgcn_global_load_lds((const unsigned*)(kb_ + cp * 32 + kvo_), (LAS unsigned*)(lds + (slot) * SLOT + cp * 1024), 16, 0, 0); } \
        _Pragma("unroll") for (int i_ = 0; i_ < 2; ++i_) { const int pv_ = w + 8 * i_, dvb_ = pv_ >> 1, kg_ = pv_ & 1; \
            __builtin_amdgcn_global_load_lds((const unsigned*)(vb_ + kg_ * (16 * LDV * 2) + 64 * dvb_ + vvo_), (LAS unsigned*)(lds + (slot) * SLOT + KB + pv_ * 1024), 16, 0, 0); } \
    } while (0)
    R2_DMA(0, 0);
    if (U.nt > 1) R2_DMA(1, 1);
    bf16x8 qr[16];
    { const bf16_t* qp = U.Q + (size_t)(32 * rb + r32) * LDQ + 8 * hi;
#pragma unroll
      for (int d0 = 0; d0 < 16; ++d0) qr[d0] = *(const bf16x8*)(qp + 16 * d0); }
    f32x16 o[4];
    { float z = 0.f; asm volatile("" : "+v"(z));
#pragma unroll
    for (int d = 0; d < 4; ++d)
#pragma unroll
        for (int i = 0; i < 16; ++i) o[d][i] = z; }
    const int cw = U.c0 + (rb >> 1);
    const int kfo = hi * 512 + r32 * 16;
    const int vfo = (4 * hi + ((l & 15) >> 2)) * 64 + ((l >> 4) & 1) * 32 + (l & 3) * 8;
    const float qpos = (float)(64 * U.c0 + 32 * rb + r32);
    float cf[16];
#pragma unroll
    for (int i = 0; i < 16; ++i) cf[i] = __builtin_amdgcn_exp2f(-U.lg * (float)((i & 3) + 8 * (i >> 2)));
    asm volatile("s_waitcnt vmcnt(0) lgkmcnt(0)\n\ts_barrier" ::: "memory");
    int slot = 0;
    for (int t = 0; t < U.nt; ++t) {
        const int s2 = (slot >= 1) ? slot - 1 : 2;
        const bool more = (t + 2 < U.nt);
        if ((t >> 1) <= cw) {
            const LAS unsigned char* kb = lds + slot * SLOT + kfo;
            const unsigned vba = (unsigned)(size_t)(lds + slot * SLOT + KB + dq * 8192 + vfo);
            f32x16 p;
#pragma unroll
            for (int i = 0; i < 16; ++i) p[i] = 0.f;
            {   bf16x8 ka[2][4];
#define R2_LOADB(buf, b_) do { _Pragma("unroll") for (int j = 0; j < 4; ++j) ka[buf][j] = *(const LAS bf16x8*)(kb + (4 * (b_) + j) * 1024); } while (0)
                R2_LOADB(0, 0);
#pragma unroll
                for (int b_ = 0; b_ < 4; ++b_) {
                    if (b_ < 3) R2_LOADB((b_ + 1) & 1, b_ + 1);
                    __builtin_amdgcn_sched_barrier(0);
#pragma unroll
                    for (int j = 0; j < 4; ++j) p = __builtin_amdgcn_mfma_f32_32x32x16_bf16(ka[b_ & 1][j], qr[4 * b_ + j], p, 0, 0, 0);
                    __builtin_amdgcn_sched_barrier(0);
                }
#undef R2_LOADB
            }
            const float dqp = qpos - (float)(32 * t + 4 * hi);
            if ((t >> 1) < cw) {
                const float rowf = __builtin_amdgcn_exp2f(U.lg * dqp);
#pragma unroll
                for (int i = 0; i < 16; ++i) p[i] *= rowf * cf[i];
            } else {
#pragma unroll
                for (int i = 0; i < 16; ++i) { const float dd = dqp - (float)((i & 3) + 8 * (i >> 2)); p[i] *= __builtin_amdgcn_exp2f(U.lg * __builtin_fabsf(dd)); }
            }
            bf16x8 pw0, pw1;
            { u32x4 t0, t1;
              t0.x = cvt_pk_bf16(p[0], p[1]); t0.y = cvt_pk_bf16(p[2], p[3]); t0.z = cvt_pk_bf16(p[4], p[5]); t0.w = cvt_pk_bf16(p[6], p[7]);
              t1.x = cvt_pk_bf16(p[8], p[9]); t1.y = cvt_pk_bf16(p[10], p[11]); t1.z = cvt_pk_bf16(p[12], p[13]); t1.w = cvt_pk_bf16(p[14], p[15]);
              pw0 = __builtin_bit_cast(bf16x8, t0); pw1 = __builtin_bit_cast(bf16x8, t1); }
            {
                const LAS unsigned char* vbp = lds + slot * SLOT + KB + dq * 8192 + vfo;
#pragma unroll
                for (int dp = 0; dp < 2; ++dp)
#pragma unroll
                    for (int j = 0; j < 4; ++j) {
                        const s16x4 lo = ds_tr16(vbp + (dp * 4 + j) * 1024), hh = ds_tr16(vbp + (dp * 4 + j) * 1024 + 512);
                        const bf16x8 vf = (bf16x8){lo[0], lo[1], lo[2], lo[3], hh[0], hh[1], hh[2], hh[3]};
                        o[dp * 2 + (j >> 1)] = __builtin_amdgcn_mfma_f32_32x32x16_bf16((j & 1) ? pw1 : pw0, vf, o[dp * 2 + (j >> 1)], 0, 0, 0); }
            }
        }
        if (more) R2_DMA(t + 2, s2);
        if (more) asm volatile("s_waitcnt vmcnt(4) lgkmcnt(0)\n\ts_barrier" ::: "memory");
        else asm volatile("s_waitcnt vmcnt(0) lgkmcnt(0)\n\ts_barrier" ::: "memory");
        slot = (slot == 2) ? 0 : slot + 1;
    }
#undef R2_DMA
    LAS float* wsf = (LAS float*)(lds + OFF_WS);
    float ssr[16];
#pragma unroll
    for (int i = 0; i < 16; ++i) { float s2v = 0.f;
#pragma unroll
        for (int d = 0; d < 4; ++d) s2v += o[d][i] * o[d][i];
        s2v = row32_sum(s2v);
        ssr[i] = s2v; if (r32 == 0) wsf[w * 32 + crow(i, hi)] = s2v; }
    FA_WAIT_BAR();
    if (dq == 0 && r32 == 0) {
#pragma unroll
        for (int i = 0; i < 16; ++i) { const int q = crow(i, hi); U.SS[(size_t)(32 * rb + q) * 8] = ssr[i] + wsf[(w ^ 1) * 32 + q]; } }
    const size_t gbase = (size_t)(32 * rb) * LDO + 128 * dq + r32;
#pragma unroll
    for (int i = 0; i < 16; ++i) {
        const size_t ro = gbase + (size_t)crow(i, hi) * LDO;
#pragma unroll
        for (int d = 0; d < 4; ++d) { const float gt = bf2f(U.G[ro + 32 * d]); U.O[ro + 32 * d] = f2bf(o[d][i] * (gt * fsigmoid(gt))); }
        __builtin_amdgcn_sched_barrier(0);
    }
    FA_WAIT_BAR();
}

struct Ret3Unit {
    const bf16_t* Q; const bf16_t* K; const bf16_t* V;
    const bf16_t* G; bf16_t* O; float* SS;
    const bf16_t* ST;
    int nst, nt, c0; float lg;
};
__device__ __forceinline__ void fa_ret3_unit(LAS unsigned char* lds, const Ret3Unit& U, int WV) {
    constexpr int LDQ = 512, LDK = 512, LDV = 1024, LDO = 1024;
    constexpr int KB = 16384, SLOT = 32768, NS = 3, OFF_WS = NS * SLOT;
    static_assert(OFF_WS + 8 * 32 * 4 <= ATT_BYTES, "ret2 LDS");
    int tid = TID_OF(WV); asm volatile("" : "+v"(tid));
    const int w = __builtin_amdgcn_readfirstlane(tid >> 6), l = tid & 63, r32 = l & 31, hi = l >> 5, rb = w >> 1, dq = w & 1;
    const unsigned kvo = (unsigned)((l & 31) * LDK * 2 + (l >> 5) * 16), vvo = (unsigned)((l >> 2) * LDV * 2 + (l & 3) * 16);
#define R3_DMA(t, slot) do { \
        const char* kb_ = (const char*)U.K + (size_t)(t) * (32 * LDK * 2); const char* vb_ = (const char*)U.V + (size_t)(t) * (32 * LDV * 2); \
        unsigned kvo_ = kvo, vvo_ = vvo; asm volatile("" : "+v"(kvo_), "+v"(vvo_)); \
        _Pragma("unroll") for (int i_ = 0; i_ < 2; ++i_) { const int cp = w + 8 * i_; \
            __builtin_amdgcn_global_load_lds((const unsigned*)(kb_ + cp * 32 + kvo_), (LAS unsigned*)(lds + (slot) * SLOT + cp * 1024), 16, 0, 0); } \
        _Pragma("unroll") for (int i_ = 0; i_ < 2; ++i_) { const int pv_ = w + 8 * i_, dvb_ = pv_ >> 1, kg_ = pv_ & 1; \
            __builtin_amdgcn_global_load_lds((const unsigned*)(vb_ + kg_ * (16 * LDV * 2) + 64 * dvb_ + vvo_), (LAS unsigned*)(lds + (slot) * SLOT + KB + pv_ * 1024), 16, 0, 0); } \
    } while (0)
    const unsigned svo = (unsigned)(l * 512);
#define R3_DMAS(ts, slot) do { const char* sb_ = (const char*)U.ST + (size_t)((ts) >> 2) * (512 * 256 * 2) + ((ts) & 3) * 128; unsigned svo_ = svo; asm volatile("" : "+v"(svo_)); \
        _Pragma("unroll") for (int i_ = 0; i_ < 4; ++i_) { const int p_ = w + 8 * i_, c_ = p_ >> 2, dvq_ = p_ & 3; \
            __builtin_amdgcn_global_load_lds((const unsigned*)(sb_ + dvq_ * (64 * 512) + c_ * 16 + svo_), (LAS unsigned*)(lds + (slot) * SLOT + p_ * 1024), 16, 0, 0); } \
    } while (0)
#define R3_ANY(tt, slot) do { if ((tt) < nst) R3_DMAS((tt), (slot)); else R3_DMA((tt) - nst, (slot)); } while (0)
    const int nst = U.nst;
    R3_ANY(0, 0);
    R3_ANY(1, 1);
    bf16x8 qr[16];
    { const bf16_t* qp = U.Q + (size_t)(32 * rb + r32) * LDQ + 8 * hi;
#pragma unroll
      for (int d0 = 0; d0 < 16; ++d0) qr[d0] = *(const bf16x8*)(qp + 16 * d0); }
    f32x16 o[4];
    { float z = 0.f; asm volatile("" : "+v"(z));
#pragma unroll
    for (int d = 0; d < 4; ++d)
#pragma unroll
        for (int i = 0; i < 16; ++i) o[d][i] = z; }
    const int cw = U.c0 + (rb >> 1);
    const int kfo = hi * 512 + r32 * 16;
    const int vfo = (4 * hi + ((l & 15) >> 2)) * 64 + ((l >> 4) & 1) * 32 + (l & 3) * 8;
    const float qpos = (float)(64 * U.c0 + 32 * rb + r32);
    float cf[16];
#pragma unroll
    for (int i = 0; i < 16; ++i) cf[i] = __builtin_amdgcn_exp2f(-U.lg * (float)((i & 3) + 8 * (i >> 2)));
    asm volatile("s_waitcnt vmcnt(0) lgkmcnt(0)\n\ts_barrier" ::: "memory");
    int slot = 0;
    if (nst) {
        const float g512 = __builtin_amdgcn_exp2f(U.lg * 512.0f);
        const int ngrp = nst >> 2;
        for (int grp = 0; grp < ngrp; ++grp) {
            if (grp) {
#pragma unroll
                for (int d = 0; d < 4; ++d)
#pragma unroll
                    for (int i = 0; i < 16; ++i) o[d][i] *= g512; }
#pragma unroll
            for (int ts = 0; ts < 4; ++ts) {
                const LAS unsigned char* sb = lds + slot * SLOT + hi * 4096 + (128 * dq + r32) * 16;
#pragma unroll
                for (int d0l = 0; d0l < 4; ++d0l) {
                    bf16x8 sf[4];
#pragma unroll
                    for (int d = 0; d < 4; ++d) sf[d] = *(const LAS bf16x8*)(sb + d0l * 8192 + d * 512);
#pragma unroll
                    for (int d = 0; d < 4; ++d) o[d] = __builtin_amdgcn_mfma_f32_32x32x16_bf16(qr[4 * ts + d0l], sf[d], o[d], 0, 0, 0);
                }
                const int s2 = (slot >= 1) ? slot - 1 : 2;
                R3_ANY(4 * grp + ts + 2, s2);
                asm volatile("s_waitcnt vmcnt(4) lgkmcnt(0)\n\ts_barrier" ::: "memory");
                slot = (slot == 2) ? 0 : slot + 1;
            }
        }
#pragma unroll
        for (int i = 0; i < 16; ++i) { const float rf = __builtin_amdgcn_exp2f(U.lg * (float)(64 * U.c0 + 32 * rb + crow(i, hi) + 1));
#pragma unroll
            for (int d = 0; d < 4; ++d) o[d][i] *= rf; }
    }
    for (int t = 0; t < U.nt; ++t) {
        const int s2 = (slot >= 1) ? slot - 1 : 2;
        const bool more = (t + 2 < U.nt);
        if ((t >> 1) <= cw) {
            const LAS unsigned char* kb = lds + slot * SLOT + kfo;
            const unsigned vba = (unsigned)(size_t)(lds + slot * SLOT + KB + dq * 8192 + vfo);
            f32x16 p;
#pragma unroll
            for (int i = 0; i < 16; ++i) p[i] = 0.f;
            {   bf16x8 ka[2][4];
#define R3_LOADB(buf, b_) do { _Pragma("unroll") for (int j = 0; j < 4; ++j) ka[buf][j] = *(const LAS bf16x8*)(kb + (4 * (b_) + j) * 1024); } while (0)
                R3_LOADB(0, 0);
#pragma unroll
                for (int b_ = 0; b_ < 4; ++b_) {
                    if (b_ < 3) R3_LOADB((b_ + 1) & 1, b_ + 1);
                    __builtin_amdgcn_sched_barrier(0);
#pragma unroll
                    for (int j = 0; j < 4; ++j) p = __builtin_amdgcn_mfma_f32_32x32x16_bf16(ka[b_ & 1][j], qr[4 * b_ + j], p, 0, 0, 0);
                    __builtin_amdgcn_sched_barrier(0);
                }
#undef R3_LOADB
            }
            const float dqp = qpos - (float)(32 * t + 4 * hi);
            if ((t >> 1) < cw) {
                const float rowf = __builtin_amdgcn_exp2f(U.lg * dqp);
#pragma unroll
                for (int i = 0; i < 16; ++i) p[i] *= rowf * cf[i];
            } else {
#pragma unroll
                for (int i = 0; i < 16; ++i) { const float dd = dqp - (float)((i & 3) + 8 * (i >> 2)); p[i] *= __builtin_amdgcn_exp2f(U.lg * __builtin_fabsf(dd)); }
            }
            bf16x8 pw0, pw1;
            { u32x4 t0, t1;
              t0.x = cvt_pk_bf16(p[0], p[1]); t0.y = cvt_pk_bf16(p[2], p[3]); t0.z = cvt_pk_bf16(p[4], p[5]); t0.w = cvt_pk_bf16(p[6], p[7]);
              t1.x = cvt_pk_bf16(p[8], p[9]); t1.y = cvt_pk_bf16(p[10], p[11]); t1.z = cvt_pk_bf16(p[12], p[13]); t1.w = cvt_pk_bf16(p[14], p[15]);
              pw0 = __builtin_bit_cast(bf16x8, t0); pw1 = __builtin_bit_cast(bf16x8, t1); }
            {
                const LAS unsigned char* vbp = lds + slot * SLOT + KB + dq * 8192 + vfo;
#pragma unroll
                for (int dp = 0; dp < 2; ++dp)
#pragma unroll
                    for (int j = 0; j < 4; ++j) {
                        const s16x4 lo = ds_tr16(vbp + (dp * 4 + j) * 1024), hh = ds_tr16(vbp + (dp * 4 + j) * 1024 + 512);
                        const bf16x8 vf = (bf16x8){lo[0], lo[1], lo[2], lo[3], hh[0], hh[1], hh[2], hh[3]};
                        o[dp * 2 + (j >> 1)] = __builtin_amdgcn_mfma_f32_32x32x16_bf16((j & 1) ? pw1 : pw0, vf, o[dp * 2 + (j >> 1)], 0, 0, 0); }
            }
        }
        if (more) R3_DMA(t + 2, s2);
        if (more) asm volatile("s_waitcnt vmcnt(4) lgkmcnt(0)\n\ts_barrier" ::: "memory");
        else asm volatile("s_waitcnt vmcnt(0) lgkmcnt(0)\n\ts_barrier" ::: "memory");
        slot = (slot == 2) ? 0 : slot + 1;
    }
#undef R3_DMA
#undef R3_DMAS
#undef R3_ANY
    LAS float* wsf = (LAS float*)(lds + OFF_WS);
    float ssr[16];
#pragma unroll
    for (int i = 0; i < 16; ++i) { float s2v = 0.f;
#pragma unroll
        for (int d = 0; d < 4; ++d) s2v += o[d][i] * o[d][i];
        s2v = row32_sum(s2v);
        ssr[i] = s2v; if (r32 == 0) wsf[w * 32 + crow(i, hi)] = s2v; }
    FA_WAIT_BAR();
    if (dq == 0 && r32 == 0) {
#pragma unroll
        for (int i = 0; i < 16; ++i) { const int q = crow(i, hi); U.SS[(size_t)(32 * rb + q) * 8] = ssr[i] + wsf[(w ^ 1) * 32 + q]; } }
    { LAS unsigned char* stg = lds + w * 8192; const char* gb = (const char*)U.G + ((size_t)(32 * rb) * LDO + 128 * dq) * 2; char* obp = (char*)U.O + ((size_t)(32 * rb) * LDO + 128 * dq) * 2;
      u32x4 gq[8];
#pragma unroll
      for (int it = 0; it < 8; ++it) { const int c = it * 64 + l, row = c >> 4, ch = c & 15; gq[it] = *(const u32x4*)(gb + ((size_t)row * LDO + ch * 8) * 2); }
#pragma unroll
      for (int it = 0; it < 8; ++it) { const int c = it * 64 + l, row = c >> 4, ch = c & 15; *(LAS u32x4*)(stg + row * 256 + ch * 16) = gq[it]; }
      asm volatile("s_waitcnt lgkmcnt(0)" ::: "memory");
#pragma unroll
      for (int i = 0; i < 16; ++i) { const int q = crow(i, hi);
#pragma unroll
          for (int d = 0; d < 4; ++d) { LAS bf16_t* sp = (LAS bf16_t*)(stg + q * 256 + (32 * d + r32) * 2); const float gt = bf2f(*sp); *sp = f2bf(o[d][i] * (gt * fsigmoid(gt))); } }
      asm volatile("s_waitcnt lgkmcnt(0)" ::: "memory");
#pragma unroll
      for (int it = 0; it < 8; ++it) { const int c = it * 64 + l, row = c >> 4, ch = c & 15; *(u32x4*)(obp + ((size_t)row * LDO + ch * 8) * 2) = *(const LAS u32x4*)(stg + row * 256 + ch * 16); } }
    FA_WAIT_BAR();
}


struct StJob { const bf16_t* K; const bf16_t* V; bf16_t* ST; int nt; float lg; };
__device__ __forceinline__ void st_job(LAS unsigned char* lds, const StJob& J, int WV) {
    constexpr int LDK = 512, LDV = 1024, VB = 16384, SLOT = 49152;
    static_assert(2 * SLOT <= ATT_BYTES, "st LDS");
    int tid = TID_OF(WV); asm volatile("" : "+v"(tid));
    const int w = __builtin_amdgcn_readfirstlane(tid >> 6), l = tid & 63, r32 = l & 31, hi = l >> 5, wm = w >> 1, wn = w & 1;
    const unsigned vvo = (unsigned)((l >> 2) * LDV * 2 + (l & 3) * 16), kvo = (unsigned)((l >> 2) * LDK * 2 + (l & 3) * 16);
#define ST_DMA(t, slot) do { const char* vb_ = (const char*)J.V + (size_t)(t) * (64 * LDV * 2); const char* kb_ = (const char*)J.K + (size_t)(t) * (64 * LDK * 2); \
        unsigned vvo_ = vvo, kvo_ = kvo; asm volatile("" : "+v"(vvo_), "+v"(kvo_)); \
        _Pragma("unroll") for (int i_ = 0; i_ < 2; ++i_) { const int p_ = w + 8 * i_, blk_ = p_ >> 2, kg_ = p_ & 3; \
            __builtin_amdgcn_global_load_lds((const unsigned*)(vb_ + kg_ * (16 * LDV * 2) + 64 * blk_ + vvo_), (LAS unsigned*)(lds + (slot) * SLOT + p_ * 1024), 16, 0, 0); } \
        _Pragma("unroll") for (int i_ = 0; i_ < 4; ++i_) { const int p_ = w + 8 * i_, blk_ = p_ >> 2, kg_ = p_ & 3; \
            __builtin_amdgcn_global_load_lds((const unsigned*)(kb_ + kg_ * (16 * LDK * 2) + 64 * blk_ + kvo_), (LAS unsigned*)(lds + (slot) * SLOT + VB + p_ * 1024), 16, 0, 0); } \
    } while (0)
    ST_DMA(0, 0);
    f32x16 acc[4];
    { float z = 0.f; asm volatile("" : "+v"(z));
#pragma unroll
    for (int d = 0; d < 4; ++d)
#pragma unroll
        for (int i = 0; i < 16; ++i) acc[d][i] = z; }
    float gj[8], gs[4];
#pragma unroll
    for (int j = 0; j < 8; ++j) gj[j] = __builtin_amdgcn_exp2f(-J.lg * (float)(8 * (j >> 2) + (j & 3)));
#pragma unroll
    for (int sI = 0; sI < 4; ++sI) gs[sI] = __builtin_amdgcn_exp2f(J.lg * (float)(63 - 16 * sI - 4 * hi));
    const float g64 = __builtin_amdgcn_exp2f(J.lg * 64.0f);
    const int tfo = (4 * hi + ((l & 15) >> 2)) * 64 + ((l >> 4) & 1) * 32 + (l & 3) * 8;
    FA_WAIT_BAR();
    for (int t = 0; t < J.nt; ++t) {
        const int slot = t & 1;
        if (t + 1 < J.nt) ST_DMA(t + 1, slot ^ 1);
#pragma unroll
        for (int d = 0; d < 4; ++d)
#pragma unroll
            for (int i = 0; i < 16; ++i) acc[d][i] *= g64;
        const unsigned va = (unsigned)(size_t)(lds + slot * SLOT + wm * 4096 + tfo);
        const unsigned ka = (unsigned)(size_t)(lds + slot * SLOT + VB + wn * 16384 + tfo);
#pragma unroll
        for (int sI = 0; sI < 4; ++sI) {
            s16x4 vlo, vhh, klo[4], khh[4];
            asm volatile("ds_read_b64_tr_b16 %0, %10 offset:%c12\n\tds_read_b64_tr_b16 %1, %10 offset:%c13\n\t"
                         "ds_read_b64_tr_b16 %2, %11 offset:%c14\n\tds_read_b64_tr_b16 %3, %11 offset:%c15\n\t"
                         "ds_read_b64_tr_b16 %4, %11 offset:%c16\n\tds_read_b64_tr_b16 %5, %11 offset:%c17\n\t"
                         "ds_read_b64_tr_b16 %6, %11 offset:%c18\n\tds_read_b64_tr_b16 %7, %11 offset:%c19\n\t"
                         "ds_read_b64_tr_b16 %8, %11 offset:%c20\n\tds_read_b64_tr_b16 %9, %11 offset:%c21\n\ts_waitcnt lgkmcnt(0)"
                         : "=&v"(vlo), "=&v"(vhh), "=&v"(klo[0]), "=&v"(khh[0]), "=&v"(klo[1]), "=&v"(khh[1]), "=&v"(klo[2]), "=&v"(khh[2]), "=&v"(klo[3]), "=&v"(khh[3])
                         : "v"(va), "v"(ka), "i"(sI * 1024), "i"(sI * 1024 + 512),
                           "i"(0 * 4096 + sI * 1024), "i"(0 * 4096 + sI * 1024 + 512), "i"(1 * 4096 + sI * 1024), "i"(1 * 4096 + sI * 1024 + 512),
                           "i"(2 * 4096 + sI * 1024), "i"(2 * 4096 + sI * 1024 + 512), "i"(3 * 4096 + sI * 1024), "i"(3 * 4096 + sI * 1024 + 512) : "memory");
            __builtin_amdgcn_sched_barrier(0);
            float x[8];
#pragma unroll
            for (int j = 0; j < 4; ++j) { x[j] = bf2f((unsigned short)vlo[j]) * (gs[sI] * gj[j]); x[4 + j] = bf2f((unsigned short)vhh[j]) * (gs[sI] * gj[4 + j]); }
            u32x4 aw; aw.x = cvt_pk_bf16(x[0], x[1]); aw.y = cvt_pk_bf16(x[2], x[3]); aw.z = cvt_pk_bf16(x[4], x[5]); aw.w = cvt_pk_bf16(x[6], x[7]);
            const bf16x8 af = __builtin_bit_cast(bf16x8, aw);
#pragma unroll
            for (int d = 0; d < 4; ++d) { const bf16x8 kf = (bf16x8){klo[d][0], klo[d][1], klo[d][2], klo[d][3], khh[d][0], khh[d][1], khh[d][2], khh[d][3]};
                acc[d] = __builtin_amdgcn_mfma_f32_32x32x16_bf16(af, kf, acc[d], 0, 0, 0); }
        }
        FA_WAIT_BAR();
    }
#undef ST_DMA
    const int odd = l & 1;
    unsigned* op = (unsigned*)(J.ST + (size_t)(32 * wm) * 256 + 128 * wn + (r32 & ~1));
#pragma unroll
    for (int i = 0; i < 16; ++i) {
#pragma unroll
        for (int dp = 0; dp < 2; ++dp) {
            const float mine = odd ? acc[2 * dp + 1][i] : acc[2 * dp][i], give = odd ? acc[2 * dp][i] : acc[2 * dp + 1][i];
            const float got = dppf<0xB1>(give);
            const unsigned w2 = odd ? cvt_pk_bf16(got, mine) : cvt_pk_bf16(mine, got);
            __hip_atomic_store(op + ((size_t)crow(i, hi) * 256 + 32 * (2 * dp + odd)) / 2, w2, __ATOMIC_RELAXED, __HIP_MEMORY_SCOPE_AGENT);
        }
        __builtin_amdgcn_sched_barrier(0);
    }
    FA_WAIT_BAR();
}

__device__ __forceinline__ unsigned pk2(float lo, float hi) { return cvt_pk_bf16(lo, hi); }
__device__ __forceinline__ int win_src(int r) {
    if (r < 2048) {
        const int sec = r >> 10, rr = r & 1023, t = rr >> 8, p = rr & 255, bj = p >> 7, wc = (p >> 5) & 3, fq = (p >> 3) & 3, ne = p & 7;
        const int d = (fq == 0) ? (8 * bj + ne) : (16 * fq + 8 * bj + ne);
        return 6144 + sec * 1024 + t * 256 + 64 * wc + d; }
    if (r < 3072) return 8192 + (r - 2048);
    if (r < 4096) return 9216 + (r - 3072);
    if (r < 5120) return 10240 + 1024 + (r - 4096);
    if (r < 6144) return 10240 + 2048 + (r - 5120);
    if (r < 6656) return (r - 6144);
    if (r < 7168) return 1024 + (r - 6656);
    if (r < 8192) return 2048 + (r - 7168);
    if (r < 9216) return 4096 + (r - 8192);
    if (r < 9728) return 512 + (r - 9216);
    if (r < 10240) return 1536 + (r - 9728);
    if (r < 11264) return 3072 + (r - 10240);
    if (r < 12288) return 5120 + (r - 11264);
    return 10240 + (r - 12288);
}
struct P0Item { f32x4 v[8]; float sc[8]; };
__device__ __forceinline__ void p0_load(P0Item& it, int kind, const float* W, const float* W2, int Nsrc, const float* scale, int Nout, int item, int lane) {
    const int nblk = Nout / 32, kb = item / nblk, nb = item % nblk, k0 = 64 * kb, n0 = 32 * nb;
    const int kr = lane >> 3, c4 = lane & 7, rr = n0 + 4 * c4; const float* src = W; int sc;
    if (kind == 0) sc = rr; else if (kind == 1) sc = win_src(rr); else { const int t = rr >> 8, p = rr & 255; if (p < 128) sc = 128 * t + p; else { sc = 128 * t + p - 128; src = W2; } }
#pragma unroll
    for (int i = 0; i < 8; ++i) it.v[i] = *(const f32x4*)(src + (size_t)(k0 + 8 * i + kr) * Nsrc + sc);
#pragma unroll
    for (int i = 0; i < 8; ++i) it.sc[i] = scale ? scale[k0 + 8 * i + kr] : 1.0f;
}
__device__ __forceinline__ void p0_store(const P0Item& it, bf16_t* WT, int K, int Nout, LAS float* scr, int item, int lane) {
    const int nblk = Nout / 32, kb = item / nblk, nb = item % nblk, k0 = 64 * kb, n0 = 32 * nb;
    const int kr = lane >> 3, c4 = lane & 7;
#pragma unroll
    for (int i = 0; i < 8; ++i) { const int kk = 8 * i + kr; const f32x4 x = it.v[i] * it.sc[i];
        scr[kk * 33 + 4 * c4 + 0] = x[0]; scr[kk * 33 + 4 * c4 + 1] = x[1]; scr[kk * 33 + 4 * c4 + 2] = x[2]; scr[kk * 33 + 4 * c4 + 3] = x[3]; }
    asm volatile("s_waitcnt lgkmcnt(0)" ::: "memory");
    const int c = lane & 7;
#pragma unroll
    for (int j = 0; j < 4; ++j) { const int n = (lane >> 3) + 8 * j; const LAS float* s = scr + (8 * c) * 33 + n;
        u32x4 o; o.x = pk2(s[0 * 33], s[1 * 33]); o.y = pk2(s[2 * 33], s[3 * 33]); o.z = pk2(s[4 * 33], s[5 * 33]); o.w = pk2(s[6 * 33], s[7 * 33]);
        *(u32x4*)(WT + (size_t)(n0 + n) * K + k0 + 8 * c) = o; }
    asm volatile("s_waitcnt lgkmcnt(0)" ::: "memory");
}

struct Args { InTab in; float* out; unsigned char* ws; int ph_lo, ph_hi; };

__global__ void __launch_bounds__(512, 2) mk_fwd(const Args args) {
    extern __shared__ __attribute__((aligned(16))) unsigned char lds_raw[];
    LAS unsigned char* lds = (LAS unsigned char*)lds_raw;
    volatile LAS unsigned* MISC = (volatile LAS unsigned*)(lds + MISC_OFF);
    const int tid0 = threadIdx.x;
    const int WV = __builtin_amdgcn_readfirstlane(tid0 >> 6);
    const int G = gridDim.x, bx = blockIdx.x; const int vcu = (G % 8 == 0) ? (bx % 8) * (G / 8) + bx / 8 : bx;
    Ctx cx;
    cx.in.tab = (const __attribute__((address_space(4))) InTab*)__builtin_amdgcn_kernarg_segment_ptr();
    cx.out = args.out; cx.ws = args.ws;
    for (int u = tid0; u < (LDS_BYTES - MISC_OFF) / 4; u += 512) ((LAS unsigned*)(lds + MISC_OFF))[u] = 0u;
    __syncthreads();
    unsigned* ctl = WSP(unsigned, WS_CTL);
    XcdBarrier bar; bar.bar = ctl + 4096; bar.x = 0; bar.st = nullptr;
    const bool multi = (args.ph_hi - args.ph_lo) > 1;
    if (multi) bar = xcd_barrier_post(ctl + 4096, MISC + 8, tid0 == 0);
    const int NGW = G * 8;

#define PHASE_IDS const int lane = lane_id(), wave = WV, tid = wave * 64 + lane, gw = vcu * 8 + wave; (void)tid; (void)gw
    if (args.ph_lo <= PH_PRO && PH_PRO < args.ph_hi) { PHASE_IDS;
            LAS float* scr = (LAS float*)(lds + wave * 16384);
            int base = 0;
#define RUNJOB(kind, W, W2, Nsrc, scale, dst, K_, Nout) do { const int nit = ((K_) / 64) * ((Nout) / 32); const int first = (gw - (base % NGW) + NGW) % NGW; \
                if (first < nit) { P0Item cur_; p0_load(cur_, kind, W, W2, Nsrc, scale, Nout, first, lane); \
                    for (int itx = first; itx < nit; itx += NGW) { P0Item nx_ = cur_; if (itx + NGW < nit) p0_load(nx_, kind, W, W2, Nsrc, scale, Nout, itx + NGW, lane); \
                        p0_store(cur_, WSP(bf16_t, dst), K_, Nout, scr, itx, lane); cur_ = nx_; } } \
                base += nit; } while (0)
            RUNJOB(1, CX_F(8), nullptr, DIN, CX_F(7), WS_WIN, 1024, DIN);
            RUNJOB(2, CX_F(4), CX_F(5), DFF, CX_F(3), WS_W1GU, 1024, 2 * DFF);
            RUNJOB(0, CX_F(6), nullptr, D, nullptr, WS_W1D, DFF, D);
            RUNJOB(2, CX_F(26), CX_F(27), DFF, CX_F(25), WS_W2GU, 1024, 2 * DFF);
            RUNJOB(0, CX_F(28), nullptr, D, nullptr, WS_W2D, DFF, D);
            RUNJOB(0, CX_F(10), nullptr, D, nullptr, WS_WRO, 512, D);
            RUNJOB(0, CX_F(10) + (size_t)512 * 1024, nullptr, D, nullptr, WS_WRO + (size_t)1 * 1024 * 512 * 2, 512, D);
            RUNJOB(0, CX_F(10) + (size_t)1024 * 1024, nullptr, D, nullptr, WS_WRO + (size_t)2 * 1024 * 512 * 2, 512, D);
            RUNJOB(0, CX_F(10) + (size_t)1536 * 1024, nullptr, D, nullptr, WS_WRO + (size_t)3 * 1024 * 512 * 2, 512, D);
            RUNJOB(0, CX_F(18), nullptr, D, nullptr, WS_WDO, 1024, D);
            RUNJOB(0, CX_F(23), nullptr, D, nullptr, WS_WMO, 1024, D);
            RUNJOB(0, CX_F(24), nullptr, D, nullptr, WS_WOUT, 1024, D);
            RUNJOB(0, CX_F(20), nullptr, 2048, nullptr, WS_WMKV, 1024, 2048);
#undef RUNJOB
            float* part0 = WSP(float, WS_PART); bf16_t* XB = WSP(bf16_t, WS_XB);
            for (int m0 = gw; m0 < T; m0 += 4 * NGW) {
                f32x4 v[4][4];
#pragma unroll
                for (int r = 0; r < 4; ++r) { const int mr = (m0 + r * NGW < T) ? m0 + r * NGW : m0; const f32x4* xr = (const f32x4*)(CX_F(0) + (size_t)mr * D) + lane;
#pragma unroll
                    for (int j = 0; j < 4; ++j) v[r][j] = xr[64 * j]; }
#pragma unroll
                for (int r = 0; r < 4; ++r) { const int m = m0 + r * NGW; if (m >= T) break; float s = 0.f; unsigned long long* o8 = (unsigned long long*)(XB + (size_t)m * D) + lane;
#pragma unroll
                    for (int j = 0; j < 4; ++j) { const f32x4 x = v[r][j]; s += (x[0] * x[0] + x[1] * x[1]) + (x[2] * x[2] + x[3] * x[3]);
                        o8[64 * j] = (unsigned long long)pk2(x[0], x[1]) | ((unsigned long long)pk2(x[2], x[3]) << 32); }
                    s = wave_sum(s);
                    if (lane < 16) part0[(size_t)m * 16 + lane] = (lane == 0) ? s : 0.f; }
            }
            bf16_t* MN = WSP(bf16_t, WS_MEMN);
            for (int m = gw; m < TM; m += NGW) {
                const f32x4* xr = (const f32x4*)(CX_F(1) + (size_t)m * D) + lane; const f32x4* wr_ = (const f32x4*)CX_F(19) + lane; f32x4 v[4]; float s = 0.f;
#pragma unroll
                for (int j = 0; j < 4; ++j) { v[j] = xr[64 * j]; s += (v[j][0] * v[j][0] + v[j][1] * v[j][1]) + (v[j][2] * v[j][2] + v[j][3] * v[j][3]); }
                const float ri = rsqrtf(wave_sum(s) * (1.0f / D) + EPS); unsigned long long* o8 = (unsigned long long*)(MN + (size_t)m * D) + lane;
#pragma unroll
                for (int j = 0; j < 4; ++j) { const f32x4 wv = wr_[64 * j]; const f32x4 y = v[j] * ri * wv;
                    o8[64 * j] = (unsigned long long)pk2(y[0], y[1]) | ((unsigned long long)pk2(y[2], y[3]) << 32); }
            }
            float* rope = WSP(float, WS_DROPE); const int* pos = (const int*)CX_F(2);
            for (int e = gw * 64 + lane; e < T * 8; e += NGW * 64) { const int m = e >> 3, i = e & 7;
                const float inv = 1.0f / powf(500000.0f, (float)(2 * i) / 16.0f); const float ang = (float)pos[m] * inv; const float sn = sinf(ang), cs = cosf(ang);
                rope[(size_t)e * 2] = cs; rope[(size_t)e * 2 + 1] = sn; }
            if (bx == 0 && tid < 128) { const float tt = (float)tid / 127.0f; WSP(float, WS_RINV)[tid] = 1.0f / powf(10000.0f, tt); }
        if (multi) xcd_barrier(bar, WV == 0 && lane_id() == 0);
    }
#ifndef PHASE_SEQ
#define PHASE_SEQ 1,2,3,4,5,6,8,9,11,12,13,14,15
#endif
    constexpr int seq_[] = {PHASE_SEQ}; constexpr int nseq = sizeof(seq_) / sizeof(int);
    for (int si = 0; si < nseq; ++si) {
        int ph = 0;
#pragma unroll
        for (int k = 0; k < nseq; ++k) ph = (si == k) ? seq_[k] : ph;
        if (ph < args.ph_lo || ph >= args.ph_hi) continue;
        switch (ph) {
        case PH_F1GU: case PH_F1D: case PH_IN_DM: case PH_MG1: case PH_IN_R0: case PH_IN_R1: case PH_MG2: case PH_WOUT: case PH_F2GU: case PH_F2D: {
#ifndef NO_GEMM
            GemmSched S; S.ph = ph; S.c = bx; S.G = G; S.cxp = &cx;
            gemm_phase(lds, S, cx, WV);
#endif
        } break;
        case PH_ATT_DM: { PHASE_IDS;
            float lam, mcd;
            { float a = CX_F(13)[lane] * CX_F(14)[lane], b = CX_F(15)[lane] * CX_F(16)[lane], mq_ = fabsf(CX_F(11)[lane]), mk_ = fabsf(CX_F(12)[lane]);
              a = wave_sum(a); b = wave_sum(b); mq_ = wave_max(mq_); mk_ = wave_max(mk_);
              lam = uni(expf(a) - expf(b) + 0.2f); mcd = uni(8.0f * mq_ * mk_ * LOG2E); }
            bf16_t* DQ = WSP(bf16_t, WS_DQ); const bf16_t* DK = WSP(bf16_t, WS_DK); const bf16_t* DV_ = WSP(bf16_t, WS_DV);
            for (int id = vcu; id < 256; id += G) {
                const int bh = id >> 2, p = id & 3, b = bh >> 3, h = bh & 7;
#pragma unroll 1
                for (int half = 0; half < 2; ++half) { const int qb = half ? 7 - p : p;
                    FaUnit U; const size_t r0 = (size_t)b * SEQ + qb * 256;
                    U.Q = DQ + r0 * 1024 + h * 128; U.ldq = 1024; U.K = DK + (size_t)b * SEQ * 1024 + h * 128; U.ldk = 1024; U.V = DV_ + (size_t)b * SEQ * 1024 + h * 128; U.ldv = 1024;
                    U.O = DQ + r0 * 1024 + h * 128; U.ldo = 1024; U.nt = 4 * qb + 4; U.vis0 = 4 * qb; U.c = 0.125f * LOG2E; U.mc = mcd; U.lam = lam;
#ifndef NO_FADIFF
                    fa_unit<2, 64, 4, 1, 1, true>(lds, U, cx, WV);
#endif
                }
            }
            float mcm;
            { const int ln = lane_id(); float nq = 0.f, nk = 0.f;
#pragma unroll
              for (int j = 0; j < 4; ++j) { nq = fmaxf(nq, fabsf(CX_F(21)[ln + 64 * j])); nk = fmaxf(nk, fabsf(CX_F(22)[ln + 64 * j])); }
              nq = wave_max(nq); nk = wave_max(nk); mcm = uni(16.0f * nq * nk * LOG2E); }
            bf16_t* MQ = WSP(bf16_t, WS_MQ); const bf16_t* MK = WSP(bf16_t, WS_MK); const bf16_t* MV = WSP(bf16_t, WS_MV);
            for (int id = vcu; id < 256; id += G) {
                const int bh = id >> 3, qb = id & 7, b = bh >> 2, h = bh & 3;
                { FaUnit U; const size_t r0 = (size_t)b * SEQ + qb * 256;
                    U.Q = MQ + r0 * 1024 + h * 256; U.ldq = 1024; U.K = MK + (size_t)b * MEML * 1024 + h * 256; U.ldk = 1024; U.V = MV + (size_t)b * MEML * 1024 + h * 256; U.ldv = 1024;
                    U.O = MQ + r0 * 1024 + h * 256; U.ldo = 1024; U.nt = 4; U.vis0 = 4; U.c = 0.0625f * LOG2E; U.mc = mcm; U.lam = 0.f;
#ifndef NO_FAMEM
                    fa_unit<1, 256, 4, 2, 2, false>(lds, U, cx, WV);
#endif
                }
            }
        } break;
        case PH_ATT_R0: case PH_ATT_R1: {
            const int hg = (ph == PH_ATT_R1);
            const bf16_t* RQ = WSP(bf16_t, WS_RQ); const bf16_t* RK = WSP(bf16_t, WS_RK); const bf16_t* RV = WSP(bf16_t, WS_RV); bf16_t* RG = WSP(bf16_t, hg ? WS_RG1 : WS_RG0);
#ifndef RET_V0
            unsigned* stc = WSP(unsigned, WS_CTL) + 12288 + hg * 512;
            for (int id = vcu; id < 192; id += G) {
                const int bh = id / 12, r = id - 12 * bh, up = r >> 2, dvq = r & 3, b = bh >> 1, hl = bh & 1, h = 2 * hg + hl;
                StJob J; J.K = RK + ((size_t)b * SEQ + 512 * up) * 512 + hl * 256; J.V = RV + ((size_t)b * SEQ + 512 * up) * 1024 + hl * 512 + dvq * 128;
                J.ST = WSP(bf16_t, WS_ST) + ((size_t)(bh * 3 + up) * 512 + dvq * 128) * 256; J.nt = 8; J.lg = log2f(1.0f - exp2f(-5.0f - (float)h));
                st_job(lds, J, WV);
                if (WV == 0 && lane_id() == 0) __hip_atomic_fetch_add(stc + bh * 16, 1u, __ATOMIC_RELAXED, __HIP_MEMORY_SCOPE_AGENT);
            }
            for (int id = vcu; id < 256; id += G) {
                int bh, sc, pr, dvh;
                if (id >= 192) { const int j = id - 192; bh = j >> 2; sc = 0; pr = (j >> 1) & 1; dvh = j & 1; }
                else { bh = id / 12; const int r = id - 12 * bh; sc = 1 + (r >> 2); pr = (r >> 1) & 1; dvh = r & 1; }
                const int b = bh >> 1, hl = bh & 1, h = 2 * hg + hl;
                const float lg = log2f(1.0f - exp2f(-5.0f - (float)h));
                if (sc > 0) {
                    if (WV == 0) { unsigned sp = 0;
                        while ((unsigned)__builtin_amdgcn_readfirstlane(__hip_atomic_load(stc + bh * 16, __ATOMIC_RELAXED, __HIP_MEMORY_SCOPE_AGENT)) < 12u) { __builtin_amdgcn_s_sleep(2); if (++sp > (1u << 22)) break; }
                        __builtin_amdgcn_fence(__ATOMIC_ACQUIRE, "agent");
                        asm volatile("s_waitcnt vmcnt(0)" ::: "memory"); }
                    asm volatile("s_waitcnt vmcnt(0) lgkmcnt(0)\n\ts_barrier" ::: "memory");
                }
#pragma unroll 1
                for (int half = 0; half < 2; ++half) { const int v = half ? 3 - pr : pr, u = 4 * sc + v;
                    Ret3Unit U; const size_t r0 = (size_t)b * SEQ + u * 128, k0 = (size_t)b * SEQ + sc * 512;
                    U.Q = RQ + r0 * 512 + hl * 256; U.K = RK + k0 * 512 + hl * 256; U.V = RV + k0 * 1024 + hl * 512 + dvh * 256;
                    U.G = RG + r0 * 1024 + hl * 512 + dvh * 256; U.O = RG + r0 * 1024 + hl * 512 + dvh * 256; U.SS = WSP(float, WS_RSS) + r0 * 8 + h * 2 + dvh;
                    U.ST = WSP(bf16_t, WS_ST) + ((size_t)(bh * 3) * 512 + dvh * 256) * 256;
                    U.nst = 4 * sc; U.nt = 2 * (2 * v + 2); U.c0 = 2 * v; U.lg = lg;
                    fa_ret3_unit(lds, U, WV); }
            }
#else
            for (int id = vcu; id < 256; id += G) {
                const int bh = id >> 4, p = id & 15, b = bh >> 1, hl = bh & 1, h = 2 * hg + hl;
                const float lg = log2f(1.0f - exp2f(-5.0f - (float)h));
#pragma unroll 1
                for (int half = 0; half < 2; ++half) { const int n = half ? 31 - p : p;
                    AttItem it; const size_t r0 = (size_t)b * SEQ + n * 64;
                    it.Q = RQ + r0 * 512 + hl * 256; it.ldq = 512; it.K = RK + (size_t)b * SEQ * 512 + hl * 256; it.ldk = 512; it.V = RV + (size_t)b * SEQ * 1024 + hl * 512; it.ldv = 1024;
                    it.G = RG + r0 * 1024 + hl * 512; it.O = RG + r0 * 1024 + hl * 512; it.ldo = 1024; it.nt = n + 1; it.q0 = n * 64; it.p0 = lg; it.p1 = 0.f; it.p2 = 0.f;
                    attn_item<1, 256, 512, 0>(lds, it, cx, WV); }
            }
#endif
        } break;
        default: break;
        }
        if (multi && si + 1 < nseq) xcd_barrier(bar, WV == 0 && lane_id() == 0);
    }
    if (false) { PHASE_IDS;
            const float* part3 = WSP(float, WS_PART) + (size_t)3 * T * 16;
            for (int m = gw; m < T; m += NGW) {
                const float ri = row_rinv(part3, m); f32x4* xr = (f32x4*)(cx.out + (size_t)m * D) + lane; const f32x4* wr_ = (const f32x4*)CX_F(29) + lane;
#pragma unroll
                for (int j = 0; j < 4; ++j) { const f32x4 v = xr[64 * j]; xr[64 * j] = v * ri * wr_[64 * j]; }
            }
    }
}

extern "C" void kernel_launch(void* const* d_in, const int* in_sizes, int n_in, void* d_out, int out_size, void* d_ws, size_t ws_size, hipStream_t stream) {
    static int grid = 0;
    if (grid == 0) {
        if (n_in != 30 || out_size != T * D || ws_size < WS_END) { fprintf(stderr, "kernel_launch: unexpected shapes (n_in %d out %d ws %zu)\n", n_in, out_size, ws_size); grid = -1; return; }
        int dev = 0, cus = 0, per_cu = 0;
        if (hipGetDevice(&dev) != hipSuccess || hipDeviceGetAttribute(&cus, hipDeviceAttributeMultiprocessorCount, dev) != hipSuccess) { grid = -1; return; }
        if (hipFuncSetAttribute((const void*)mk_fwd, hipFuncAttributeMaxDynamicSharedMemorySize, LDS_BYTES) != hipSuccess) { fprintf(stderr, "kernel_launch: hipFuncSetAttribute failed\n"); grid = -1; return; }
        if (hipOccupancyMaxActiveBlocksPerMultiprocessor(&per_cu, (const void*)mk_fwd, 512, LDS_BYTES) != hipSuccess || per_cu < 1) { fprintf(stderr, "kernel_launch: occupancy query says %d\n", per_cu); }
        (void)hipGetLastError();
        grid = cus;
    }
    if (grid < 0) return;
    (void)hipMemsetAsync((char*)d_ws + WS_CTL, 0, CTL_ZERO_BYTES, stream);
    Args a{};
    for (int i = 0; i < 30; ++i) a.in.p[i] = (const float*)d_in[i];
    a.out = (float*)d_out; a.ws = (unsigned char*)d_ws;
#if MK_N_LAUNCHES == 1
    a.ph_lo = 0; a.ph_hi = PH_COUNT;
    hipLaunchKernelGGL(mk_fwd, dim3(grid), dim3(512), LDS_BYTES, stream, a);
#else
    for (int ph = 0; ph < PH_COUNT; ++ph) { a.ph_lo = ph; a.ph_hi = ph + 1; hipLaunchKernelGGL(mk_fwd, dim3(grid), dim3(512), LDS_BYTES, stream, a); }
#endif
}
```

```cpp
#include <hip/hip_runtime.h>
#include <cstdio>
#include <cstdint>

#ifndef MK_N_LAUNCHES
#define MK_N_LAUNCHES 1
#endif

#define LAS __attribute__((address_space(3)))
#define GAS __attribute__((address_space(1)))
typedef unsigned short bf16_t;
typedef short bf16x8 __attribute__((ext_vector_type(8)));
typedef short s16x4 __attribute__((ext_vector_type(4)));
typedef float f32x4 __attribute__((ext_vector_type(4)));
typedef float f32x2 __attribute__((ext_vector_type(2)));
typedef unsigned u32x4 __attribute__((ext_vector_type(4)));
typedef unsigned u32x2 __attribute__((ext_vector_type(2)));

constexpr int D = 1024, NB = 8, SEQ = 2048, T = NB * SEQ, DFF = 2816, MEML = 256, TM = NB * MEML;
constexpr int DIN = 13312;
constexpr float EPS = 1e-6f;
constexpr float LOG2E = 1.4426950408889634f;

constexpr size_t MiB = 1u << 20;
constexpr size_t HALFMiB = 1u << 19;
constexpr size_t WS_WIN = 0;
constexpr size_t WS_W2GU = 26 * MiB;
constexpr size_t WS_W2D = 37 * MiB;
constexpr size_t WS_WDO = 42 * MiB + HALFMiB;
constexpr size_t WS_WMO = 44 * MiB + HALFMiB;
constexpr size_t WS_WOUT = 46 * MiB + HALFMiB;
constexpr size_t WS_WRO = 48 * MiB + HALFMiB;
constexpr size_t WS_WMKV = 52 * MiB + HALFMiB;
constexpr size_t WS_XB = 56 * MiB + HALFMiB;
constexpr size_t WS_W1GU = 88 * MiB + HALFMiB;
constexpr size_t WS_W1D = 99 * MiB + HALFMiB;
constexpr size_t WS_ACT = 105 * MiB;
constexpr size_t WS_MEMN = 236 * MiB;
constexpr size_t WS_MK = 240 * MiB;
constexpr size_t WS_MV = 244 * MiB;
constexpr size_t WS_DQ = 88 * MiB + HALFMiB;
constexpr size_t WS_DK = 120 * MiB + HALFMiB;
constexpr size_t WS_DV = 152 * MiB + HALFMiB;
constexpr size_t WS_MQ = 184 * MiB + HALFMiB;
constexpr size_t WS_SG = WS_DK;
constexpr size_t WS_M = WS_DV;
constexpr size_t WS_RQ = 88 * MiB + HALFMiB;
constexpr size_t WS_RK = 104 * MiB + HALFMiB;
constexpr size_t WS_RV = 120 * MiB + HALFMiB;
constexpr size_t WS_RG0 = 184 * MiB + HALFMiB;
constexpr size_t WS_RG1 = 216 * MiB + HALFMiB;
constexpr size_t WS_SG2 = 88 * MiB + HALFMiB;
constexpr size_t WS_ST = 0;
constexpr size_t WS_SGB = 216 * MiB + HALFMiB;
constexpr size_t WS_PART = 250 * MiB;
constexpr size_t WS_DROPE = 254 * MiB;
constexpr size_t WS_CTL = 255 * MiB;
constexpr size_t CTL_ZERO_BYTES = 64 * 1024;
constexpr size_t WS_RINV = 255 * MiB + 768 * 1024;
constexpr size_t WS_RSS = 255 * MiB + 128 * 1024;
constexpr size_t WS_END = 256 * MiB;

constexpr int RING_BYTES = 131072;
constexpr int ATT_BYTES = 157696;
#ifdef PROBE_PH
#ifndef PROBE_K
#define PROBE_K 0
#endif
#ifndef PROBE_BX
#define PROBE_BX 0
#endif
#ifndef PROBE_Q
#define PROBE_Q 2.0f
#endif
#ifndef PROBE_OFF
#define PROBE_OFF 0
#endif
#define PROBE_T0(lds_, ph_) do { if ((ph_) == PROBE_PH && WV == 0) { const unsigned t_ = (unsigned)__builtin_amdgcn_s_memrealtime(); if (lane_id() == 0) *(volatile LAS unsigned*)((lds_) + MISC_OFF + 128) = t_; } } while (0)
#define PROBE_MARK(lds_, ph_, k_) do { if ((ph_) == PROBE_PH && (k_) == PROBE_K && WV == 0) { const unsigned t_ = (unsigned)__builtin_amdgcn_s_memrealtime(); if (lane_id() == 0) { volatile LAS unsigned* m_ = (volatile LAS unsigned*)((lds_) + MISC_OFF + 128); m_[1] = t_ - m_[0]; } } } while (0)
#define PROBE_MARK1(lds_, k_) do { if ((k_) == PROBE_K && WV == 0) { const unsigned t_ = (unsigned)__builtin_amdgcn_s_memrealtime(); if (lane_id() == 0) { volatile LAS unsigned* m_ = (volatile LAS unsigned*)((lds_) + MISC_OFF + 128); if (m_[0] != 0u && m_[1] == 0u) m_[1] = t_ - m_[0]; } } } while (0)
#else
#define PROBE_MARK1(lds_, k_) do { } while (0)
#define PROBE_T0(lds_, ph_) do { } while (0)
#define PROBE_MARK(lds_, ph_, k_) do { } while (0)
#endif
constexpr int EPI_OFF = 131072;
constexpr int MISC_OFF = ATT_BYTES;
constexpr int LDS_BYTES = ATT_BYTES + 512;

#define RLX_AGENT __ATOMIC_RELAXED, __HIP_MEMORY_SCOPE_AGENT
typedef __bf16 bf16x2_t __attribute__((ext_vector_type(2)));
__device__ __forceinline__ unsigned cvt_pk_bf16(float lo, float hi) { f32x2 v = {lo, hi}; bf16x2_t b = __builtin_convertvector(v, bf16x2_t); return __builtin_bit_cast(unsigned, b); }
__device__ __forceinline__ float bf2f(unsigned short b) { return __uint_as_float((unsigned)b << 16); }
__device__ __forceinline__ float bflo(unsigned w) { return __uint_as_float(w << 16); }
__device__ __forceinline__ float bfhi(unsigned w) { return __uint_as_float(w & 0xffff0000u); }
__device__ __forceinline__ unsigned short f2bf(float f) { return (unsigned short)(cvt_pk_bf16(f, 0.f) & 0xffffu); }
__device__ __forceinline__ int lane_id() { int r; asm volatile("v_mbcnt_lo_u32_b32 %0, -1, 0\n\tv_mbcnt_hi_u32_b32 %0, -1, %0" : "=v"(r)); return r; }
#define TID_OF(wv) ((wv) * 64 + lane_id())

template <int K> __device__ __forceinline__ float xor_f(float v) {
    if (K == 32) { auto r = __builtin_amdgcn_permlane32_swap(__float_as_uint(v), __float_as_uint(v), false, false); return (lane_id() & 32) ? __uint_as_float(r[0]) : __uint_as_float(r[1]); }
    return __int_as_float(__builtin_amdgcn_ds_swizzle(__float_as_int(v), 0x1F | (K << 10)));
}
__device__ __forceinline__ float sum_xor32(float v) { auto r = __builtin_amdgcn_permlane32_swap(__float_as_uint(v), __float_as_uint(v), false, false); return __uint_as_float(r[0]) + __uint_as_float(r[1]); }
template <int CTRL> __device__ __forceinline__ float dppf(float v) { return __int_as_float(__builtin_amdgcn_update_dpp(0, __float_as_int(v), CTRL, 0xF, 0xF, true)); }
__device__ __forceinline__ float row32_sum(float v) {
    v += dppf<0xB1>(v); v += dppf<0x4E>(v); v += dppf<0x141>(v); v += dppf<0x140>(v);
    auto r = __builtin_amdgcn_permlane16_swap(__float_as_uint(v), __float_as_uint(v), false, false);
    return __uint_as_float(r[0]) + __uint_as_float(r[1]);
}
__device__ __forceinline__ float wave_sum(float v) {
    v += xor_f<1>(v); v += xor_f<2>(v); v += xor_f<4>(v); v += xor_f<8>(v); v += xor_f<16>(v);
    return sum_xor32(v);
}
__device__ __forceinline__ float wave_max(float v) {
    v = fmaxf(v, xor_f<1>(v)); v = fmaxf(v, xor_f<2>(v)); v = fmaxf(v, xor_f<4>(v)); v = fmaxf(v, xor_f<8>(v)); v = fmaxf(v, xor_f<16>(v));
    auto r = __builtin_amdgcn_permlane32_swap(__float_as_uint(v), __float_as_uint(v), false, false); return fmaxf(__uint_as_float(r[0]), __uint_as_float(r[1]));
}
__device__ __forceinline__ float uni(float v) { return __uint_as_float(__builtin_amdgcn_readfirstlane(__float_as_uint(v))); }

#define XB_TMO      128
#define XB_XCNT(j)  (256  + 64 * (j))
#define XB_XSUB(j)  (1280 + 64 * (j))
#define XB_XGEN(j)  (2304 + 64 * (j))
#define XB_TOP      3328
#define XB_TOPGEN   3392
#define XCD_BAR_WORDS 3456
#define XB_SPIN_CAP (1u << 22)
__device__ __forceinline__ unsigned xb_ld(unsigned* p)              { return __hip_atomic_load(p, __ATOMIC_RELAXED, __HIP_MEMORY_SCOPE_AGENT); }
__device__ __forceinline__ unsigned xb_add(unsigned* p, unsigned v) { return __hip_atomic_fetch_add(p, v, __ATOMIC_RELAXED, __HIP_MEMORY_SCOPE_AGENT); }
__device__ __forceinline__ unsigned xb_xcc_id() { return (unsigned)__builtin_amdgcn_s_getreg((3 << 11) | 20) & 0xFu; }
#define XB_SPIN(cond, bar) do { unsigned _sp = 0; while (cond) { __builtin_amdgcn_s_sleep(1); \
    if ((++_sp & 255u) == 0u) { if (xb_ld(&(bar)[XB_TMO])) break; if (_sp > XB_SPIN_CAP) { atomicAdd(&(bar)[XB_TMO], 1u); break; } } } } while (0)
struct XcdBarrier { unsigned* bar; unsigned x; volatile LAS unsigned* st; };
__device__ __forceinline__ XcdBarrier xcd_barrier_post(unsigned* bar, volatile LAS unsigned* st, bool t0) {
    XcdBarrier b; b.bar = bar; b.x = xb_xcc_id(); b.st = st;
    if (t0) (void)xb_add(&bar[XB_XCNT(b.x)], 1u);
    return b;
}
__device__ __forceinline__ void xcd_barrier_complete(unsigned* bar, unsigned x, unsigned& nloc, unsigned& nx) {
    const unsigned G = gridDim.x * gridDim.y * gridDim.z;
    unsigned sum, cnt, mine, sp = 0u;
    for (;;) {
        sum = 0u; cnt = 0u; mine = 0u;
#pragma unroll
        for (unsigned j = 0; j < 16; ++j) { const unsigned c = xb_ld(&bar[XB_XCNT(j)]); sum += c; cnt += (c > 0u) ? 1u : 0u; mine = (j == x) ? c : mine; }
        if (sum == G) break;
        __builtin_amdgcn_s_sleep(1);
        if ((++sp & 255u) == 0u) { if (xb_ld(&bar[XB_TMO])) break; if (sp > XB_SPIN_CAP) { atomicAdd(&bar[XB_TMO], 1u); break; } }
    }
    nloc = mine > 0u ? mine : 1u; nx = cnt > 0u ? cnt : 1u;
}
__device__ __forceinline__ void xcd_barrier(const XcdBarrier& b, bool t0) {
    asm volatile("s_waitcnt vmcnt(0)" ::: "memory");
    __syncthreads();
    if (t0) {
        unsigned* bar = b.bar;
        __builtin_amdgcn_s_waitcnt(0);
        unsigned nloc = b.st[0], nx = b.st[1];
        if (nloc == 0u) { xcd_barrier_complete(bar, b.x, nloc, nx); b.st[0] = nloc; b.st[1] = nx; }
        const unsigned old = xb_add(&bar[XB_XSUB(b.x)], 1u);
        const unsigned gen = old / nloc;
        if (old + 1u == (gen + 1u) * nloc) {
            __builtin_amdgcn_fence(__ATOMIC_RELEASE, "agent");
            asm volatile("s_waitcnt vmcnt(0)" ::: "memory");
            const unsigned og = xb_add(&bar[XB_TOP], 1u);
            const unsigned tg = og / nx;
            if (og + 1u == (tg + 1u) * nx) xb_add(&bar[XB_TOPGEN], 1u);
            else XB_SPIN(xb_ld(&bar[XB_TOPGEN]) == tg, bar);
            __builtin_amdgcn_fence(__ATOMIC_ACQUIRE, "agent");
            xb_add(&bar[XB_XGEN(b.x)], 1u);
            asm volatile("s_waitcnt vmcnt(0)" ::: "memory");
        } else {
            XB_SPIN(xb_ld(&bar[XB_XGEN(b.x)]) == gen, bar);
            __builtin_amdgcn_fence(__ATOMIC_ACQUIRE, "agent");
            asm volatile("s_waitcnt vmcnt(0)" ::: "memory");
        }
    }
    __syncthreads();
}

struct InTab { const float* p[30]; };
struct CtxIn {
    const __attribute__((address_space(4))) InTab* tab;
    __device__ __forceinline__ const float* operator[](int i) const { typedef const float* cfp; return *(volatile const __attribute__((address_space(4))) cfp*)&tab->p[i]; }
};
struct Ctx {
    CtxIn in;
    float* out;
    unsigned char* ws;
};
#define CX_F(i) (cx.in[i])
#define WSP(T_, off) ((T_*)(cx.ws + (off)))

namespace pg8 {
constexpr int BM = 256, BK = 64, HALF = 128, HTB = HALF * BK * 2, STAGE_BYTES = 8 * HTB, NXCD = 8, WGM = 8;
__device__ __forceinline__ int lds_byte(int r, int c) { const int st = (r >> 4) * 2 + (c >> 5), rr = r & 15, cc = c & 31, ob = rr * 64 + cc * 2; return st * 1024 + (ob ^ (((ob >> 9) & 1) << 5)); }
__device__ __forceinline__ void stage_rc(int b, int& R, int& C) { const int st = b / 1024, sb = b % 1024, swz = sb ^ (((sb >> 9) & 1) << 5); R = (st >> 1) * 16 + swz / 64; C = (st & 1) * 32 + (swz % 64) / 2; }
__device__ __forceinline__ int perm32(int rho) { const int n = rho >> 4, i = rho & 15; return 8 * (i >> 2) + 4 * n + (i & 3); }
__device__ __forceinline__ void tile_of(int L, int nM, int nN, int& pm, int& pn) {
    const int nwg = nM * nN; int wgid = L;
    { const int q = nwg / NXCD, r = nwg % NXCD, xcd = wgid % NXCD, off = wgid / NXCD; wgid = (xcd < r ? xcd * (q + 1) : r * (q + 1) + (xcd - r) * q) + off; }
    const int nig = WGM * nN, gid = wgid / nig, fm = gid * WGM, gsz = (nM - fm) < WGM ? (nM - fm) : WGM;
    pm = fm + ((wgid % nig) % gsz); pn = (wgid % nig) / gsz;
}
}

enum { EP_GU = 0, EP_MK, EP_MV, EP_RES, EP_DQK, EP_PLAIN, EP_MQ, EP_ROT, EP_SG, EP_PM, EP_RSC };
struct Unit { const bf16_t* A; const bf16_t* Bt; int K, lda; int pm, pn; int epi, aux, po; int kjt; long kjump; int rs; };

enum { PH_PRO = 0, PH_F1GU, PH_F1D, PH_IN_DM, PH_ATT_DM, PH_MG1, PH_IN_R0, PH_ST0, PH_ATT_R0, PH_IN_R1, PH_ST1, PH_ATT_R1,
       PH_MG2, PH_WOUT, PH_F2GU, PH_F2D, PH_FIN, PH_COUNT };

struct GemmSched {
    int ph, c, G;
    const Ctx* cxp;
    __device__ __forceinline__ bool next(int i, Unit& u) const { u.lda = 0; const bool ok = next_(i, u); if (u.lda == 0) u.lda = u.K; return ok; }
    __device__ __forceinline__ bool next_(int i, Unit& u) const {
        const Ctx& cx = *cxp;
        const int L = i * G + c;
        u.kjt = 1 << 30; u.kjump = 0; u.rs = 0;
        switch (ph) {
        case PH_F1GU: case PH_F2GU: {
            const int f2 = (ph == PH_F2GU);
            if (L < 64 * 22) { pg8::tile_of(L, 64, 22, u.pm, u.pn); u.A = WSP(bf16_t, WS_XB); u.Bt = WSP(bf16_t, f2 ? WS_W2GU : WS_W1GU); u.K = 1024; u.epi = EP_GU; u.aux = f2; u.po = u.pn; return true; }
            if (f2) return false;
            const int j = L - 64 * 22; if (j >= 64) return false;
            pg8::tile_of(j, 8, 8, u.pm, u.pn); u.A = WSP(bf16_t, WS_MEMN); u.Bt = WSP(bf16_t, WS_WMKV); u.K = 1024;
            if (u.pn < 4) { u.epi = EP_MK; u.po = u.pn; } else { u.epi = EP_MV; u.po = u.pn - 4; }
            u.aux = 0; return true; }
        case PH_F1D: case PH_F2D: {
            if (L >= 256) return false; pg8::tile_of(L, 64, 4, u.pm, u.pn);
            u.A = WSP(bf16_t, WS_ACT); u.Bt = WSP(bf16_t, ph == PH_F1D ? WS_W1D : WS_W2D); u.K = DFF; u.epi = EP_RES; u.aux = (ph == PH_F1D) ? 0 : 2; u.po = u.pn; return true; }
        case PH_IN_DM: {
            if (L >= 64 * 16) return false; pg8::tile_of(L, 64, 16, u.pm, u.pn);
            u.A = WSP(bf16_t, WS_XB); u.Bt = WSP(bf16_t, WS_WIN); u.K = 1024;
            const int s = u.pn >> 2; u.po = u.pn & 3;
            if (s == 0) { u.epi = EP_DQK; u.aux = 0; } else if (s == 1) { u.epi = EP_DQK; u.aux = 1; } else if (s == 2) { u.epi = EP_PLAIN; u.aux = 0; } else { u.epi = EP_MQ; u.aux = 0; }
            return true; }
        case PH_MG1: {
            const int kind = i & 3, tl = c + G * (i >> 2); if (tl >= 256) return false; pg8::tile_of(tl, 64, 4, u.pm, u.pn); u.K = 1024; u.po = u.pn;
            if (kind == 0) { u.A = WSP(bf16_t, WS_XB); u.Bt = WSP(bf16_t, WS_WIN); u.pn += 16; u.epi = EP_SG; u.aux = 1; }
            else if (kind == 1) { u.A = WSP(bf16_t, WS_DQ); u.Bt = WSP(bf16_t, WS_WDO); u.epi = EP_PM; u.aux = 0; }
            else if (kind == 2) { u.A = WSP(bf16_t, WS_XB); u.Bt = WSP(bf16_t, WS_WIN); u.pn += 20; u.epi = EP_SG; u.aux = 2; }
            else { u.A = WSP(bf16_t, WS_MQ); u.Bt = WSP(bf16_t, WS_WMO); u.epi = EP_PM; u.aux = 1 | 4; }
            return true; }
        case PH_MG2: {
            const int kind = i % 5, tl = c + G * (i / 5); if (tl >= 256) return false; pg8::tile_of(tl, 64, 4, u.pm, u.pn); u.po = u.pn;
            if (kind == 0) { u.A = WSP(bf16_t, WS_XB); u.Bt = WSP(bf16_t, WS_WIN); u.K = 1024; u.pn += 48; u.epi = EP_SG; u.aux = 0; }
            else { const int h = kind - 1; u.A = WSP(bf16_t, (h < 2) ? WS_RG0 : WS_RG1) + (h & 1) * 512; u.lda = 1024; u.Bt = WSP(bf16_t, WS_WRO) + (size_t)h * 1024 * 512; u.K = 512;
                   if (h < 3) { u.epi = EP_RSC; u.aux = h + 1; } else { u.epi = EP_PM; u.aux = 1 | 2; u.rs = 1; } }
            return true; }
        case PH_IN_R0: {
            if (L >= 64 * 24) return false; pg8::tile_of(L, 64, 24, u.pm, u.pn);
            const int hg = u.pn / 12; const int t = u.pn - 12 * hg;
            u.A = WSP(bf16_t, WS_XB); u.Bt = WSP(bf16_t, WS_WIN); u.K = 1024; u.pn = 24 + 12 * hg + t;
            if (t < 2) { u.epi = EP_ROT; u.aux = 0 | (hg << 3); u.po = t; } else if (t < 4) { u.epi = EP_ROT; u.aux = 1 | (hg << 3); u.po = t - 2; }
            else if (t < 8) { u.epi = EP_PLAIN; u.aux = 1 | (hg << 3); u.po = t - 4; } else { u.epi = EP_PLAIN; u.aux = 2 + hg; u.po = t - 8; }
            return true; }
        case PH_WOUT: {
            if (L >= 256) return false; pg8::tile_of(L, 64, 4, u.pm, u.pn);
            u.A = WSP(bf16_t, WS_M); u.Bt = WSP(bf16_t, WS_WOUT); u.K = 1024; u.epi = EP_RES; u.aux = 1; u.po = u.pn; return true; }
        default: return false;
        }
    }
};

__device__ __forceinline__ float row_rinv(const float* part, int row) {
    const f32x4* p = (const f32x4*)(part + (size_t)row * 16);
    const f32x4 a = p[0], b = p[1], c = p[2], d = p[3];
    const float s = ((a[0] + a[1]) + (a[2] + a[3])) + ((b[0] + b[1]) + (b[2] + b[3])) + ((c[0] + c[1]) + (c[2] + c[3])) + ((d[0] + d[1]) + (d[2] + d[3]));
    return __builtin_amdgcn_rsqf(s * (1.0f / 1024.0f) + EPS);
}
__device__ __forceinline__ float fsigmoid(float v) { return __builtin_amdgcn_rcpf(1.0f + __builtin_amdgcn_exp2f(v * (-LOG2E))); }
__device__ __forceinline__ f32x4 exp2_4(f32x4 v) { return (f32x4){__builtin_amdgcn_exp2f(v[0]), __builtin_amdgcn_exp2f(v[1]), __builtin_amdgcn_exp2f(v[2]), __builtin_amdgcn_exp2f(v[3])}; }
__device__ __forceinline__ f32x4 rcp_4(f32x4 v) { return (f32x4){__builtin_amdgcn_rcpf(v[0]), __builtin_amdgcn_rcpf(v[1]), __builtin_amdgcn_rcpf(v[2]), __builtin_amdgcn_rcpf(v[3])}; }
__device__ __forceinline__ float ret_rms2(const float* ss, int row, int h);
__device__ __forceinline__ void rescale_rows(const Ctx& cx, f32x4 (&acc)[2][2][4][2], int rowb, int hn);

__device__ __forceinline__ void epilogue(const Ctx& cx, const Unit& u, f32x4 (&acc)[2][2][4][2], int wr, int wc, int fr, int fq, LAS unsigned char* lds) {
    const int rowb = u.pm * 256 + wr * 64 + fr;
    const int colw = wc * 32 + 8 * fq;
    float* PART = WSP(float, WS_PART);
#ifdef EPI_ONLY
    if (u.epi != EPI_ONLY) return;
#endif
    LAS float* rl = (LAS float*)(lds + EPI_OFF + 8192);
    LAS float* pl = (LAS float*)(lds + EPI_OFF + 9216);
    LAS unsigned char* ropl = lds + EPI_OFF + 10240;
    {
        const float* rp = nullptr;
        if (u.epi == EP_GU) rp = PART + (size_t)(u.aux ? 2 : 0) * T * 16;
        else if (u.epi == EP_PLAIN || u.epi == EP_DQK || u.epi == EP_MQ || u.epi == EP_ROT || u.epi == EP_SG) rp = PART + (size_t)1 * T * 16;
        if (rp) {
            const int lt = (wr * 4 + wc) * 64 + fq * 16 + fr, r = lt >> 1, hf = lt & 1;
            const f32x4* p = (const f32x4*)(rp + (size_t)(u.pm * 256 + r) * 16 + hf * 8);
            const f32x4 a = p[0], b = p[1];
            f32x4 c0 = (f32x4){0.f, 0.f, 0.f, 0.f}, c1 = c0; float pf = 0.f;
            if (u.epi == EP_DQK) { const f32x4* q = (const f32x4*)(WSP(float, WS_DROPE) + (size_t)(u.pm * 256 + r) * 16 + hf * 8); c0 = q[0]; c1 = q[1]; }
            if (u.epi == EP_ROT) pf = (float)((const int*)cx.in[2])[u.pm * 256 + (lt & 255)];
            float s = ((a[0] + a[1]) + (a[2] + a[3])) + ((b[0] + b[1]) + (b[2] + b[3]));
            s += dppf<0xB1>(s);
            if (hf == 0) rl[r] = __builtin_amdgcn_rsqf(s * (1.0f / 1024.0f) + EPS);
            if (u.epi == EP_DQK) { *(LAS f32x4*)(ropl + r * 64 + hf * 32) = c0; *(LAS f32x4*)(ropl + r * 64 + hf * 32 + 16) = c1; }
            if (u.epi == EP_ROT && lt < 256) pl[lt] = pf;
            asm volatile("s_waitcnt vmcnt(0) lgkmcnt(0)" ::: "memory"); __builtin_amdgcn_s_barrier(); asm volatile("" ::: "memory");
        }
    }
    const int lrb = wr * 64 + fr;
    switch (u.epi) {
    case EP_GU: {
        bf16_t* O = WSP(bf16_t, WS_ACT);
#pragma unroll
        for (int ai = 0; ai < 2; ++ai)
#pragma unroll
            for (int m = 0; m < 4; ++m) {
                const int row = rowb + ai * 128 + m * 16; const float ri = rl[lrb + ai * 128 + m * 16];
                const float k1 = -ri * LOG2E, ri2 = ri * ri; f32x4 ov[2];
#pragma unroll
                for (int n = 0; n < 2; ++n) { const f32x4 gq = acc[ai][0][m][n], uq = acc[ai][1][m][n];
                    const f32x4 den = exp2_4(gq * k1) + 1.0f; ov[n] = (gq * uq) * (rcp_4(den) * ri2); }
                u32x4 w; w.x = cvt_pk_bf16(ov[0][0], ov[0][1]); w.y = cvt_pk_bf16(ov[0][2], ov[0][3]); w.z = cvt_pk_bf16(ov[1][0], ov[1][1]); w.w = cvt_pk_bf16(ov[1][2], ov[1][3]);
                *(u32x4*)(O + (size_t)row * DFF + u.po * 128 + colw) = w;
            }
    } break;
    case EP_MV: case EP_PLAIN: {
        bf16_t* O; int ld; const bool part = (u.epi != EP_MV);
        if (u.epi == EP_MV) { O = WSP(bf16_t, WS_MV); ld = 1024; }
        else { ld = 1024; O = (u.aux == 9) ? (bf16_t*)cx.out + (size_t)T * 1024 : WSP(bf16_t, u.aux == 0 ? WS_DV : u.aux == 1 ? WS_RV : u.aux == 2 ? WS_RG0 : WS_RG1); }
#pragma unroll
        for (int ai = 0; ai < 2; ++ai)
#pragma unroll
            for (int m = 0; m < 4; ++m) {
                const int row = rowb + ai * 128 + m * 16; const float ri = part ? rl[lrb + ai * 128 + m * 16] : 1.0f;
#pragma unroll
                for (int bj = 0; bj < 2; ++bj) { const f32x4 v0 = acc[ai][bj][m][0] * ri, v1 = acc[ai][bj][m][1] * ri;
                    u32x4 w; w.x = cvt_pk_bf16(v0[0], v0[1]); w.y = cvt_pk_bf16(v0[2], v0[3]); w.z = cvt_pk_bf16(v1[0], v1[1]); w.w = cvt_pk_bf16(v1[2], v1[3]);
                    if (u.aux == 2 || u.aux == 3) __builtin_nontemporal_store(w, (u32x4*)(O + (size_t)row * ld + u.po * 256 + bj * 128 + colw));
                    else *(u32x4*)(O + (size_t)row * ld + u.po * 256 + bj * 128 + colw) = w; }
            }
    } break;
    case EP_RES: if (u.aux == 2) {
        float* part = PART + (size_t)3 * T * 16; unsigned* cnt = WSP(unsigned, WS_CTL) + 8192 + 64 * u.pm; const float* wn = cx.in[29]; const bf16_t* XB = WSP(bf16_t, WS_XB);
        LAS unsigned* flag = (LAS unsigned*)(lds + EPI_OFF);
#pragma unroll
        for (int ai = 0; ai < 2; ++ai) {
            u32x4 xv[4][2];
#pragma unroll
            for (int m = 0; m < 4; ++m)
#pragma unroll
                for (int bj = 0; bj < 2; ++bj) xv[m][bj] = *(const u32x4*)(XB + (size_t)(rowb + ai * 128 + m * 16) * D + u.po * 256 + bj * 128 + colw);
#pragma unroll
            for (int m = 0; m < 4; ++m) {
                const int row = rowb + ai * 128 + m * 16; float ss = 0.f;
#pragma unroll
                for (int bj = 0; bj < 2; ++bj) { const u32x4 xq = xv[m][bj];
                    const f32x4 x0 = (f32x4){bflo(xq.x), bfhi(xq.x), bflo(xq.y), bfhi(xq.y)}, x1 = (f32x4){bflo(xq.z), bfhi(xq.z), bflo(xq.w), bfhi(xq.w)};
                    const f32x4 y0 = x0 + acc[ai][bj][m][0] * 0.5f, y1 = x1 + acc[ai][bj][m][1] * 0.5f;
                    ss += (y0[0] * y0[0] + y0[1] * y0[1]) + (y0[2] * y0[2] + y0[3] * y0[3]) + (y1[0] * y1[0] + y1[1] * y1[1]) + (y1[2] * y1[2] + y1[3] * y1[3]); }
                ss += xor_f<16>(ss); ss = sum_xor32(ss);
                if (fq == 0) __hip_atomic_store(part + (size_t)row * 16 + u.po * 4 + wc, ss, __ATOMIC_RELAXED, __HIP_MEMORY_SCOPE_AGENT);
            }
        }
        asm volatile("s_waitcnt vmcnt(0)" ::: "memory");
        if (fr == 0 && fq == 0) __hip_atomic_fetch_add(cnt, 1u, __ATOMIC_RELAXED, __HIP_MEMORY_SCOPE_AGENT);
        if (wr == 0 && wc == 0) {
            unsigned sp = 0;
            while ((unsigned)__builtin_amdgcn_readfirstlane(__hip_atomic_load(cnt, __ATOMIC_RELAXED, __HIP_MEMORY_SCOPE_AGENT)) < 32u) { __builtin_amdgcn_s_sleep(2); if (++sp > (1u << 22)) break; }
            __builtin_amdgcn_fence(__ATOMIC_ACQUIRE, "agent");
            asm volatile("s_waitcnt vmcnt(0)" ::: "memory");
            if (fr == 0 && fq == 0) flag[0] = 1u;
        }
        asm volatile("s_waitcnt vmcnt(0) lgkmcnt(0)" ::: "memory"); __builtin_amdgcn_s_barrier(); asm volatile("" ::: "memory");
        int rowb2 = rowb, colw2 = colw; asm volatile("" : "+v"(rowb2), "+v"(colw2));
#pragma unroll
        for (int q4 = 0; q4 < 4; ++q4) {
            const int ai = q4 >> 1, m0 = (q4 & 1) * 2;
            u32x4 xv[2][2]; float ri[2];
#pragma unroll
            for (int mm = 0; mm < 2; ++mm) { const int row = rowb2 + ai * 128 + (m0 + mm) * 16; ri[mm] = row_rinv(part, row);
#pragma unroll
                for (int bj = 0; bj < 2; ++bj) xv[mm][bj] = *(const u32x4*)(XB + (size_t)row * D + u.po * 256 + bj * 128 + colw2); }
            __builtin_amdgcn_sched_barrier(0);
#pragma unroll
            for (int mm = 0; mm < 2; ++mm) { const int row = rowb2 + ai * 128 + (m0 + mm) * 16;
#pragma unroll
                for (int bj = 0; bj < 2; ++bj) { const size_t off = (size_t)row * D + u.po * 256 + bj * 128 + colw2; const u32x4 xq = xv[mm][bj];
                    const f32x4 x0 = (f32x4){bflo(xq.x), bfhi(xq.x), bflo(xq.y), bfhi(xq.y)}, x1 = (f32x4){bflo(xq.z), bfhi(xq.z), bflo(xq.w), bfhi(xq.w)};
                    const f32x4 w0 = *(const f32x4*)(wn + u.po * 256 + bj * 128 + colw2), w1 = *(const f32x4*)(wn + u.po * 256 + bj * 128 + colw2 + 4);
                    __builtin_nontemporal_store((x0 + acc[ai][bj][m0 + mm][0] * 0.5f) * ri[mm] * w0, (f32x4*)(cx.out + off)); __builtin_nontemporal_store((x1 + acc[ai][bj][m0 + mm][1] * 0.5f) * ri[mm] * w1, (f32x4*)(cx.out + off + 4)); } }
            __builtin_amdgcn_sched_barrier(0);
        }
    } else {
        float* part = PART + (size_t)(u.aux + 1) * T * 16; bf16_t* XB = WSP(bf16_t, WS_XB);
#pragma unroll
        for (int ai = 0; ai < 2; ++ai) {
            f32x4 xv[4][2][2];
            {
                u32x4 xb[4][2];
#pragma unroll
                for (int m = 0; m < 4; ++m)
#pragma unroll
                    for (int bj = 0; bj < 2; ++bj) xb[m][bj] = *(const u32x4*)(XB + (size_t)(rowb + ai * 128 + m * 16) * D + u.po * 256 + bj * 128 + colw);
#pragma unroll
                for (int m = 0; m < 4; ++m)
#pragma unroll
                    for (int bj = 0; bj < 2; ++bj) { const u32x4 xq = xb[m][bj];
                        xv[m][bj][0] = (f32x4){bflo(xq.x), bfhi(xq.x), bflo(xq.y), bfhi(xq.y)}; xv[m][bj][1] = (f32x4){bflo(xq.z), bfhi(xq.z), bflo(xq.w), bfhi(xq.w)}; }
            }
            __builtin_amdgcn_sched_barrier(0);
            const float sc = (u.aux == 1) ? 1.0f : 0.5f;
#pragma unroll
            for (int m = 0; m < 4; ++m) {
                const int row = rowb + ai * 128 + m * 16; float ss = 0.f;
#pragma unroll
                for (int bj = 0; bj < 2; ++bj) { const size_t off = (size_t)row * D + u.po * 256 + bj * 128 + colw;
                    const f32x4 y0 = xv[m][bj][0] + acc[ai][bj][m][0] * sc, y1 = xv[m][bj][1] + acc[ai][bj][m][1] * sc;
                    ss += (y0[0] * y0[0] + y0[1] * y0[1]) + (y0[2] * y0[2] + y0[3] * y0[3]) + (y1[0] * y1[0] + y1[1] * y1[1]) + (y1[2] * y1[2] + y1[3] * y1[3]);
                    u32x4 w; w.x = cvt_pk_bf16(y0[0], y0[1]); w.y = cvt_pk_bf16(y0[2], y0[3]); w.z = cvt_pk_bf16(y1[0], y1[1]); w.w = cvt_pk_bf16(y1[2], y1[3]);
                    *(u32x4*)(XB + off) = w; }
                ss += xor_f<16>(ss); ss = sum_xor32(ss);
                if (fq == 0) part[(size_t)row * 16 + u.po * 4 + wc] = ss;
            }
            __builtin_amdgcn_sched_barrier(0);
        }
    } break;
    case EP_DQK: {
        const float* wn = cx.in[u.aux ? 12 : 11];
        bf16_t* O = WSP(bf16_t, u.aux ? WS_DK : WS_DQ);
        f32x4 wv[2][2];
#pragma unroll
        for (int bj = 0; bj < 2; ++bj)
#pragma unroll
            for (int n = 0; n < 2; ++n) wv[bj][n] = *(const f32x4*)(wn + 16 * fq + 8 * bj + 4 * n);
#pragma unroll
        for (int ai = 0; ai < 2; ++ai)
#pragma unroll
            for (int m = 0; m < 4; ++m) {
                const int row = rowb + ai * 128 + m * 16; const float ri = rl[lrb + ai * 128 + m * 16];
                f32x4 v[2][2]; float ss = 0.f;
#pragma unroll
                for (int bj = 0; bj < 2; ++bj)
#pragma unroll
                    for (int n = 0; n < 2; ++n) { v[bj][n] = acc[ai][bj][m][n] * ri; ss += (v[bj][n][0] * v[bj][n][0] + v[bj][n][1] * v[bj][n][1]) + (v[bj][n][2] * v[bj][n][2] + v[bj][n][3] * v[bj][n][3]); }
                ss += xor_f<16>(ss); ss = sum_xor32(ss);
                const float r2 = __builtin_amdgcn_rsqf(ss * (1.0f / 64.0f) + EPS);
#pragma unroll
                for (int bj = 0; bj < 2; ++bj)
#pragma unroll
                    for (int n = 0; n < 2; ++n) v[bj][n] = v[bj][n] * r2 * wv[bj][n];
                if (fq == 0) {
                    const LAS f32x4* rp = (const LAS f32x4*)(ropl + (lrb + ai * 128 + m * 16) * 64);
#pragma unroll
                    for (int n = 0; n < 2; ++n) { const f32x4 cs0 = rp[2 * n], cs1 = rp[2 * n + 1];
                        const float c_[4] = {cs0[0], cs0[2], cs1[0], cs1[2]}, s_[4] = {cs0[1], cs0[3], cs1[1], cs1[3]};
#pragma unroll
                        for (int e = 0; e < 4; ++e) { const float x1 = v[0][n][e], x2 = v[1][n][e]; v[0][n][e] = x1 * c_[e] - x2 * s_[e]; v[1][n][e] = x2 * c_[e] + x1 * s_[e]; } }
                }
#pragma unroll
                for (int bj = 0; bj < 2; ++bj) { u32x4 w; w.x = cvt_pk_bf16(v[bj][0][0], v[bj][0][1]); w.y = cvt_pk_bf16(v[bj][0][2], v[bj][0][3]); w.z = cvt_pk_bf16(v[bj][1][0], v[bj][1][1]); w.w = cvt_pk_bf16(v[bj][1][2], v[bj][1][3]);
                    *(u32x4*)(O + (size_t)row * 1024 + u.po * 256 + wc * 64 + bj * 32 + 8 * fq) = w; }
            }
    } break;
    case EP_MQ: case EP_MK: {
        const bool part = (u.epi == EP_MQ); const float* wn = cx.in[u.epi == EP_MQ ? 21 : 22];
        bf16_t* O = WSP(bf16_t, u.epi == EP_MQ ? WS_MQ : WS_MK);
        LAS float* red = (LAS float*)(lds + EPI_OFF);
        float ri[2][4];
#pragma unroll
        for (int ai = 0; ai < 2; ++ai)
#pragma unroll
            for (int m = 0; m < 4; ++m) {
                ri[ai][m] = part ? rl[lrb + ai * 128 + m * 16] : 1.0f; float ss = 0.f;
#pragma unroll
                for (int bj = 0; bj < 2; ++bj)
#pragma unroll
                    for (int n = 0; n < 2; ++n) { const f32x4 v = acc[ai][bj][m][n] * ri[ai][m]; ss += (v[0] * v[0] + v[1] * v[1]) + (v[2] * v[2] + v[3] * v[3]); }
                ss += xor_f<16>(ss); ss = sum_xor32(ss);
                if (fq == 0) red[(ai * 128 + wr * 64 + m * 16 + fr) * 4 + wc] = ss;
            }
        asm volatile("s_waitcnt lgkmcnt(0)" ::: "memory"); __builtin_amdgcn_s_barrier(); asm volatile("" ::: "memory");
        f32x4 wv[2][2];
#pragma unroll
        for (int bj = 0; bj < 2; ++bj)
#pragma unroll
            for (int n = 0; n < 2; ++n) wv[bj][n] = *(const f32x4*)(wn + bj * 128 + colw + 4 * n);
#pragma unroll
        for (int ai = 0; ai < 2; ++ai)
#pragma unroll
            for (int m = 0; m < 4; ++m) {
                const int row = rowb + ai * 128 + m * 16; const int lr = ai * 128 + wr * 64 + m * 16 + fr;
                const float tot = (red[lr * 4 + 0] + red[lr * 4 + 1]) + (red[lr * 4 + 2] + red[lr * 4 + 3]);
                const float r2 = __builtin_amdgcn_rsqf(tot * (1.0f / 256.0f) + EPS) * ri[ai][m];
#pragma unroll
                for (int bj = 0; bj < 2; ++bj) { const f32x4 v0 = acc[ai][bj][m][0] * r2 * wv[bj][0], v1 = acc[ai][bj][m][1] * r2 * wv[bj][1];
                    u32x4 w; w.x = cvt_pk_bf16(v0[0], v0[1]); w.y = cvt_pk_bf16(v0[2], v0[3]); w.z = cvt_pk_bf16(v1[0], v1[1]); w.w = cvt_pk_bf16(v1[2], v1[3]);
                    *(u32x4*)(O + (size_t)row * 1024 + u.po * 256 + bj * 128 + colw) = w; }
            }
        asm volatile("s_waitcnt lgkmcnt(0)" ::: "memory"); __builtin_amdgcn_s_barrier(); asm volatile("" ::: "memory");
    } break;
    case EP_ROT: {
        const float* rinvf = WSP(float, WS_RINV);
        const int isk = u.aux & 1; bf16_t* O = (u.aux & 8) ? (bf16_t*)cx.out + (isk ? (size_t)T * 512 : (size_t)0) : WSP(bf16_t, isk ? WS_RK : WS_RQ); const float ksc = isk ? 0.0625f : 1.0f;
        f32x4 fr4[2];
#pragma unroll
        for (int bj = 0; bj < 2; ++bj) fr4[bj] = *(const f32x4*)(rinvf + (bj * 128 + colw) / 2);
#pragma unroll
        for (int ai = 0; ai < 2; ++ai)
#pragma unroll
            for (int m = 0; m < 4; ++m) {
                const int row = rowb + ai * 128 + m * 16; const float ri = rl[lrb + ai * 128 + m * 16] * ksc; const float pf = pl[lrb + ai * 128 + m * 16];
#pragma unroll
                for (int bj = 0; bj < 2; ++bj) { float o[8];
#pragma unroll
                    for (int p = 0; p < 4; ++p) { const float ang = pf * fr4[bj][p];
                        const float rh = ang * 0.15915494309189535f; const float rl = __builtin_fmaf(ang, 0.15915494309189535f, -rh) + ang * (-1.2154201256553420e-10f);
                        float fr_ = rh - floorf(rh); fr_ += rl;
                        const float sn = __builtin_amdgcn_sinf(fr_), cs = __builtin_amdgcn_cosf(fr_);
                        const float xe = acc[ai][bj][m][p >> 1][(p & 1) * 2] * ri, xo = acc[ai][bj][m][p >> 1][(p & 1) * 2 + 1] * ri;
                        o[2 * p] = xe * cs - xo * sn; o[2 * p + 1] = xo * cs + xe * sn; }
                    u32x4 w; w.x = cvt_pk_bf16(o[0], o[1]); w.y = cvt_pk_bf16(o[2], o[3]); w.z = cvt_pk_bf16(o[4], o[5]); w.w = cvt_pk_bf16(o[6], o[7]);
                    *(u32x4*)(O + (size_t)row * 512 + u.po * 256 + bj * 128 + colw) = w; }
            }
    } break;
    case EP_SG: {
        const float* bg = cx.in[9] + u.aux * 1024 + u.po * 256;
        bf16_t* O = WSP(bf16_t, u.aux == 0 ? WS_SG2 : u.aux == 1 ? WS_SG : WS_SGB);
        f32x4 bv[2][2];
#pragma unroll
        for (int bj = 0; bj < 2; ++bj)
#pragma unroll
            for (int n = 0; n < 2; ++n) bv[bj][n] = *(const f32x4*)(bg + bj * 128 + colw + 4 * n);
#pragma unroll
        for (int ai = 0; ai < 2; ++ai)
#pragma unroll
            for (int m = 0; m < 4; ++m) {
                const int row = rowb + ai * 128 + m * 16; const float ri = rl[lrb + ai * 128 + m * 16];
#pragma unroll
                for (int bj = 0; bj < 2; ++bj) { f32x4 ov[2];
#pragma unroll
                    for (int n = 0; n < 2; ++n) ov[n] = rcp_4(exp2_4((acc[ai][bj][m][n] * ri + bv[bj][n]) * (-LOG2E)) + 1.0f);
                    u32x4 w; w.x = cvt_pk_bf16(ov[0][0], ov[0][1]); w.y = cvt_pk_bf16(ov[0][2], ov[0][3]); w.z = cvt_pk_bf16(ov[1][0], ov[1][1]); w.w = cvt_pk_bf16(ov[1][2], ov[1][3]);
                    *(u32x4*)(O + (size_t)row * 1024 + u.po * 256 + bj * 128 + colw) = w; }
            }
    } break;
    case EP_PM: {
        const bf16_t* SG = WSP(bf16_t, (u.aux & 2) ? WS_SG2 : (u.aux & 4) ? WS_SGB : WS_SG); bf16_t* Mb = WSP(bf16_t, WS_M); const bool accum = (u.aux & 1);
#pragma unroll
        for (int ai = 0; ai < 2; ++ai) {
            u32x4 gv[4][2], pv[4][2]; float rs[4];
#pragma unroll
            for (int m = 0; m < 4; ++m) { const int row = rowb + ai * 128 + m * 16; rs[m] = u.rs ? rsqrtf(ret_rms2(WSP(float, WS_RSS), row, 3)) : 1.0f;
#pragma unroll
                for (int bj = 0; bj < 2; ++bj) { const size_t off = (size_t)row * 1024 + u.po * 256 + bj * 128 + colw;
                    gv[m][bj] = *(const u32x4*)(SG + off); pv[m][bj] = (u32x4){0u, 0u, 0u, 0u}; if (accum) pv[m][bj] = *(const u32x4*)(Mb + off); } }
            __builtin_amdgcn_sched_barrier(0);
#pragma unroll
            for (int m = 0; m < 4; ++m) { const int row = rowb + ai * 128 + m * 16;
#pragma unroll
                for (int bj = 0; bj < 2; ++bj) { const size_t off = (size_t)row * 1024 + u.po * 256 + bj * 128 + colw;
                    const u32x4 g = gv[m][bj], pm = pv[m][bj];
                    const f32x4 a0 = acc[ai][bj][m][0] * rs[m], a1 = acc[ai][bj][m][1] * rs[m];
                    float o[8];
                    o[0] = bflo(g.x) * a0[0] + bflo(pm.x); o[1] = bfhi(g.x) * a0[1] + bfhi(pm.x); o[2] = bflo(g.y) * a0[2] + bflo(pm.y); o[3] = bfhi(g.y) * a0[3] + bfhi(pm.y);
                    o[4] = bflo(g.z) * a1[0] + bflo(pm.z); o[5] = bfhi(g.z) * a1[1] + bfhi(pm.z); o[6] = bflo(g.w) * a1[2] + bflo(pm.w); o[7] = bfhi(g.w) * a1[3] + bfhi(pm.w);
                    u32x4 w; w.x = cvt_pk_bf16(o[0], o[1]); w.y = cvt_pk_bf16(o[2], o[3]); w.z = cvt_pk_bf16(o[4], o[5]); w.w = cvt_pk_bf16(o[6], o[7]);
                    *(u32x4*)(Mb + off) = w; } }
            __builtin_amdgcn_sched_barrier(0);
        }
    } break;
    default: break;
    }
}


__device__ __forceinline__ float ret_rms2(const float* ss, int row, int h) { const f32x2 v = *(const f32x2*)(ss + (size_t)row * 8 + 2 * h); return (v[0] + v[1]) * (1.0f / 512.0f) + EPS; }
__device__ __forceinline__ void rescale_rows(const Ctx& cx, f32x4 (&acc)[2][2][4][2], int rowb, int hn) {
    const float* ss = WSP(float, WS_RSS);
#pragma unroll
    for (int ai = 0; ai < 2; ++ai)
#pragma unroll
        for (int m = 0; m < 4; ++m) { const int row = rowb + ai * 128 + m * 16; const float f = sqrtf(ret_rms2(ss, row, hn) / ret_rms2(ss, row, hn - 1));
#pragma unroll
            for (int bj = 0; bj < 2; ++bj)
#pragma unroll
                for (int n = 0; n < 2; ++n) acc[ai][bj][m][n] = acc[ai][bj][m][n] * f; }
}
__device__ __forceinline__ void gemm_phase(LAS unsigned char* lds, const GemmSched& S, const Ctx& cx, int WV) {
    using namespace pg8;
    int tid = TID_OF(WV); asm volatile("" : "+v"(tid));
    const int wid = __builtin_amdgcn_readfirstlane(tid >> 6), lane = tid & 63, wr = wid >> 2, wc = wid & 3, fr = lane & 15, fq = lane >> 4;
    int RA, RB, CC;
    { int R, C; stage_rc(tid * 16, R, C); RA = R * 2; RB = ((R & ~31) + perm32(R & 31)) * 2; CC = C * 2; }
    const size_t kstep = (size_t)(BK * 2);
    const unsigned ldsw = (unsigned)wid * 1024u;
    const int aoff = lds_byte(wr * 64 + fr, fq * 8), boff = lds_byte(wc * 32 + fr, fq * 8);
#define PG8_SA(b, h) (((b) * 2 + (h)) * HTB)
#define PG8_SB(b, h) ((4 + (b) * 2 + (h)) * HTB)
#define PG8_STAGE(bufoff, gbase, voff, hs) do { \
        __builtin_amdgcn_global_load_lds((const unsigned*)((const char*)(gbase) + (voff)), (LAS unsigned*)(lds + (bufoff) + ldsw), 16, 0, 0); \
        __builtin_amdgcn_global_load_lds((const unsigned*)((const char*)(gbase) + ((hs) >> 1) + (voff)), (LAS unsigned*)(lds + (bufoff) + ldsw + 8192), 16, 0, 0); } while (0)
#define PG8_LDA(dst, b, h) do { _Pragma("unroll") for (int m = 0; m < 4; ++m) _Pragma("unroll") for (int k = 0; k < 2; ++k) dst[m][k] = *(const LAS bf16x8*)(lds + PG8_SA(b, h) + aoff + m * 2048 + k * 1024); } while (0)
#define PG8_LDB(dst, b, h) do { _Pragma("unroll") for (int n = 0; n < 2; ++n) _Pragma("unroll") for (int k = 0; k < 2; ++k) dst[n][k] = *(const LAS bf16x8*)(lds + PG8_SB(b, h) + boff + n * 2048 + k * 1024); } while (0)
#define PG8_MMA(ai, bj, At, Bt) do { __builtin_amdgcn_s_setprio(1); _Pragma("unroll") for (int m = 0; m < 4; ++m) _Pragma("unroll") for (int n = 0; n < 2; ++n) _Pragma("unroll") for (int k = 0; k < 2; ++k) \
        acc[ai][bj][m][n] = __builtin_amdgcn_mfma_f32_16x16x32_bf16(Bt[n][k], At[m][k], acc[ai][bj][m][n], 0, 0, 0); __builtin_amdgcn_s_setprio(0); } while (0)
#define PG8_WAIT_V(n) asm volatile("s_waitcnt vmcnt(" #n ")" ::: "memory")
#define PG8_WAIT_L(n) asm volatile("s_waitcnt lgkmcnt(" #n ")" ::: "memory")
#define PG8_BAR __builtin_amdgcn_s_barrier()
#define PG8_SCHED __builtin_amdgcn_sched_barrier(0)
    Unit cur, nxt; int ui = 0;
    if (!S.next(0, cur)) return;
    f32x4 acc[2][2][4][2];
    { float z = 0.f; asm volatile("" : "+v"(z));
#pragma unroll
    for (int a = 0; a < 2; ++a)
#pragma unroll
        for (int b = 0; b < 2; ++b)
#pragma unroll
            for (int m = 0; m < 4; ++m)
#pragma unroll
                for (int n = 0; n < 2; ++n) acc[a][b][m][n] = (f32x4){z, z, z, z}; }
    bf16x8 At[4][2], B0[2][2], B1[2][2];
    int Kc = cur.K; size_t hsAc = (size_t)HALF * cur.lda * 2, hsBc = (size_t)HALF * Kc * 2;
    unsigned vAc = (unsigned)(RA * cur.lda + CC), vBc = (unsigned)(RB * Kc + CC);
    const char* cA = (const char*)cur.A + (size_t)cur.pm * 2 * hsAc; const char* cB = (const char*)cur.Bt + (size_t)cur.pn * 2 * hsBc;
    PG8_STAGE(PG8_SB(0, 0), cB, vBc, hsBc); PG8_STAGE(PG8_SB(0, 1), cB + hsBc, vBc, hsBc); PG8_STAGE(PG8_SA(0, 0), cA, vAc, hsAc); PG8_STAGE(PG8_SA(0, 1), cA + hsAc, vAc, hsAc);
    if (wr == 1) PG8_BAR;
    PG8_WAIT_V(2); PG8_BAR;
    PG8_STAGE(PG8_SB(1, 0), cB + kstep, vBc, hsBc); PG8_STAGE(PG8_SA(1, 0), cA + kstep, vAc, hsAc); PG8_STAGE(PG8_SB(1, 1), cB + hsBc + kstep, vBc, hsBc);
    PG8_WAIT_V(6); PG8_BAR;
    PROBE_MARK(lds, S.ph, 0);
    for (;;) {
        const bool has_next = S.next(ui + 1, nxt);
        const int Kn = has_next ? nxt.K : Kc; const int ldan = has_next ? nxt.lda : cur.lda; const size_t hsAn = (size_t)HALF * ldan * 2, hsBn = (size_t)HALF * Kn * 2;
        const unsigned vAn = (unsigned)(RA * ldan + CC), vBn = (unsigned)(RB * Kn + CC);
        const char* nA = has_next ? (const char*)nxt.A + (size_t)nxt.pm * 2 * hsAn : cA; const char* nB = has_next ? (const char*)nxt.Bt + (size_t)nxt.pn * 2 * hsBn : cB;
        const int nt = Kc / BK; const int kjt = cur.kjt; const size_t kj = (size_t)cur.kjump;
#define PG8_AOFF(tt) ((size_t)(tt) * kstep + (((tt) >= kjt) ? kj : (size_t)0))
        for (int t = 0; t < nt; t += 2) {
            const bool last = (t == nt - 2);
            const char* a1 = cA + PG8_AOFF(t + 1);
            const char* a2 = last ? nA : cA + PG8_AOFF(t + 2); const char* b2 = last ? nB : cB + (size_t)(t + 2) * kstep;
            const char* a3 = last ? nA + kstep : cA + PG8_AOFF(t + 3); const char* b3 = b2 + kstep;
            const size_t hsA2 = last ? hsAn : hsAc, hsB2 = last ? hsBn : hsBc;
            const unsigned vA2 = last ? vAn : vAc, vB2 = last ? vBn : vBc;
            PG8_LDB(B0, 0, 0); PG8_LDB(B1, 0, 1); PG8_SCHED; PG8_LDA(At, 0, 0); PG8_STAGE(PG8_SA(1, 1), a1 + hsAc, vAc, hsAc);
            PG8_WAIT_V(8); PG8_WAIT_L(0); PG8_BAR; PG8_MMA(0, 0, At, B0); PG8_MMA(0, 1, At, B1); PG8_BAR; PG8_SCHED;
            PG8_LDA(At, 0, 1); PG8_STAGE(PG8_SB(0, 0), b2, vB2, hsB2); PG8_STAGE(PG8_SB(0, 1), b2 + hsB2, vB2, hsB2); PG8_STAGE(PG8_SA(0, 0), a2, vA2, hsA2);
            PG8_WAIT_V(8); PG8_WAIT_L(0); PG8_BAR; PG8_MMA(1, 0, At, B0); PG8_MMA(1, 1, At, B1); PG8_BAR; PG8_SCHED;
            PG8_LDB(B0, 1, 0); PG8_LDB(B1, 1, 1); PG8_SCHED; PG8_LDA(At, 1, 0); PG8_STAGE(PG8_SA(0, 1), a2 + hsA2, vA2, hsA2);
            PG8_WAIT_V(8); PG8_WAIT_L(0); PG8_BAR; PG8_MMA(0, 0, At, B0); PG8_MMA(0, 1, At, B1); PG8_BAR; PG8_SCHED;
            PG8_LDA(At, 1, 1); PG8_STAGE(PG8_SB(1, 0), b3, vB2, hsB2); PG8_STAGE(PG8_SB(1, 1), b3 + hsB2, vB2, hsB2); PG8_STAGE(PG8_SA(1, 0), a3, vA2, hsA2);
            PG8_WAIT_V(8); PG8_WAIT_L(0); PG8_BAR; PG8_MMA(1, 0, At, B0); PG8_MMA(1, 1, At, B1); PG8_BAR; PG8_SCHED;
        }
#undef PG8_AOFF
        if (wr == 0) PG8_BAR;
        if (ui == 0) PROBE_MARK(lds, S.ph, 1); if (!has_next) PROBE_MARK(lds, S.ph, 3);
        { int fr_ = fr, fq_ = fq; asm volatile("" : "+v"(fr_), "+v"(fq_));
          epilogue(cx, cur, acc, wr, wc, fr_, fq_, lds); }
        if (ui == 0) PROBE_MARK(lds, S.ph, 2); if (!has_next) PROBE_MARK(lds, S.ph, 4);
        if (!has_next) break;
        {
            const bool rsc = (cur.epi == EP_RSC); const int hn = rsc ? cur.aux : 1; const float* ss = WSP(float, WS_RSS); const int rowb = cur.pm * 256 + wr * 64 + fr;
#pragma unroll
            for (int a = 0; a < 2; ++a)
#pragma unroll
                for (int m = 0; m < 4; ++m) { const int row = rowb + a * 128 + m * 16; float f = 0.0f; if (rsc) f = sqrtf(ret_rms2(ss, row, hn) / ret_rms2(ss, row, hn - 1));
#pragma unroll
                    for (int b = 0; b < 2; ++b)
#pragma unroll
                        for (int n = 0; n < 2; ++n) acc[a][b][m][n] = acc[a][b][m][n] * f; }
        }
        cur = nxt; cA = nA; cB = nB; Kc = Kn; hsAc = hsAn; hsBc = hsBn; vAc = vAn; vBc = vBn;
        ++ui;
        if (wr == 1) PG8_BAR;
    }
    PG8_WAIT_V(0);
    PG8_BAR;
#undef PG8_SA
#undef PG8_SB
#undef PG8_STAGE
#undef PG8_LDA
#undef PG8_LDB
#undef PG8_MMA
#undef PG8_WAIT_V
#undef PG8_WAIT_L
#undef PG8_BAR
#undef PG8_SCHED
}

struct AttItem {
    const bf16_t* Q; int ldq;
    const bf16_t* K; int ldk;
    const bf16_t* V; int ldv;
    bf16_t* O; int ldo;
    const bf16_t* G;
    int nt;
    int q0;
    float p0, p1, p2;
};
__device__ __forceinline__ s16x4 ds_tr16(const LAS unsigned char* p) { return __builtin_bit_cast(s16x4, __builtin_amdgcn_ds_read_tr16_b64_v4i16((LAS s16x4*)p)); }

template <int NM, int DQ, int DV, int MODE>
__device__ __forceinline__ void attn_item(LAS unsigned char* lds, const AttItem& it, const Ctx& cx, int WV) {
    constexpr int QW = NM * DQ, QP = (QW + 8) * 2  , VP = (DV + 8) * 2, PP = 72 * 2;
    constexpr int OFF_Q = 0, OFF_K = OFF_Q + 64 * QP, OFF_V = OFF_K + 64 * QP, OFF_P = OFF_V + 64 * VP, OFF_R = OFF_P + NM * 64 * PP;
    static_assert(OFF_R + 8 * 64 * 4 + 2 * 64 * 4 <= ATT_BYTES, "attention LDS");
    int tid = TID_OF(WV); asm volatile("" : "+v"(tid));
    const int w = __builtin_amdgcn_readfirstlane(tid >> 6), l = tid & 63, l15 = l & 15, g = l >> 4;
    const int rb = w >> 1, ch = w & 1;
    constexpr int NTV = DV / 128;
    const int c0 = w * (DV / 8);
    LAS float* RED = (LAS float*)(lds + OFF_R);
    LAS float* FIN = RED + 8 * 64;
    for (int i = tid; i < 64 * (QW / 8); i += 512) { const int r = i / (QW / 8), c = i % (QW / 8);
        *(LAS u32x4*)(lds + OFF_Q + r * QP + c * 16) = *(const u32x4*)(it.Q + (size_t)r * it.ldq + c * 8); }
    f32x4 o[NM][4][NTV];
#pragma unroll
    for (int r = 0; r < NM; ++r)
#pragma unroll
        for (int m = 0; m < 4; ++m)
#pragma unroll
            for (int n = 0; n < NTV; ++n) o[r][m][n] = (f32x4){0.f, 0.f, 0.f, 0.f};
    float lsum[NM][4];
#pragma unroll
    for (int r = 0; r < NM; ++r)
#pragma unroll
        for (int j = 0; j < 4; ++j) lsum[r][j] = 0.f;
    for (int kt = 0; kt < it.nt; ++kt) {
        for (int i = tid; i < 64 * (QW / 8); i += 512) { const int r = i / (QW / 8), c = i % (QW / 8);
            *(LAS u32x4*)(lds + OFF_K + r * QP + c * 16) = *(const u32x4*)(it.K + (size_t)(kt * 64 + r) * it.ldk + c * 8); }
        for (int i = tid; i < 64 * (DV / 8); i += 512) { const int r = i / (DV / 8), c = i % (DV / 8);
            *(LAS u32x4*)(lds + OFF_V + r * VP + c * 16) = *(const u32x4*)(it.V + (size_t)(kt * 64 + r) * it.ldv + c * 8); }
        __syncthreads();
#pragma unroll
        for (int r = 0; r < NM; ++r) {
            f32x4 s[2]; s[0] = (f32x4){0.f, 0.f, 0.f, 0.f}; s[1] = s[0];
#pragma unroll
            for (int ks = 0; ks < DQ / 32; ++ks) {
                const bf16x8 a = *(const LAS bf16x8*)(lds + OFF_Q + (16 * rb + l15) * QP + (r * DQ + 32 * ks + 8 * g) * 2);
#pragma unroll
                for (int n = 0; n < 2; ++n) { const bf16x8 b = *(const LAS bf16x8*)(lds + OFF_K + (32 * ch + 16 * n + l15) * QP + (r * DQ + 32 * ks + 8 * g) * 2);
                    s[n] = __builtin_amdgcn_mfma_f32_16x16x32_bf16(a, b, s[n], 0, 0, 0); }
            }
#pragma unroll
            for (int n = 0; n < 2; ++n)
#pragma unroll
                for (int j = 0; j < 4; ++j) {
                    const int row = 16 * rb + 4 * g + j, key = 32 * ch + 16 * n + l15; float p;
                    if (MODE == 0) { const int dist = (it.q0 + row) - (kt * 64 + key); p = s[n][j] * __builtin_amdgcn_exp2f(it.p0 * (float)(dist < 0 ? -dist : dist)); }
                    else { p = __builtin_amdgcn_exp2f(s[n][j] * it.p0 - it.p1); lsum[r][j] += p; }
                    *(LAS unsigned short*)(lds + OFF_P + r * 64 * PP + row * PP + key * 2) = f2bf(p);
                }
        }
        __syncthreads();
#pragma unroll
        for (int ks = 0; ks < 2; ++ks) {
            bf16x8 bv[NTV];
#pragma unroll
            for (int n = 0; n < NTV; ++n) {
                const int q = (l & 15) >> 2, p = l & 3;
                const LAS unsigned char* base = lds + OFF_V + (32 * ks + 8 * g + q) * VP + (c0 + 16 * n + 4 * p) * 2;
                const s16x4 t0 = ds_tr16(base), t1 = ds_tr16(base + 4 * VP);
                bv[n] = (bf16x8){t0[0], t0[1], t0[2], t0[3], t1[0], t1[1], t1[2], t1[3]};
            }
#pragma unroll
            for (int r = 0; r < NM; ++r)
#pragma unroll
                for (int m = 0; m < 4; ++m) {
                    const bf16x8 a = *(const LAS bf16x8*)(lds + OFF_P + r * 64 * PP + (16 * m + l15) * PP + (32 * ks + 8 * g) * 2);
#pragma unroll
                    for (int n = 0; n < NTV; ++n) o[r][m][n] = __builtin_amdgcn_mfma_f32_16x16x32_bf16(a, bv[n], o[r][m][n], 0, 0, 0);
                }
        }
        __syncthreads();
    }
    if (MODE != 0) {
#pragma unroll
        for (int r = 0; r < NM; ++r)
#pragma unroll
            for (int j = 0; j < 4; ++j) { float v = lsum[r][j]; v += xor_f<1>(v); v += xor_f<2>(v); v += xor_f<4>(v); v += xor_f<8>(v);
                if (l15 == 0) RED[(r * 2 + ch) * 64 + 16 * rb + 4 * g + j] = v; }
        __syncthreads();
        if (tid < NM * 64) { const int r = tid >> 6, row = tid & 63; FIN[r * 64 + row] = 1.0f / (RED[(r * 2 + 0) * 64 + row] + RED[(r * 2 + 1) * 64 + row]); }
        __syncthreads();
    }
    f32x4 y[4][NTV];
#pragma unroll
    for (int m = 0; m < 4; ++m)
#pragma unroll
        for (int n = 0; n < NTV; ++n)
#pragma unroll
            for (int j = 0; j < 4; ++j) { const int row = 16 * m + 4 * g + j;
                if (MODE == 0) y[m][n][j] = o[0][m][n][j];
                else if (MODE == 1) y[m][n][j] = o[0][m][n][j] * FIN[row] - it.p2 * (o[NM - 1][m][n][j] * FIN[(NM - 1) * 64 + row]);
                else y[m][n][j] = o[0][m][n][j] * FIN[row]; }
    if (MODE != 2) {
        __syncthreads();
#pragma unroll
        for (int m = 0; m < 4; ++m)
#pragma unroll
            for (int j = 0; j < 4; ++j) { float v = 0.f;
#pragma unroll
                for (int n = 0; n < NTV; ++n) v += y[m][n][j] * y[m][n][j];
                v += xor_f<1>(v); v += xor_f<2>(v); v += xor_f<4>(v); v += xor_f<8>(v);
                if (l15 == 0) RED[w * 64 + 16 * m + 4 * g + j] = v; }
        __syncthreads();
        if (tid < 64) { float s = 0.f;
#pragma unroll
            for (int k = 0; k < 8; ++k) s += RED[k * 64 + tid];
            FIN[tid] = rsqrtf(s * (1.0f / DV) + EPS); }
        __syncthreads();
    }
#pragma unroll
    for (int m = 0; m < 4; ++m)
#pragma unroll
        for (int n = 0; n < NTV; ++n)
#pragma unroll
            for (int j = 0; j < 4; ++j) { const int row = 16 * m + 4 * g + j, col = c0 + 16 * n + l15; float v = y[m][n][j];
                if (MODE == 0) { const float gt = bf2f(it.G[(size_t)row * it.ldv + col]); v = v * FIN[row] * (gt * fsigmoid(gt)); }
                else if (MODE == 1) { v = v * FIN[row] * cx.in[17][col] * 0.8f; }
                it.O[(size_t)row * it.ldo + col] = f2bf(v); }
    __syncthreads();
}


#define TR8(lo, hh, addr, base) asm volatile( \
    "ds_read_b64_tr_b16 %0, %8 offset:%c9\n\tds_read_b64_tr_b16 %4, %8 offset:%c10\n\t" \
    "ds_read_b64_tr_b16 %1, %8 offset:%c11\n\tds_read_b64_tr_b16 %5, %8 offset:%c12\n\t" \
    "ds_read_b64_tr_b16 %2, %8 offset:%c13\n\tds_read_b64_tr_b16 %6, %8 offset:%c14\n\t" \
    "ds_read_b64_tr_b16 %3, %8 offset:%c15\n\tds_read_b64_tr_b16 %7, %8 offset:%c16\n\ts_waitcnt lgkmcnt(0)" \
    : "=&v"(lo[0]), "=&v"(lo[1]), "=&v"(lo[2]), "=&v"(lo[3]), "=&v"(hh[0]), "=&v"(hh[1]), "=&v"(hh[2]), "=&v"(hh[3]) \
    : "v"(addr), "i"((base)), "i"((base) + 512), "i"((base) + 1024), "i"((base) + 1536), "i"((base) + 2048), "i"((base) + 2560), "i"((base) + 3072), "i"((base) + 3584) : "memory")
#define TR8K(lo, hh, addr, base) asm volatile( \
    "ds_read_b64_tr_b16 %0, %8 offset:%c9\n\tds_read_b64_tr_b16 %4, %8 offset:%c10\n\t" \
    "ds_read_b64_tr_b16 %1, %8 offset:%c11\n\tds_read_b64_tr_b16 %5, %8 offset:%c12\n\t" \
    "ds_read_b64_tr_b16 %2, %8 offset:%c13\n\tds_read_b64_tr_b16 %6, %8 offset:%c14\n\t" \
    "ds_read_b64_tr_b16 %3, %8 offset:%c15\n\tds_read_b64_tr_b16 %7, %8 offset:%c16\n\ts_waitcnt lgkmcnt(0)" \
    : "=&v"(lo[0]), "=&v"(lo[1]), "=&v"(lo[2]), "=&v"(lo[3]), "=&v"(hh[0]), "=&v"(hh[1]), "=&v"(hh[2]), "=&v"(hh[3]) \
    : "v"(addr), "i"((base)), "i"((base) + 512), "i"((base) + 4096), "i"((base) + 4608), "i"((base) + 8192), "i"((base) + 8704), "i"((base) + 12288), "i"((base) + 12800) : "memory")
typedef float f32x16 __attribute__((ext_vector_type(16)));
struct FaUnit {
    const bf16_t* Q; int ldq;
    const bf16_t* K; int ldk;
    const bf16_t* V; int ldv;
    bf16_t* O; int ldo;
    int nt;
    int vis0;
    float c, mc, lam;
};
__device__ __forceinline__ int crow(int r, int hi) { return (r & 3) + 8 * (r >> 2) + 4 * hi; }
#define FA_WAIT_BAR() asm volatile("s_waitcnt vmcnt(0) lgkmcnt(0)\n\ts_barrier" ::: "memory")

template <int NM, int DQ, int NDVB, int MODE, int NPASS, bool QLDS, bool KEEP = false>
__device__ __forceinline__ void fa_unit(LAS unsigned char* lds, const FaUnit& U, const Ctx& cx, int WV) {
    constexpr int NKP = NM * DQ / 8;
    constexpr int NVP = NDVB * 4;
    constexpr int KB = NKP * 1024, VB = NVP * 1024, SLOT = KB + VB;
    constexpr int OFF_WS = 2 * SLOT;
    constexpr int OFF_QL = OFF_WS + 8 * NM * 32 * 4;
    constexpr int NQF = NM * (DQ / 16);
    static_assert(OFF_QL + (QLDS ? NQF * 8192 : 0) <= ATT_BYTES, "fa LDS");
    static_assert(QLDS ? (8 * 32 * (NDVB * 64) <= NQF * 8192) : (8 * 32 * (NDVB * 64) <= OFF_WS), "fa stage");
    int tid = TID_OF(WV); asm volatile("" : "+v"(tid));
    const int w = __builtin_amdgcn_readfirstlane(tid >> 6), l = tid & 63, r32 = l & 31, hi = l >> 5;
    const unsigned kvo = (unsigned)(l * U.ldk * 2), vvo = (unsigned)((l >> 2) * U.ldv * 2 + (l & 3) * 16);
    const size_t ktile = (size_t)64 * U.ldk * 2, vtile = (size_t)64 * U.ldv * 2;
#define FA_DMA(t, slot) do { \
        const char* kb_ = (const char*)U.K + (size_t)(t) * ktile; const char* vb_ = (const char*)U.V + (size_t)(t) * vtile + ps * (64 * NDVB); \
        unsigned kvo_ = kvo, vvo_ = vvo; asm volatile("" : "+v"(kvo_), "+v"(vvo_));   \
        if (!(KEEP && ps == 1)) { _Pragma("unroll") for (int i_ = 0; i_ < NKP / 8; ++i_) { const int ck = w + 8 * i_; \
            __builtin_amdgcn_global_load_lds((const unsigned*)(kb_ + ck * 16 + kvo_), (LAS unsigned*)(lds + (slot) * SLOT + ck * 1024), 16, 0, 0); } }   \
        _Pragma("unroll") for (int i_ = 0; i_ < NVP / 8; ++i_) { const int pv_ = w + 8 * i_, dvb_ = pv_ >> 2, kg_ = pv_ & 3; \
            __builtin_amdgcn_global_load_lds((const unsigned*)(vb_ + (size_t)(16 * kg_) * U.ldv * 2 + 64 * dvb_ + vvo_), (LAS unsigned*)(lds + (slot) * SLOT + KB + pv_ * 1024), 16, 0, 0); } \
    } while (0)
    bf16x8 qr[NM][DQ / 16];
    LAS unsigned char* qls = lds + OFF_QL + tid * 16;
    { const bf16_t* qp = U.Q + (size_t)(32 * w + r32) * U.ldq + 8 * hi;
#pragma unroll
      for (int r = 0; r < NM; ++r)
#pragma unroll
          for (int d0 = 0; d0 < DQ / 16; ++d0) { const bf16x8 v = *(const bf16x8*)(qp + r * DQ + 16 * d0);
              if (QLDS) *(LAS bf16x8*)(qls + (r * (DQ / 16) + d0) * 8192) = v; else qr[r][d0] = v; } }
    static_assert(!KEEP || (NM == 1 && NPASS == 2), "KEEP");
    bf16x8 pst[KEEP ? 4 : 1][4];
    float lsum[NM];
#pragma unroll
    for (int r = 0; r < NM; ++r) lsum[r] = 0.f;
#pragma unroll 1
    for (int ps_ = 0; ps_ < (KEEP ? 1 : NPASS); ++ps_)
#pragma unroll
    for (int ps = (KEEP ? 0 : ps_); ps < (KEEP ? NPASS : ps_ + 1); ++ps) {
    FA_DMA(0, 0);
    float zf_ = 0.f; asm volatile("" : "+v"(zf_));
    f32x16 o[NM][NDVB];
#pragma unroll
    for (int r = 0; r < NM; ++r)
#pragma unroll
        for (int d = 0; d < NDVB; ++d)
#pragma unroll
            for (int i = 0; i < 16; ++i) o[r][d][i] = zf_;
    if (!KEEP) {
#pragma unroll
        for (int r = 0; r < NM; ++r) lsum[r] = 0.f; }
    const int vis = U.vis0 + (w >> 1);
    const int kfo = hi * 1024 + r32 * 16;
    const int vfo = (4 * hi + ((l & 15) >> 2)) * 64 + ((l >> 4) & 1) * 32 + (l & 3) * 8;
    FA_WAIT_BAR();
    auto tile_body = [&](const int t, const int tk) {
        const int slot = t & 1;
        if (t + 1 < U.nt) FA_DMA(t + 1, slot ^ 1);
        if (t <= vis) {
            const LAS unsigned char* kb = lds + slot * SLOT + kfo;
            const unsigned vba = (unsigned)(size_t)(lds + slot * SLOT + KB + vfo);
#pragma unroll
            for (int r = 0; r < NM; ++r) {
                bf16x8 pw[4]; float ls = 0.f;
                if (KEEP && ps == 1) {
#pragma unroll
                    for (int k4 = 0; k4 < 4; ++k4) pw[k4] = pst[KEEP ? tk : 0][k4];
                } else {
#pragma unroll
                for (int kh = 0; kh < 2; ++kh) {
                    f32x16 p;
#pragma unroll
                    for (int i = 0; i < 16; ++i) p[i] = 0.f;
#pragma unroll
                    for (int d0 = 0; d0 < DQ / 16; ++d0) {
                        const bf16x8 a0 = *(const LAS bf16x8*)(kb + (r * (DQ / 8) + 2 * d0) * 1024 + kh * 512);
                        bf16x8 qf; if (QLDS) qf = *(const LAS bf16x8*)(qls + (r * (DQ / 16) + d0) * 8192); else qf = qr[r][d0];
                        p = __builtin_amdgcn_mfma_f32_32x32x16_bf16(a0, qf, p, 0, 0, 0);
                    }
#pragma unroll
                    for (int i = 0; i < 16; ++i) { p[i] = __builtin_amdgcn_exp2f(__builtin_fmaf(p[i], U.c, -U.mc)); ls += p[i]; }
                    u32x4 t0, t1;
                    t0.x = cvt_pk_bf16(p[0], p[1]); t0.y = cvt_pk_bf16(p[2], p[3]); t0.z = cvt_pk_bf16(p[4], p[5]); t0.w = cvt_pk_bf16(p[6], p[7]);
                    t1.x = cvt_pk_bf16(p[8], p[9]); t1.y = cvt_pk_bf16(p[10], p[11]); t1.z = cvt_pk_bf16(p[12], p[13]); t1.w = cvt_pk_bf16(p[14], p[15]);
                    pw[2 * kh] = __builtin_bit_cast(bf16x8, t0); pw[2 * kh + 1] = __builtin_bit_cast(bf16x8, t1);
                }
                if (KEEP) {
#pragma unroll
                    for (int k4 = 0; k4 < 4; ++k4) pst[KEEP ? tk : 0][k4] = pw[k4]; }
                lsum[r] += ls;
                }
                static_assert(NDVB == 4, "P V step layout");
#pragma unroll
                for (int ks = 0; ks < 4; ++ks) {
                    s16x4 lo[4], hh[4];
                    TR8K(lo, hh, vba, ks * 1024);
                    __builtin_amdgcn_sched_barrier(0);
#pragma unroll
                    for (int d = 0; d < 4; ++d) {
                        const bf16x8 vf = (bf16x8){lo[d][0], lo[d][1], lo[d][2], lo[d][3], hh[d][0], hh[d][1], hh[d][2], hh[d][3]};
                        o[r][d] = __builtin_amdgcn_mfma_f32_32x32x16_bf16(pw[ks], vf, o[r][d], 0, 0, 0); }
                }
            }
        }
        FA_WAIT_BAR();
    };
    if constexpr (KEEP) {
#pragma unroll
        for (int t = 0; t < 4; ++t) tile_body(t, t);
    } else {
        for (int t = 0; t < U.nt; ++t) tile_body(t, 0);
    }
#ifdef FA_NOEPI
    { float acc_ = lsum[0]; for (int r = 0; r < NM; ++r) for (int d = 0; d < NDVB; ++d) for (int i = 0; i < 16; ++i) acc_ += o[r][d][i]; U.O[tid] = f2bf(acc_); }
#else
    LAS float* wsf = (LAS float*)(lds + OFF_WS) + w * (NM * 32);
#pragma unroll
    for (int r = 0; r < NM; ++r) { const float v = sum_xor32(lsum[r]); if (hi == 0) wsf[r * 32 + r32] = __builtin_amdgcn_rcpf(v); }
    asm volatile("s_waitcnt lgkmcnt(0)" ::: "memory");
    char* ob = (char*)U.O + ((size_t)(32 * w) * U.ldo + ps * (32 * NDVB)) * 2;
    constexpr int SPITCH = NDVB * 64; LAS unsigned char* stg = lds + (QLDS ? OFF_QL : 0) + w * (32 * SPITCH);
    float wv[NDVB];
#pragma unroll
    for (int d = 0; d < NDVB; ++d) wv[d] = (MODE == 1) ? cx.in[17][32 * d + r32] * 0.8f : 1.0f;
#pragma unroll
    for (int i = 0; i < 16; ++i) {
        const int q = crow(i, hi); const float li0 = wsf[q]; float y[NDVB];
        if (MODE == 1) { const float li1 = wsf[(NM - 1) * 32 + q] * U.lam; float s2 = 0.f;
#pragma unroll
            for (int d = 0; d < NDVB; ++d) { y[d] = o[0][d][i] * li0 - o[NM - 1][d][i] * li1; s2 += y[d] * y[d]; }
            s2 = row32_sum(s2);
            const float rn = __builtin_amdgcn_rsqf(s2 * (1.0f / (32 * NDVB)) + EPS);
#pragma unroll
            for (int d = 0; d < NDVB; ++d) y[d] = y[d] * rn * wv[d]; }
        else {
#pragma unroll
            for (int d = 0; d < NDVB; ++d) y[d] = o[0][d][i] * li0; }
#pragma unroll
        for (int d = 0; d < NDVB; ++d) *(LAS bf16_t*)(stg + q * SPITCH + (32 * d + r32) * 2) = f2bf(y[d]);
    }
    asm volatile("s_waitcnt lgkmcnt(0)" ::: "memory");
#pragma unroll
    for (int it = 0; it < NDVB * 2; ++it) { const int c = it * 64 + l, row = c / (NDVB * 4), ch = c % (NDVB * 4);
        const u32x4 v = *(const LAS u32x4*)(stg + row * SPITCH + ch * 16);
        *(u32x4*)(ob + ((size_t)row * U.ldo + ch * 8) * 2) = v; }
#endif
    FA_WAIT_BAR();
    }
#undef FA_DMA
}


struct RetUnit {
    const bf16_t* Q; const bf16_t* K; const bf16_t* V;
    const bf16_t* G; bf16_t* O;
    int nt;
    int c0;
    float lg;
};
__device__ __forceinline__ void fa_ret_unit(LAS unsigned char* lds, const RetUnit& U, int WV) {
    constexpr int LDQ = 512, LDK = 512, LDV = 1024, LDO = 1024;
    constexpr int KB = 16384, SLOT = 49152, OFF_QP = 2 * SLOT, OFF_WS = OFF_QP + 4 * 14 * 1024;
    static_assert(OFF_WS + 8 * 32 * 4 <= ATT_BYTES, "ret LDS");
    int tid = TID_OF(WV); asm volatile("" : "+v"(tid));
    const int w = __builtin_amdgcn_readfirstlane(tid >> 6), l = tid & 63, r32 = l & 31, hi = l >> 5, rb = w >> 1, dh = w & 1;
    const unsigned kvo = (unsigned)((l & 31) * LDK * 2 + (l >> 5) * 16), vvo = (unsigned)((l >> 2) * LDV * 2 + (l & 3) * 16);
#define RT_DMA(t, slot) do { \
        const char* kb_ = (const char*)U.K + (size_t)(t) * (32 * LDK * 2); const char* vb_ = (const char*)U.V + (size_t)(t) * (32 * LDV * 2); \
        unsigned kvo_ = kvo, vvo_ = vvo; asm volatile("" : "+v"(kvo_), "+v"(vvo_)); \
        _Pragma("unroll") for (int i_ = 0; i_ < 2; ++i_) { const int cp = w + 8 * i_; \
            __builtin_amdgcn_global_load_lds((const unsigned*)(kb_ + cp * 32 + kvo_), (LAS unsigned*)(lds + (slot) * SLOT + cp * 1024), 16, 0, 0); } \
        _Pragma("unroll") for (int i_ = 0; i_ < 4; ++i_) { const int pv_ = w + 8 * i_, dvb_ = pv_ >> 1, kg_ = pv_ & 1; \
            __builtin_amdgcn_global_load_lds((const unsigned*)(vb_ + kg_ * (16 * LDV * 2) + 64 * dvb_ + vvo_), (LAS unsigned*)(lds + (slot) * SLOT + KB + pv_ * 1024), 16, 0, 0); } \
    } while (0)
    RT_DMA(0, 0);
    bf16x8 q0r, q1r;
    { const bf16_t* qp = U.Q + (size_t)(32 * rb + r32) * LDQ + 8 * hi; LAS unsigned char* qpk = lds + OFF_QP + rb * 14336 + l * 16;
      q0r = *(const bf16x8*)(qp); q1r = *(const bf16x8*)(qp + 16);
      if (dh == 0) {
#pragma unroll
          for (int d0 = 2; d0 < 16; ++d0) *(LAS bf16x8*)(qpk + (d0 - 2) * 1024) = *(const bf16x8*)(qp + 16 * d0); } }
    f32x16 o[8];
#pragma unroll
    for (int d = 0; d < 8; ++d)
#pragma unroll
        for (int i = 0; i < 16; ++i) o[d][i] = 0.f;
    const int cw = U.c0 + (rb >> 1);
    const int kfo = hi * 512 + r32 * 16;
    const int vfo = (4 * hi + ((l & 15) >> 2)) * 64 + ((l >> 4) & 1) * 32 + (l & 3) * 8;
    const LAS unsigned char* qpk = lds + OFF_QP + rb * 14336 + l * 16;
    const float qpos = (float)(64 * U.c0 + 32 * rb + r32);
    FA_WAIT_BAR();
    for (int t = 0; t < U.nt; ++t) {
        const int slot = t & 1;
        if (t + 1 < U.nt) RT_DMA(t + 1, slot ^ 1);
        if ((t >> 1) <= cw) {
            const LAS unsigned char* kb = lds + slot * SLOT + kfo;
            const unsigned vba = (unsigned)(size_t)(lds + slot * SLOT + KB + dh * 16384 + vfo);
            f32x16 p;
#pragma unroll
            for (int i = 0; i < 16; ++i) p[i] = 0.f;
            {
                bf16x8 ka[2][4], qa[2][4];
#define RT_LOADB(buf, b_) do { _Pragma("unroll") for (int j = 0; j < 4; ++j) { const int d0 = 4 * (b_) + j; ka[buf][j] = *(const LAS bf16x8*)(kb + d0 * 1024); \
                    if (d0 == 0) qa[buf][j] = q0r; else if (d0 == 1) qa[buf][j] = q1r; else qa[buf][j] = *(const LAS bf16x8*)(qpk + (d0 - 2) * 1024); } } while (0)
                RT_LOADB(0, 0);
#pragma unroll
                for (int b_ = 0; b_ < 4; ++b_) {
                    if (b_ < 3) RT_LOADB((b_ + 1) & 1, b_ + 1);
                    __builtin_amdgcn_sched_barrier(0);
#pragma unroll
                    for (int j = 0; j < 4; ++j) p = __builtin_amdgcn_mfma_f32_32x32x16_bf16(ka[b_ & 1][j], qa[b_ & 1][j], p, 0, 0, 0);
                    __builtin_amdgcn_sched_barrier(0);
                }
#undef RT_LOADB
            }
            const float dq = qpos - (float)(32 * t + 4 * hi);
#pragma unroll
            for (int i = 0; i < 16; ++i) { const float dd = dq - (float)((i & 3) + 8 * (i >> 2)); p[i] *= __builtin_amdgcn_exp2f(U.lg * __builtin_fabsf(dd)); }
            bf16x8 pw0, pw1;
            { u32x4 t0, t1;
              t0.x = cvt_pk_bf16(p[0], p[1]); t0.y = cvt_pk_bf16(p[2], p[3]); t0.z = cvt_pk_bf16(p[4], p[5]); t0.w = cvt_pk_bf16(p[6], p[7]);
              t1.x = cvt_pk_bf16(p[8], p[9]); t1.y = cvt_pk_bf16(p[10], p[11]); t1.z = cvt_pk_bf16(p[12], p[13]); t1.w = cvt_pk_bf16(p[14], p[15]);
              pw0 = __builtin_bit_cast(bf16x8, t0); pw1 = __builtin_bit_cast(bf16x8, t1); }
            {
#pragma unroll
                for (int dp = 0; dp < 4; ++dp) {
                    s16x4 lo[4], hh[4];
                    TR8(lo, hh, vba, dp * 4096);
                    __builtin_amdgcn_sched_barrier(0);
#pragma unroll
                    for (int j = 0; j < 4; ++j) {
                        const bf16x8 vf = (bf16x8){lo[j][0], lo[j][1], lo[j][2], lo[j][3], hh[j][0], hh[j][1], hh[j][2], hh[j][3]};
                        o[dp * 2 + (j >> 1)] = __builtin_amdgcn_mfma_f32_32x32x16_bf16((j & 1) ? pw1 : pw0, vf, o[dp * 2 + (j >> 1)], 0, 0, 0); }
                }
            }
        }
        FA_WAIT_BAR();
    }
#undef RT_DMA
    LAS float* wsf = (LAS float*)(lds + OFF_WS);
    float ssr[16];
#pragma unroll
    for (int i = 0; i < 16; ++i) { float s2 = 0.f;
#pragma unroll
        for (int d = 0; d < 8; ++d) s2 += o[d][i] * o[d][i];
        s2 = row32_sum(s2);
        ssr[i] = s2; if (r32 == 0) wsf[w * 32 + crow(i, hi)] = s2; }
    FA_WAIT_BAR();
    const size_t gbase = (size_t)(32 * rb) * LDO + 256 * dh + r32;
#pragma unroll
    for (int i = 0; i < 16; ++i) {
        const int q = crow(i, hi); const float rn = rsqrtf((ssr[i] + wsf[(w ^ 1) * 32 + q]) * (1.0f / 512.0f) + EPS);
        const size_t ro = gbase + (size_t)q * LDO;
#pragma unroll
        for (int d = 0; d < 8; ++d) { const float gt = bf2f(U.G[ro + 32 * d]); U.O[ro + 32 * d] = f2bf(o[d][i] * rn * (gt * fsigmoid(gt))); }
        __builtin_amdgcn_sched_barrier(0);
    }
    FA_WAIT_BAR();
}


struct Ret2Unit {
    const bf16_t* Q; const bf16_t* K; const bf16_t* V;
    const bf16_t* G; bf16_t* O; float* SS;
    int nt, c0; float lg;
};
__device__ __forceinline__ void fa_ret2_unit(LAS unsigned char* lds, const Ret2Unit& U, int WV) {
    constexpr int LDQ = 512, LDK = 512, LDV = 1024, LDO = 1024;
    constexpr int KB = 16384, SLOT = 32768, NS = 3, OFF_WS = NS * SLOT;
    static_assert(OFF_WS + 8 * 32 * 4 <= ATT_BYTES, "ret2 LDS");
    int tid = TID_OF(WV); asm volatile("" : "+v"(tid));
    const int w = __builtin_amdgcn_readfirstlane(tid >> 6), l = tid & 63, r32 = l & 31, hi = l >> 5, rb = w >> 1, dq = w & 1;
    const unsigned kvo = (unsigned)((l & 31) * LDK * 2 + (l >> 5) * 16), vvo = (unsigned)((l >> 2) * LDV * 2 + (l & 3) * 16);
#define R2_DMA(t, slot) do { \
        const char* kb_ = (const char*)U.K + (size_t)(t) * (32 * LDK * 2); const char* vb_ = (const char*)U.V + (size_t)(t) * (32 * LDV * 2); \
        unsigned kvo_ = kvo, vvo_ = vvo; asm volatile("" : "+v"(kvo_), "+v"(vvo_)); \
        _Pragma("unroll") for (int i_ = 0; i_ < 2; ++i_) { const int cp = w + 8 * i_; \
            __builtin_amdgcn_global_load_lds((const unsigned*)(kb_ + cp * 32 + kvo_), (LAS unsigned*)(lds + (slot) * SLOT + cp * 1024), 16, 0, 0); } \
        _Pragma("unroll") for (int i_ = 0; i_ < 2; ++i_) { const int pv_ = w + 8 * i_, dvb_ = pv_ >> 1, kg_ = pv_ & 1; \
            __builtin_amdgcn_global_load_lds((const unsigned*)(vb_ + kg_ * (16 * LDV * 2) + 64 * dvb_ + vvo_), (LAS unsigned*)(lds + (slot) * SLOT + KB + pv_ * 1024), 16, 0, 0); } \
    } while (0)
    R2_DMA(0, 0);
    if (U.nt > 1) R2_DMA(1, 1);
    bf16x8 qr[16];
    { const bf16_t* qp = U.Q + (size_t)(32 * rb + r32) * LDQ + 8 * hi;
#pragma unroll
      for (int d0 = 0; d0 < 16; ++d0) qr[d0] = *(const bf16x8*)(qp + 16 * d0); }
    f32x16 o[4];
    { float z = 0.f; asm volatile("" : "+v"(z));
#pragma unroll
    for (int d = 0; d < 4; ++d)
#pragma unroll
        for (int i = 0; i < 16; ++i) o[d][i] = z; }
    const int cw = U.c0 + (rb >> 1);
    const int kfo = hi * 512 + r32 * 16;
    const int vfo = (4 * hi + ((l & 15) >> 2)) * 64 + ((l >> 4) & 1) * 32 + (l & 3) * 8;
    const float qpos = (float)(64 * U.c0 + 32 * rb + r32);
    float cf[16];
#pragma unroll
    for (int i = 0; i < 16; ++i) cf[i] = __builtin_amdgcn_exp2f(-U.lg * (float)((i & 3) + 8 * (i >> 2)));
    asm volatile("s_waitcnt vmcnt(0) lgkmcnt(0)\n\ts_barrier" ::: "memory");
    int slot = 0;
    for (int t = 0; t < U.nt; ++t) {
        const int s2 = (slot >= 1) ? slot - 1 : 2;
        const bool more = (t + 2 < U.nt);
        if ((t >> 1) <= cw) {
            const LAS unsigned char* kb = lds + slot * SLOT + kfo;
            const unsigned vba = (unsigned)(size_t)(lds + slot * SLOT + KB + dq * 8192 + vfo);
            f32x16 p;
#pragma unroll
            for (int i = 0; i < 16; ++i) p[i] = 0.f;
            {   bf16x8 ka[2][4];
#define R2_LOADB(buf, b_) do { _Pragma("unroll") for (int j = 0; j < 4; ++j) ka[buf][j] = *(const LAS bf16x8*)(kb + (4 * (b_) + j) * 1024); } while (0)
                R2_LOADB(0, 0);
#pragma unroll
                for (int b_ = 0; b_ < 4; ++b_) {
                    if (b_ < 3) R2_LOADB((b_ + 1) & 1, b_ + 1);
                    __builtin_amdgcn_sched_barrier(0);
#pragma unroll
                    for (int j = 0; j < 4; ++j) p = __builtin_amdgcn_mfma_f32_32x32x16_bf16(ka[b_ & 1][j], qr[4 * b_ + j], p, 0, 0, 0);
                    __builtin_amdgcn_sched_barrier(0);
                }
#undef R2_LOADB
            }
            const float dqp = qpos - (float)(32 * t + 4 * hi);
            if ((t >> 1) < cw) {
                const float rowf = __builtin_amdgcn_exp2f(U.lg * dqp);
#pragma unroll
                for (int i = 0; i < 16; ++i) p[i] *= rowf * cf[i];
            } else {
#pragma unroll
                for (int i = 0; i < 16; ++i) { const float dd = dqp - (float)((i & 3) + 8 * (i >> 2)); p[i] *= __builtin_amdgcn_exp2f(U.lg * __builtin_fabsf(dd)); }
            }
            bf16x8 pw0, pw1;
            { u32x4 t0, t1;
              t0.x = cvt_pk_bf16(p[0], p[1]); t0.y = cvt_pk_bf16(p[2], p[3]); t0.z = cvt_pk_bf16(p[4], p[5]); t0.w = cvt_pk_bf16(p[6], p[7]);
              t1.x = cvt_pk_bf16(p[8], p[9]); t1.y = cvt_pk_bf16(p[10], p[11]); t1.z = cvt_pk_bf16(p[12], p[13]); t1.w = cvt_pk_bf16(p[14], p[15]);
              pw0 = __builtin_bit_cast(bf16x8, t0); pw1 = __builtin_bit_cast(bf16x8, t1); }
            {
                const LAS unsigned char* vbp = lds + slot * SLOT + KB + dq * 8192 + vfo;
#pragma unroll
                for (int dp = 0; dp < 2; ++dp)
#pragma unroll
                    for (int j = 0; j < 4; ++j) {
                        const s16x4 lo = ds_tr16(vbp + (dp * 4 + j) * 1024), hh = ds_tr16(vbp + (dp * 4 + j) * 1024 + 512);
                        const bf16x8 vf = (bf16x8){lo[0], lo[1], lo[2], lo[3], hh[0], hh[1], hh[2], hh[3]};
                        o[dp * 2 + (j >> 1)] = __builtin_amdgcn_mfma_f32_32x32x16_bf16((j & 1) ? pw1 : pw0, vf, o[dp * 2 + (j >> 1)], 0, 0, 0); }
            }
        }
        if (more) R2_DMA(t + 2, s2);
        if (more) asm volatile("s_waitcnt vmcnt(4) lgkmcnt(0)\n\ts_barrier" ::: "memory");
        else asm volatile("s_waitcnt vmcnt(0) lgkmcnt(0)\n\ts_barrier" ::: "memory");
        slot = (slot == 2) ? 0 : slot + 1;
    }
#undef R2_DMA
    LAS float* wsf = (LAS float*)(lds + OFF_WS);
    float ssr[16];
#pragma unroll
    for (int i = 0; i < 16; ++i) { float s2v = 0.f;
#pragma unroll
        for (int d = 0; d < 4; ++d) s2v += o[d][i] * o[d][i];
        s2v = row32_sum(s2v);
        ssr[i] = s2v; if (r32 == 0) wsf[w * 32 + crow(i, hi)] = s2v; }
    FA_WAIT_BAR();
    if (dq == 0 && r32 == 0) {
#pragma unroll
        for (int i = 0; i < 16; ++i) { const int q = crow(i, hi); U.SS[(size_t)(32 * rb + q) * 8] = ssr[i] + wsf[(w ^ 1) * 32 + q]; } }
    const size_t gbase = (size_t)(32 * rb) * LDO + 128 * dq + r32;
#pragma unroll
    for (int i = 0; i < 16; ++i) {
        const size_t ro = gbase + (size_t)crow(i, hi) * LDO;
#pragma unroll
        for (int d = 0; d < 4; ++d) { const float gt = bf2f(U.G[ro + 32 * d]); U.O[ro + 32 * d] = f2bf(o[d][i] * (gt * fsigmoid(gt))); }
        __builtin_amdgcn_sched_barrier(0);
    }
    FA_WAIT_BAR();
}

struct Ret3Unit {
    const bf16_t* Q; const bf16_t* K; const bf16_t* V;
    const bf16_t* G; bf16_t* O; float* SS;
    const bf16_t* ST;
    int nst, nt, c0; float lg;
};
__device__ __forceinline__ void fa_ret3_unit(LAS unsigned char* lds, const Ret3Unit& U, int WV) {
    constexpr int LDQ = 512, LDK = 512, LDV = 1024, LDO = 1024;
    constexpr int KB = 16384, SLOT = 32768, NS = 3, OFF_WS = NS * SLOT;
    static_assert(OFF_WS + 8 * 32 * 4 <= ATT_BYTES, "ret2 LDS");
    int tid = TID_OF(WV); asm volatile("" : "+v"(tid));
    const int w = __builtin_amdgcn_readfirstlane(tid >> 6), l = tid & 63, r32 = l & 31, hi = l >> 5, rb = w >> 1, dq = w & 1;
    const unsigned kvo = (unsigned)((l & 31) * LDK * 2 + (l >> 5) * 16), vvo = (unsigned)((l >> 2) * LDV * 2 + (l & 3) * 16);
#define R3_DMA(t, slot) do { \
        const char* kb_ = (const char*)U.K + (size_t)(t) * (32 * LDK * 2); const char* vb_ = (const char*)U.V + (size_t)(t) * (32 * LDV * 2); \
        unsigned kvo_ = kvo, vvo_ = vvo; asm volatile("" : "+v"(kvo_), "+v"(vvo_)); \
        _Pragma("unroll") for (int i_ = 0; i_ < 2; ++i_) { const int cp = w + 8 * i_; \
            __builtin_amdgcn_global_load_lds((const unsigned*)(kb_ + cp * 32 + kvo_), (LAS unsigned*)(lds + (slot) * SLOT + cp * 1024), 16, 0, 0); } \
        _Pragma("unroll") for (int i_ = 0; i_ < 2; ++i_) { const int pv_ = w + 8 * i_, dvb_ = pv_ >> 1, kg_ = pv_ & 1; \
            __builtin_amdgcn_global_load_lds((const unsigned*)(vb_ + kg_ * (16 * LDV * 2) + 64 * dvb_ + vvo_), (LAS unsigned*)(lds + (slot) * SLOT + KB + pv_ * 1024), 16, 0, 0); } \
    } while (0)
    const unsigned svo = (unsigned)(l * 512);
#define R3_DMAS(ts, slot) do { const char* sb_ = (const char*)U.ST + (size_t)((ts) >> 2) * (512 * 256 * 2) + ((ts) & 3) * 128; unsigned svo_ = svo; asm volatile("" : "+v"(svo_)); \
        _Pragma("unroll") for (int i_ = 0; i_ < 4; ++i_) { const int p_ = w + 8 * i_, c_ = p_ >> 2, dvq_ = p_ & 3; \
            __builtin_amdgcn_global_load_lds((const unsigned*)(sb_ + dvq_ * (64 * 512) + c_ * 16 + svo_), (LAS unsigned*)(lds + (slot) * SLOT + p_ * 1024), 16, 0, 0); } \
    } while (0)
#define R3_ANY(tt, slot) do { if ((tt) < nst) R3_DMAS((tt), (slot)); else R3_DMA((tt) - nst, (slot)); } while (0)
    const int nst = U.nst;
    R3_ANY(0, 0);
    R3_ANY(1, 1);
    bf16x8 qr[16];
    { const bf16_t* qp = U.Q + (size_t)(32 * rb + r32) * LDQ + 8 * hi;
#pragma unroll
      for (int d0 = 0; d0 < 16; ++d0) qr[d0] = *(const bf16x8*)(qp + 16 * d0); }
    f32x16 o[4];
    { float z = 0.f; asm volatile("" : "+v"(z));
#pragma unroll
    for (int d = 0; d < 4; ++d)
#pragma unroll
        for (int i = 0; i < 16; ++i) o[d][i] = z; }
    const int cw = U.c0 + (rb >> 1);
    const int kfo = hi * 512 + r32 * 16;
    const int vfo = (4 * hi + ((l & 15) >> 2)) * 64 + ((l >> 4) & 1) * 32 + (l & 3) * 8;
    const float qpos = (float)(64 * U.c0 + 32 * rb + r32);
    float cf[16];
#pragma unroll
    for (int i = 0; i < 16; ++i) cf[i] = __builtin_amdgcn_exp2f(-U.lg * (float)((i & 3) + 8 * (i >> 2)));
    asm volatile("s_waitcnt vmcnt(0) lgkmcnt(0)\n\ts_barrier" ::: "memory");
    PROBE_MARK1(lds, 10);
    int slot = 0;
    if (nst) {
        const float g512 = __builtin_amdgcn_exp2f(U.lg * 512.0f);
        const int ngrp = nst >> 2;
        for (int grp = 0; grp < ngrp; ++grp) {
            if (grp) {
#pragma unroll
                for (int d = 0; d < 4; ++d)
#pragma unroll
                    for (int i = 0; i < 16; ++i) o[d][i] *= g512; }
#pragma unroll
            for (int ts = 0; ts < 4; ++ts) {
                const LAS unsigned char* sb = lds + slot * SLOT + hi * 4096 + (128 * dq + r32) * 16;
#pragma unroll
                for (int d0l = 0; d0l < 4; ++d0l) {
                    bf16x8 sf[4];
#pragma unroll
                    for (int d = 0; d < 4; ++d) sf[d] = *(const LAS bf16x8*)(sb + d0l * 8192 + d * 512);
#pragma unroll
                    for (int d = 0; d < 4; ++d) o[d] = __builtin_amdgcn_mfma_f32_32x32x16_bf16(qr[4 * ts + d0l], sf[d], o[d], 0, 0, 0);
                }
                const int s2 = (slot >= 1) ? slot - 1 : 2;
                R3_ANY(4 * grp + ts + 2, s2);
                asm volatile("s_waitcnt vmcnt(4) lgkmcnt(0)\n\ts_barrier" ::: "memory");
                slot = (slot == 2) ? 0 : slot + 1;
            }
        }
#pragma unroll
        for (int i = 0; i < 16; ++i) { const float rf = __builtin_amdgcn_exp2f(U.lg * (float)(64 * U.c0 + 32 * rb + crow(i, hi) + 1));
#pragma unroll
            for (int d = 0; d < 4; ++d) o[d][i] *= rf; }
    }
#ifdef PROBE_NOTILE
    const int ntl_ = 0;
#else
    const int ntl_ = U.nt;
#endif
    for (int t = 0; t < ntl_; ++t) {
        const int s2 = (slot >= 1) ? slot - 1 : 2;
        const bool more = (t + 2 < U.nt);
        if ((t >> 1) <= cw) {
            const LAS unsigned char* kb = lds + slot * SLOT + kfo;
            const unsigned vba = (unsigned)(size_t)(lds + slot * SLOT + KB + dq * 8192 + vfo);
            f32x16 p;
#pragma unroll
            for (int i = 0; i < 16; ++i) p[i] = 0.f;
            {   bf16x8 ka[2][4];
#define R3_LOADB(buf, b_) do { _Pragma("unroll") for (int j = 0; j < 4; ++j) ka[buf][j] = *(const LAS bf16x8*)(kb + (4 * (b_) + j) * 1024); } while (0)
                R3_LOADB(0, 0);
#pragma unroll
                for (int b_ = 0; b_ < 4; ++b_) {
                    if (b_ < 3) R3_LOADB((b_ + 1) & 1, b_ + 1);
                    __builtin_amdgcn_sched_barrier(0);
#pragma unroll
                    for (int j = 0; j < 4; ++j) p = __builtin_amdgcn_mfma_f32_32x32x16_bf16(ka[b_ & 1][j], qr[4 * b_ + j], p, 0, 0, 0);
                    __builtin_amdgcn_sched_barrier(0);
                }
#undef R3_LOADB
            }
            const float dqp = qpos - (float)(32 * t + 4 * hi);
            if ((t >> 1) < cw) {
                const float rowf = __builtin_amdgcn_exp2f(U.lg * dqp);
#pragma unroll
                for (int i = 0; i < 16; ++i) p[i] *= rowf * cf[i];
            } else {
#pragma unroll
                for (int i = 0; i < 16; ++i) { const float dd = dqp - (float)((i & 3) + 8 * (i >> 2)); p[i] *= __builtin_amdgcn_exp2f(U.lg * __builtin_fabsf(dd)); }
            }
            bf16x8 pw0, pw1;
            { u32x4 t0, t1;
              t0.x = cvt_pk_bf16(p[0], p[1]); t0.y = cvt_pk_bf16(p[2], p[3]); t0.z = cvt_pk_bf16(p[4], p[5]); t0.w = cvt_pk_bf16(p[6], p[7]);
              t1.x = cvt_pk_bf16(p[8], p[9]); t1.y = cvt_pk_bf16(p[10], p[11]); t1.z = cvt_pk_bf16(p[12], p[13]); t1.w = cvt_pk_bf16(p[14], p[15]);
              pw0 = __builtin_bit_cast(bf16x8, t0); pw1 = __builtin_bit_cast(bf16x8, t1); }
            {
#pragma unroll
                for (int dp = 0; dp < 2; ++dp) {
                    s16x4 lo[4], hh[4];
                    TR8(lo, hh, vba, dp * 4096);
                    __builtin_amdgcn_sched_barrier(0);
#pragma unroll
                    for (int j = 0; j < 4; ++j) {
                        const bf16x8 vf = (bf16x8){lo[j][0], lo[j][1], lo[j][2], lo[j][3], hh[j][0], hh[j][1], hh[j][2], hh[j][3]};
                        o[dp * 2 + (j >> 1)] = __builtin_amdgcn_mfma_f32_32x32x16_bf16((j & 1) ? pw1 : pw0, vf, o[dp * 2 + (j >> 1)], 0, 0, 0); }
                }
            }
        }
        if (more) R3_DMA(t + 2, s2);
        if (more) asm volatile("s_waitcnt vmcnt(4) lgkmcnt(0)\n\ts_barrier" ::: "memory");
        else asm volatile("s_waitcnt vmcnt(0) lgkmcnt(0)\n\ts_barrier" ::: "memory");
        slot = (slot == 2) ? 0 : slot + 1;
    }
#undef R3_DMA
#undef R3_DMAS
#undef R3_ANY
    PROBE_MARK1(lds, 11);
    const char* gb = (const char*)U.G + ((size_t)(32 * rb) * LDO + 128 * dq) * 2;
    u32x4 gq[8];
#pragma unroll
    for (int it = 0; it < 8; ++it) { const int c = it * 64 + l, row = c >> 4, ch = c & 15; gq[it] = *(const u32x4*)(gb + ((size_t)row * LDO + ch * 8) * 2); }
    LAS float* wsf = (LAS float*)(lds + OFF_WS);
    float ssr[16];
#pragma unroll
    for (int i = 0; i < 16; ++i) { float s2v = 0.f;
#pragma unroll
        for (int d = 0; d < 4; ++d) s2v += o[d][i] * o[d][i];
        s2v = row32_sum(s2v);
        ssr[i] = s2v; if (r32 == 0) wsf[w * 32 + crow(i, hi)] = s2v; }
    FA_WAIT_BAR();
    PROBE_MARK1(lds, 12);
    if (dq == 0 && r32 == 0) {
#pragma unroll
        for (int i = 0; i < 16; ++i) { const int q = crow(i, hi); U.SS[(size_t)(32 * rb + q) * 8] = ssr[i] + wsf[(w ^ 1) * 32 + q]; } }
#ifndef PROBE_NOEPI_A
    { LAS unsigned char* stg = lds + w * 8192; char* obp = (char*)U.O + ((size_t)(32 * rb) * LDO + 128 * dq) * 2;
#pragma unroll
      for (int it = 0; it < 8; ++it) { const int c = it * 64 + l, row = c >> 4, ch = c & 15; *(LAS u32x4*)(stg + row * 256 + ch * 16) = gq[it]; }
      asm volatile("s_waitcnt lgkmcnt(0)" ::: "memory");
      PROBE_MARK1(lds, 13);
#ifndef PROBE_NOEPI_B
      unsigned short gt16[16][4];
#pragma unroll
      for (int i = 0; i < 16; ++i) { const int q = crow(i, hi);
#pragma unroll
          for (int d = 0; d < 4; ++d) gt16[i][d] = *(const LAS bf16_t*)(stg + q * 256 + (32 * d + r32) * 2); }
      asm volatile("s_waitcnt lgkmcnt(0)" ::: "memory");
#pragma unroll
      for (int i = 0; i < 16; ++i) { const int q = crow(i, hi);
#pragma unroll
          for (int d = 0; d < 4; ++d) { const float gt = bf2f(gt16[i][d]); *(LAS bf16_t*)(stg + q * 256 + (32 * d + r32) * 2) = f2bf(o[d][i] * (gt * fsigmoid(gt))); } }
#endif
      asm volatile("s_waitcnt lgkmcnt(0)" ::: "memory");
      PROBE_MARK1(lds, 14);
#pragma unroll
      for (int it = 0; it < 8; ++it) { const int c = it * 64 + l, row = c >> 4, ch = c & 15; *(u32x4*)(obp + ((size_t)row * LDO + ch * 8) * 2) = *(const LAS u32x4*)(stg + row * 256 + ch * 16); } }
#else
    { float a_ = 0.f; for (int d = 0; d < 4; ++d) for (int i = 0; i < 16; ++i) a_ += o[d][i]; U.O[tid] = f2bf(a_); }
#endif
    FA_WAIT_BAR();
    PROBE_MARK1(lds, 15);
}


struct StJob { const bf16_t* K; const bf16_t* V; bf16_t* ST; int nt; float lg; const bf16_t* PREV; float gprev; unsigned* waitc; };
__device__ __forceinline__ void st_job(LAS unsigned char* lds, const StJob& J, int WV) {
    constexpr int LDK = 512, LDV = 1024, VB = 16384, SLOT = 49152;
    static_assert(2 * SLOT <= ATT_BYTES, "st LDS");
    int tid = TID_OF(WV); asm volatile("" : "+v"(tid));
    const int w = __builtin_amdgcn_readfirstlane(tid >> 6), l = tid & 63, r32 = l & 31, hi = l >> 5, wm = w >> 1, wn = w & 1;
    const unsigned vvo = (unsigned)((l >> 2) * LDV * 2 + (l & 3) * 16), kvo = (unsigned)((l >> 2) * LDK * 2 + (l & 3) * 16);
#define ST_DMA(t, slot) do { const char* vb_ = (const char*)J.V + (size_t)(t) * (64 * LDV * 2); const char* kb_ = (const char*)J.K + (size_t)(t) * (64 * LDK * 2); \
        unsigned vvo_ = vvo, kvo_ = kvo; asm volatile("" : "+v"(vvo_), "+v"(kvo_)); \
        _Pragma("unroll") for (int i_ = 0; i_ < 2; ++i_) { const int p_ = w + 8 * i_, blk_ = p_ >> 2, kg_ = p_ & 3; \
            __builtin_amdgcn_global_load_lds((const unsigned*)(vb_ + kg_ * (16 * LDV * 2) + 64 * blk_ + vvo_), (LAS unsigned*)(lds + (slot) * SLOT + p_ * 1024), 16, 0, 0); } \
        _Pragma("unroll") for (int i_ = 0; i_ < 4; ++i_) { const int p_ = w + 8 * i_, blk_ = p_ >> 2, kg_ = p_ & 3; \
            __builtin_amdgcn_global_load_lds((const unsigned*)(kb_ + kg_ * (16 * LDK * 2) + 64 * blk_ + kvo_), (LAS unsigned*)(lds + (slot) * SLOT + VB + p_ * 1024), 16, 0, 0); } \
    } while (0)
    ST_DMA(0, 0);
    f32x16 acc[4];
    { float z = 0.f; asm volatile("" : "+v"(z));
#pragma unroll
    for (int d = 0; d < 4; ++d)
#pragma unroll
        for (int i = 0; i < 16; ++i) acc[d][i] = z; }
    float gj[8], gs[4];
#pragma unroll
    for (int j = 0; j < 8; ++j) gj[j] = __builtin_amdgcn_exp2f(-J.lg * (float)(8 * (j >> 2) + (j & 3)));
#pragma unroll
    for (int sI = 0; sI < 4; ++sI) gs[sI] = __builtin_amdgcn_exp2f(J.lg * (float)(63 - 16 * sI - 4 * hi));
    const float g64 = __builtin_amdgcn_exp2f(J.lg * 64.0f);
    const int tfo = (4 * hi + ((l & 15) >> 2)) * 64 + ((l >> 4) & 1) * 32 + (l & 3) * 8;
    FA_WAIT_BAR();
    for (int t = 0; t < J.nt; ++t) {
        const int slot = t & 1;
        if (t + 1 < J.nt) ST_DMA(t + 1, slot ^ 1);
#pragma unroll
        for (int d = 0; d < 4; ++d)
#pragma unroll
            for (int i = 0; i < 16; ++i) acc[d][i] *= g64;
        const unsigned va = (unsigned)(size_t)(lds + slot * SLOT + wm * 4096 + tfo);
        const unsigned ka = (unsigned)(size_t)(lds + slot * SLOT + VB + wn * 16384 + tfo);
#pragma unroll
        for (int sI = 0; sI < 4; ++sI) {
            s16x4 vlo, vhh, klo[4], khh[4];
            asm volatile("ds_read_b64_tr_b16 %0, %10 offset:%c12\n\tds_read_b64_tr_b16 %1, %10 offset:%c13\n\t"
                         "ds_read_b64_tr_b16 %2, %11 offset:%c14\n\tds_read_b64_tr_b16 %3, %11 offset:%c15\n\t"
                         "ds_read_b64_tr_b16 %4, %11 offset:%c16\n\tds_read_b64_tr_b16 %5, %11 offset:%c17\n\t"
                         "ds_read_b64_tr_b16 %6, %11 offset:%c18\n\tds_read_b64_tr_b16 %7, %11 offset:%c19\n\t"
                         "ds_read_b64_tr_b16 %8, %11 offset:%c20\n\tds_read_b64_tr_b16 %9, %11 offset:%c21\n\ts_waitcnt lgkmcnt(0)"
                         : "=&v"(vlo), "=&v"(vhh), "=&v"(klo[0]), "=&v"(khh[0]), "=&v"(klo[1]), "=&v"(khh[1]), "=&v"(klo[2]), "=&v"(khh[2]), "=&v"(klo[3]), "=&v"(khh[3])
                         : "v"(va), "v"(ka), "i"(sI * 1024), "i"(sI * 1024 + 512),
                           "i"(0 * 4096 + sI * 1024), "i"(0 * 4096 + sI * 1024 + 512), "i"(1 * 4096 + sI * 1024), "i"(1 * 4096 + sI * 1024 + 512),
                           "i"(2 * 4096 + sI * 1024), "i"(2 * 4096 + sI * 1024 + 512), "i"(3 * 4096 + sI * 1024), "i"(3 * 4096 + sI * 1024 + 512) : "memory");
            __builtin_amdgcn_sched_barrier(0);
            float x[8];
#pragma unroll
            for (int j = 0; j < 4; ++j) { x[j] = bf2f((unsigned short)vlo[j]) * (gs[sI] * gj[j]); x[4 + j] = bf2f((unsigned short)vhh[j]) * (gs[sI] * gj[4 + j]); }
            u32x4 aw; aw.x = cvt_pk_bf16(x[0], x[1]); aw.y = cvt_pk_bf16(x[2], x[3]); aw.z = cvt_pk_bf16(x[4], x[5]); aw.w = cvt_pk_bf16(x[6], x[7]);
            const bf16x8 af = __builtin_bit_cast(bf16x8, aw);
#pragma unroll
            for (int d = 0; d < 4; ++d) { const bf16x8 kf = (bf16x8){klo[d][0], klo[d][1], klo[d][2], klo[d][3], khh[d][0], khh[d][1], khh[d][2], khh[d][3]};
                acc[d] = __builtin_amdgcn_mfma_f32_32x32x16_bf16(af, kf, acc[d], 0, 0, 0); }
        }
        FA_WAIT_BAR();
    }
#undef ST_DMA
    if (J.waitc) {
        if (WV == 0) { unsigned sp = 0;
            while ((unsigned)__builtin_amdgcn_readfirstlane(__hip_atomic_load(J.waitc, __ATOMIC_RELAXED, __HIP_MEMORY_SCOPE_AGENT)) < 4u) { __builtin_amdgcn_s_sleep(2); if (++sp > (1u << 22)) break; }
            __builtin_amdgcn_fence(__ATOMIC_ACQUIRE, "agent");
            asm volatile("s_waitcnt vmcnt(0)" ::: "memory"); }
        asm volatile("s_waitcnt vmcnt(0) lgkmcnt(0)\n\ts_barrier" ::: "memory");
    }
    unsigned short pv[16][4];
    { const bf16_t* pp = J.PREV + (size_t)(32 * wm) * 256 + 128 * wn + r32;
#pragma unroll
      for (int i = 0; i < 16; ++i)
#pragma unroll
          for (int d = 0; d < 4; ++d) pv[i][d] = pp[(size_t)crow(i, hi) * 256 + 32 * d]; }
    const float gp = J.gprev;
    const int odd = l & 1;
    unsigned* op = (unsigned*)(J.ST + (size_t)(32 * wm) * 256 + 128 * wn + (r32 & ~1));
#pragma unroll
    for (int i = 0; i < 16; ++i) {
#pragma unroll
        for (int dp = 0; dp < 2; ++dp) {
            const float ae = acc[2 * dp][i] + gp * bf2f(pv[i][2 * dp]), ao = acc[2 * dp + 1][i] + gp * bf2f(pv[i][2 * dp + 1]);
            const float mine = odd ? ao : ae, give = odd ? ae : ao;
            const float got = dppf<0xB1>(give);
            const unsigned w2 = odd ? cvt_pk_bf16(got, mine) : cvt_pk_bf16(mine, got);
            __hip_atomic_store(op + ((size_t)crow(i, hi) * 256 + 32 * (2 * dp + odd)) / 2, w2, __ATOMIC_RELAXED, __HIP_MEMORY_SCOPE_AGENT);
        }
        __builtin_amdgcn_sched_barrier(0);
    }
    FA_WAIT_BAR();
}

__device__ __forceinline__ unsigned pk2(float lo, float hi) { return cvt_pk_bf16(lo, hi); }
__device__ __forceinline__ int win_src(int r) {
    if (r < 2048) {
        const int sec = r >> 10, rr = r & 1023, t = rr >> 8, p = rr & 255, bj = p >> 7, wc = (p >> 5) & 3, fq = (p >> 3) & 3, ne = p & 7;
        const int d = (fq == 0) ? (8 * bj + ne) : (16 * fq + 8 * bj + ne);
        return 6144 + sec * 1024 + t * 256 + 64 * wc + d; }
    if (r < 3072) return 8192 + (r - 2048);
    if (r < 4096) return 9216 + (r - 3072);
    if (r < 5120) return 10240 + 1024 + (r - 4096);
    if (r < 6144) return 10240 + 2048 + (r - 5120);
    if (r < 6656) return (r - 6144);
    if (r < 7168) return 1024 + (r - 6656);
    if (r < 8192) return 2048 + (r - 7168);
    if (r < 9216) return 4096 + (r - 8192);
    if (r < 9728) return 512 + (r - 9216);
    if (r < 10240) return 1536 + (r - 9728);
    if (r < 11264) return 3072 + (r - 10240);
    if (r < 12288) return 5120 + (r - 11264);
    return 10240 + (r - 12288);
}
struct P0Item { f32x4 v[8]; float sc[8]; };
__device__ __forceinline__ void p0_load(P0Item& it, int kind, const float* W, const float* W2, int Nsrc, const float* scale, int Nout, int item, int lane) {
    const int nblk = Nout / 32, kb = item / nblk, nb = item % nblk, k0 = 64 * kb, n0 = 32 * nb;
    const int kr = lane >> 3, c4 = lane & 7, rr = n0 + 4 * c4; const float* src = W; int sc;
    if (kind == 0) sc = rr; else if (kind == 1) sc = win_src(rr); else { const int t = rr >> 8, p = rr & 255; if (p < 128) sc = 128 * t + p; else { sc = 128 * t + p - 128; src = W2; } }
#pragma unroll
    for (int i = 0; i < 8; ++i) it.v[i] = __builtin_nontemporal_load((const f32x4*)(src + (size_t)(k0 + 8 * i + kr) * Nsrc + sc));
#pragma unroll
    for (int i = 0; i < 8; ++i) it.sc[i] = scale ? scale[k0 + 8 * i + kr] : 1.0f;
}
__device__ __forceinline__ void p0_store(const P0Item& it, bf16_t* WT, int K, int Nout, LAS float* scr, int item, int lane) {
    const int nblk = Nout / 32, kb = item / nblk, nb = item % nblk, k0 = 64 * kb, n0 = 32 * nb;
    const int kr = lane >> 3, c4 = lane & 7;
#pragma unroll
    for (int i = 0; i < 8; ++i) { const int kk = 8 * i + kr; const f32x4 x = it.v[i] * it.sc[i];
        scr[kk * 33 + 4 * c4 + 0] = x[0]; scr[kk * 33 + 4 * c4 + 1] = x[1]; scr[kk * 33 + 4 * c4 + 2] = x[2]; scr[kk * 33 + 4 * c4 + 3] = x[3]; }
    asm volatile("s_waitcnt lgkmcnt(0)" ::: "memory");
    const int c = lane & 7;
#pragma unroll
    for (int j = 0; j < 4; ++j) { const int n = (lane >> 3) + 8 * j; const LAS float* s = scr + (8 * c) * 33 + n;
        u32x4 o; o.x = pk2(s[0 * 33], s[1 * 33]); o.y = pk2(s[2 * 33], s[3 * 33]); o.z = pk2(s[4 * 33], s[5 * 33]); o.w = pk2(s[6 * 33], s[7 * 33]);
        *(u32x4*)(WT + (size_t)(n0 + n) * K + k0 + 8 * c) = o; }
    asm volatile("s_waitcnt lgkmcnt(0)" ::: "memory");
}

struct Args { InTab in; float* out; unsigned char* ws; int ph_lo, ph_hi; };

__global__ void __launch_bounds__(512, 2) mk_fwd(const Args args) {
    extern __shared__ __attribute__((aligned(16))) unsigned char lds_raw[];
    LAS unsigned char* lds = (LAS unsigned char*)lds_raw;
    volatile LAS unsigned* MISC = (volatile LAS unsigned*)(lds + MISC_OFF);
    const int tid0 = threadIdx.x;
    const int WV = __builtin_amdgcn_readfirstlane(tid0 >> 6);
    const int G = gridDim.x, bx = blockIdx.x; const int vcu = (G % 8 == 0) ? (bx % 8) * (G / 8) + bx / 8 : bx;
    Ctx cx;
    cx.in.tab = (const __attribute__((address_space(4))) InTab*)__builtin_amdgcn_kernarg_segment_ptr();
    cx.out = args.out; cx.ws = args.ws;
    for (int u = tid0; u < (LDS_BYTES - MISC_OFF) / 4; u += 512) ((LAS unsigned*)(lds + MISC_OFF))[u] = 0u;
    __syncthreads();
    unsigned* ctl = WSP(unsigned, WS_CTL);
    XcdBarrier bar; bar.bar = ctl + 4096; bar.x = 0; bar.st = nullptr;
    const bool multi = (args.ph_hi - args.ph_lo) > 1;
    if (multi) bar = xcd_barrier_post(ctl + 4096, MISC + 8, tid0 == 0);
    const int NGW = G * 8;

#define PHASE_IDS const int lane = lane_id(), wave = WV, tid = wave * 64 + lane, gw = vcu * 8 + wave; (void)tid; (void)gw
    if (args.ph_lo <= PH_PRO && PH_PRO < args.ph_hi) { PHASE_IDS;
            LAS float* scr = (LAS float*)(lds + wave * 16384);
            int base = 0;
#define RUNJOB(kind, W, W2, Nsrc, scale, dst, K_, Nout) do { const int nit = ((K_) / 64) * ((Nout) / 32); const int first = (gw - (base % NGW) + NGW) % NGW; \
                if (first < nit) { P0Item cur_; p0_load(cur_, kind, W, W2, Nsrc, scale, Nout, first, lane); \
                    for (int itx = first; itx < nit; itx += NGW) { P0Item nx_ = cur_; if (itx + NGW < nit) p0_load(nx_, kind, W, W2, Nsrc, scale, Nout, itx + NGW, lane); \
                        p0_store(cur_, WSP(bf16_t, dst), K_, Nout, scr, itx, lane); cur_ = nx_; } } \
                base += nit; } while (0)
            RUNJOB(1, CX_F(8), nullptr, DIN, CX_F(7), WS_WIN, 1024, DIN);
            RUNJOB(2, CX_F(4), CX_F(5), DFF, CX_F(3), WS_W1GU, 1024, 2 * DFF);
            RUNJOB(0, CX_F(6), nullptr, D, nullptr, WS_W1D, DFF, D);
            RUNJOB(2, CX_F(26), CX_F(27), DFF, CX_F(25), WS_W2GU, 1024, 2 * DFF);
            RUNJOB(0, CX_F(28), nullptr, D, nullptr, WS_W2D, DFF, D);
            RUNJOB(0, CX_F(10), nullptr, D, nullptr, WS_WRO, 512, D);
            RUNJOB(0, CX_F(10) + (size_t)512 * 1024, nullptr, D, nullptr, WS_WRO + (size_t)1 * 1024 * 512 * 2, 512, D);
            RUNJOB(0, CX_F(10) + (size_t)1024 * 1024, nullptr, D, nullptr, WS_WRO + (size_t)2 * 1024 * 512 * 2, 512, D);
            RUNJOB(0, CX_F(10) + (size_t)1536 * 1024, nullptr, D, nullptr, WS_WRO + (size_t)3 * 1024 * 512 * 2, 512, D);
            RUNJOB(0, CX_F(18), nullptr, D, nullptr, WS_WDO, 1024, D);
            RUNJOB(0, CX_F(23), nullptr, D, nullptr, WS_WMO, 1024, D);
            RUNJOB(0, CX_F(24), nullptr, D, nullptr, WS_WOUT, 1024, D);
            RUNJOB(0, CX_F(20), nullptr, 2048, nullptr, WS_WMKV, 1024, 2048);
#undef RUNJOB
            float* part0 = WSP(float, WS_PART); bf16_t* XB = WSP(bf16_t, WS_XB);
            for (int m0 = gw; m0 < T; m0 += 4 * NGW) {
                f32x4 v[4][4];
#pragma unroll
                for (int r = 0; r < 4; ++r) { const int mr = (m0 + r * NGW < T) ? m0 + r * NGW : m0; const f32x4* xr = (const f32x4*)(CX_F(0) + (size_t)mr * D) + lane;
#pragma unroll
                    for (int j = 0; j < 4; ++j) v[r][j] = __builtin_nontemporal_load(xr + 64 * j); }
#pragma unroll
                for (int r = 0; r < 4; ++r) { const int m = m0 + r * NGW; if (m >= T) break; float s = 0.f; unsigned long long* o8 = (unsigned long long*)(XB + (size_t)m * D) + lane;
#pragma unroll
                    for (int j = 0; j < 4; ++j) { const f32x4 x = v[r][j]; s += (x[0] * x[0] + x[1] * x[1]) + (x[2] * x[2] + x[3] * x[3]);
                        o8[64 * j] = (unsigned long long)pk2(x[0], x[1]) | ((unsigned long long)pk2(x[2], x[3]) << 32); }
                    s = wave_sum(s);
                    if (lane < 16) part0[(size_t)m * 16 + lane] = (lane == 0) ? s : 0.f; }
            }
            bf16_t* MN = WSP(bf16_t, WS_MEMN);
            for (int m = gw; m < TM; m += NGW) {
                const f32x4* xr = (const f32x4*)(CX_F(1) + (size_t)m * D) + lane; const f32x4* wr_ = (const f32x4*)CX_F(19) + lane; f32x4 v[4]; float s = 0.f;
#pragma unroll
                for (int j = 0; j < 4; ++j) { v[j] = xr[64 * j]; s += (v[j][0] * v[j][0] + v[j][1] * v[j][1]) + (v[j][2] * v[j][2] + v[j][3] * v[j][3]); }
                const float ri = rsqrtf(wave_sum(s) * (1.0f / D) + EPS); unsigned long long* o8 = (unsigned long long*)(MN + (size_t)m * D) + lane;
#pragma unroll
                for (int j = 0; j < 4; ++j) { const f32x4 wv = wr_[64 * j]; const f32x4 y = v[j] * ri * wv;
                    o8[64 * j] = (unsigned long long)pk2(y[0], y[1]) | ((unsigned long long)pk2(y[2], y[3]) << 32); }
            }
            float* rope = WSP(float, WS_DROPE); const int* pos = (const int*)CX_F(2);
            for (int e = gw * 64 + lane; e < T * 8; e += NGW * 64) { const int m = e >> 3, i = e & 7;
                const float inv = 1.0f / powf(500000.0f, (float)(2 * i) / 16.0f); const float ang = (float)pos[m] * inv; const float sn = sinf(ang), cs = cosf(ang);
                rope[(size_t)e * 2] = cs; rope[(size_t)e * 2 + 1] = sn; }
            if (bx == 0 && tid < 128) { const float tt = (float)tid / 127.0f; WSP(float, WS_RINV)[tid] = 1.0f / powf(10000.0f, tt); }
        if (multi) xcd_barrier(bar, WV == 0 && lane_id() == 0);
    }
#ifndef PHASE_SEQ
#define PHASE_SEQ 1,2,3,4,5,6,8,12,13,14,15
#endif
    constexpr int seq_[] = {PHASE_SEQ}; constexpr int nseq = sizeof(seq_) / sizeof(int);
    for (int si = 0; si < nseq; ++si) {
        int ph = 0;
#pragma unroll
        for (int k = 0; k < nseq; ++k) ph = (si == k) ? seq_[k] : ph;
        if (ph < args.ph_lo || ph >= args.ph_hi) continue;
        PROBE_T0(lds, ph);
        switch (ph) {
        case PH_F1GU: case PH_F1D: case PH_IN_DM: case PH_MG1: case PH_IN_R0: case PH_IN_R1: case PH_MG2: case PH_WOUT: case PH_F2GU: case PH_F2D: {
#ifndef NO_GEMM
            GemmSched S; S.ph = ph; S.c = bx; S.G = G; S.cxp = &cx;
            gemm_phase(lds, S, cx, WV);
#endif
        } break;
        case PH_ATT_DM: { PHASE_IDS;
            float lam, mcd;
            { float a = CX_F(13)[lane] * CX_F(14)[lane], b = CX_F(15)[lane] * CX_F(16)[lane], mq_ = fabsf(CX_F(11)[lane]), mk_ = fabsf(CX_F(12)[lane]);
              a = wave_sum(a); b = wave_sum(b); mq_ = wave_max(mq_); mk_ = wave_max(mk_);
              lam = uni(expf(a) - expf(b) + 0.2f); mcd = uni(8.0f * mq_ * mk_ * LOG2E); }
            bf16_t* DQ = WSP(bf16_t, WS_DQ); const bf16_t* DK = WSP(bf16_t, WS_DK); const bf16_t* DV_ = WSP(bf16_t, WS_DV);
            for (int id = vcu; id < 256; id += G) {
                const int bh = id >> 2, p = id & 3, b = bh >> 3, h = bh & 7;
#pragma unroll 1
                for (int half = 0; half < 2; ++half) { const int qb = half ? 7 - p : p;
                    FaUnit U; const size_t r0 = (size_t)b * SEQ + qb * 256;
                    U.Q = DQ + r0 * 1024 + h * 128; U.ldq = 1024; U.K = DK + (size_t)b * SEQ * 1024 + h * 128; U.ldk = 1024; U.V = DV_ + (size_t)b * SEQ * 1024 + h * 128; U.ldv = 1024;
                    U.O = DQ + r0 * 1024 + h * 128; U.ldo = 1024; U.nt = 4 * qb + 4; U.vis0 = 4 * qb; U.c = 0.125f * LOG2E; U.mc = mcd; U.lam = lam;
#ifndef NO_FADIFF
                    fa_unit<2, 64, 4, 1, 1, true>(lds, U, cx, WV);
#endif
                }
            }
            PROBE_MARK1(lds, 20);
            float mcm;
            { const int ln = lane_id(); float nq = 0.f, nk = 0.f;
#pragma unroll
              for (int j = 0; j < 4; ++j) { nq = fmaxf(nq, fabsf(CX_F(21)[ln + 64 * j])); nk = fmaxf(nk, fabsf(CX_F(22)[ln + 64 * j])); }
              nq = wave_max(nq); nk = wave_max(nk); mcm = uni(16.0f * nq * nk * LOG2E); }
            bf16_t* MQ = WSP(bf16_t, WS_MQ); const bf16_t* MK = WSP(bf16_t, WS_MK); const bf16_t* MV = WSP(bf16_t, WS_MV);
            for (int id = vcu; id < 256; id += G) {
                const int bh = id >> 3, qb = id & 7, b = bh >> 2, h = bh & 3;
                { FaUnit U; const size_t r0 = (size_t)b * SEQ + qb * 256;
                    U.Q = MQ + r0 * 1024 + h * 256; U.ldq = 1024; U.K = MK + (size_t)b * MEML * 1024 + h * 256; U.ldk = 1024; U.V = MV + (size_t)b * MEML * 1024 + h * 256; U.ldv = 1024;
                    U.O = MQ + r0 * 1024 + h * 256; U.ldo = 1024; U.nt = 4; U.vis0 = 4; U.c = 0.0625f * LOG2E; U.mc = mcm; U.lam = 0.f;
#ifndef NO_FAMEM
                    fa_unit<1, 256, 4, 2, 2, false, true>(lds, U, cx, WV);
#endif
                }
            }
        } break;
        case PH_ATT_R0: {
            unsigned* stc = WSP(unsigned, WS_CTL) + 12288;
            for (int sid = vcu; sid < 384; sid += G) {
                const int up = sid >> 7, x = sid & 127, hg = x >> 6, bh = (x >> 2) & 15, dvq = x & 3, b = bh >> 1, hl = bh & 1, h = 2 * hg + hl;
                const bf16_t* RK = hg ? (const bf16_t*)cx.out + (size_t)T * 512 : WSP(bf16_t, WS_RK); const bf16_t* RV = hg ? (const bf16_t*)cx.out + (size_t)T * 1024 : WSP(bf16_t, WS_RV);
                StJob J; J.K = RK + ((size_t)b * SEQ + 512 * up) * 512 + hl * 256; J.V = RV + ((size_t)b * SEQ + 512 * up) * 1024 + hl * 512 + dvq * 128;
                J.ST = WSP(bf16_t, WS_ST) + (size_t)hg * (6 * MiB) + ((size_t)(bh * 3 + up) * 512 + dvq * 128) * 256; J.nt = 8; J.lg = log2f(1.0f - exp2f(-5.0f - (float)h));
                J.PREV = up ? J.ST - (size_t)512 * 256 : J.K; J.gprev = up ? exp2f(J.lg * 512.0f) : 0.0f; J.waitc = up ? stc + ((hg * 16 + bh) * 3 + up - 1) * 16 : nullptr;
                st_job(lds, J, WV);
                if (WV == 0 && lane_id() == 0) __hip_atomic_fetch_add(stc + ((hg * 16 + bh) * 3 + up) * 16, 1u, __ATOMIC_RELAXED, __HIP_MEMORY_SCOPE_AGENT);
            }
            for (int jid = vcu; jid < 512; jid += G) {
                const int a = (jid >> 7) & 1, idx = ((jid >> 8) << 7) | (jid & 127), hg = idx >> 7, bh = (idx >> 3) & 15, r8 = idx & 7, v0 = r8 >> 1, dvh = r8 & 1;
                const int b = bh >> 1, hl = bh & 1, h = 2 * hg + hl;
                const bf16_t* RQ = hg ? (const bf16_t*)cx.out : WSP(bf16_t, WS_RQ); const bf16_t* RK = hg ? (const bf16_t*)cx.out + (size_t)T * 512 : WSP(bf16_t, WS_RK);
                const bf16_t* RV = hg ? (const bf16_t*)cx.out + (size_t)T * 1024 : WSP(bf16_t, WS_RV); bf16_t* RG = WSP(bf16_t, hg ? WS_RG1 : WS_RG0);
                const float lg = log2f(1.0f - exp2f(-5.0f - (float)h));
                int have = 0;
#pragma unroll 1
                for (int half = 0; half < 2; ++half) { const int sc = half ? 3 - a : a, v = half ? 3 - v0 : v0, u = 4 * sc + v;
                    if (sc > have) {
                        if (WV == 0) {
                            { unsigned sp = 0; unsigned* cp = stc + ((hg * 16 + bh) * 3 + sc - 1) * 16;
                                while ((unsigned)__builtin_amdgcn_readfirstlane(__hip_atomic_load(cp, __ATOMIC_RELAXED, __HIP_MEMORY_SCOPE_AGENT)) < 4u) { __builtin_amdgcn_s_sleep(2); if (++sp > (1u << 22)) break; } }
                            __builtin_amdgcn_fence(__ATOMIC_ACQUIRE, "agent");
                            asm volatile("s_waitcnt vmcnt(0)" ::: "memory"); }
                        asm volatile("s_waitcnt vmcnt(0) lgkmcnt(0)\n\ts_barrier" ::: "memory");
                        have = sc;
                    }
                    Ret3Unit U; const size_t r0 = (size_t)b * SEQ + u * 128, k0 = (size_t)b * SEQ + sc * 512;
                    U.Q = RQ + r0 * 512 + hl * 256; U.K = RK + k0 * 512 + hl * 256; U.V = RV + k0 * 1024 + hl * 512 + dvh * 256;
                    U.G = RG + r0 * 1024 + hl * 512 + dvh * 256; U.O = RG + r0 * 1024 + hl * 512 + dvh * 256; U.SS = WSP(float, WS_RSS) + r0 * 8 + h * 2 + dvh;
                    U.ST = WSP(bf16_t, WS_ST) + (size_t)hg * (6 * MiB) + ((size_t)(bh * 3 + (sc ? sc - 1 : 0)) * 512 + dvh * 256) * 256;
                    U.nst = sc ? 4 : 0; U.nt = 2 * (2 * v + 2); U.c0 = 2 * v; U.lg = lg;
                    fa_ret3_unit(lds, U, WV); }
            }
        } break;
        default: break;
        }
        PROBE_MARK(lds, ph, 6);
        if (multi && si + 1 < nseq) xcd_barrier(bar, WV == 0 && lane_id() == 0);
        PROBE_MARK(lds, ph, 5);
    }
#ifdef PROBE_PH
    if (multi) xcd_barrier(bar, WV == 0 && lane_id() == 0);
    if (bx == PROBE_BX && WV == 0 && lane_id() == 0) { const float us = (float)((volatile LAS unsigned*)(lds + MISC_OFF + 128))[1] * 0.01f - (float)PROBE_OFF; cx.out[0] = PROBE_Q * floorf(us / PROBE_Q + 0.5f); }
#endif
    if (false) { PHASE_IDS;
            const float* part3 = WSP(float, WS_PART) + (size_t)3 * T * 16;
            for (int m = gw; m < T; m += NGW) {
                const float ri = row_rinv(part3, m); f32x4* xr = (f32x4*)(cx.out + (size_t)m * D) + lane; const f32x4* wr_ = (const f32x4*)CX_F(29) + lane;
#pragma unroll
                for (int j = 0; j < 4; ++j) { const f32x4 v = xr[64 * j]; xr[64 * j] = v * ri * wr_[64 * j]; }
            }
    }
}

extern "C" void kernel_launch(void* const* d_in, const int* in_sizes, int n_in, void* d_out, int out_size, void* d_ws, size_t ws_size, hipStream_t stream) {
    static int grid = 0;
    if (grid == 0) {
        if (n_in != 30 || out_size != T * D || ws_size < WS_END) { fprintf(stderr, "kernel_launch: unexpected shapes (n_in %d out %d ws %zu)\n", n_in, out_size, ws_size); grid = -1; return; }
        int dev = 0, cus = 0, per_cu = 0;
        if (hipGetDevice(&dev) != hipSuccess || hipDeviceGetAttribute(&cus, hipDeviceAttributeMultiprocessorCount, dev) != hipSuccess) { grid = -1; return; }
        if (hipFuncSetAttribute((const void*)mk_fwd, hipFuncAttributeMaxDynamicSharedMemorySize, LDS_BYTES) != hipSuccess) { fprintf(stderr, "kernel_launch: hipFuncSetAttribute failed\n"); grid = -1; return; }
        if (hipOccupancyMaxActiveBlocksPerMultiprocessor(&per_cu, (const void*)mk_fwd, 512, LDS_BYTES) != hipSuccess || per_cu < 1) { fprintf(stderr, "kernel_launch: occupancy query says %d\n", per_cu); }
        (void)hipGetLastError();
        grid = cus;
    }
    if (grid < 0) return;
    (void)hipMemsetAsync((char*)d_ws + WS_CTL, 0, CTL_ZERO_BYTES, stream);
    Args a{};
    for (int i = 0; i < 30; ++i) a.in.p[i] = (const float*)d_in[i];
    a.out = (float*)d_out; a.ws = (unsigned char*)d_ws;
#if MK_N_LAUNCHES == 1
    a.ph_lo = 0; a.ph_hi = PH_COUNT;
    hipLaunchKernelGGL(mk_fwd, dim3(grid), dim3(512), LDS_BYTES, stream, a);
#else
    for (int ph = 0; ph < PH_COUNT; ++ph) { a.ph_lo = ph; a.ph_hi = ph + 1; hipLaunchKernelGGL(mk_fwd, dim3(grid), dim3(512), LDS_BYTES, stream, a); }
#endif
}
```

```cpp
#include <hip/hip_runtime.h>
#include <cstdio>
#include <cstdint>

#ifndef MK_N_LAUNCHES
#define MK_N_LAUNCHES 1
#endif

#define LAS __attribute__((address_space(3)))
#define GAS __attribute__((address_space(1)))
typedef unsigned short bf16_t;
typedef short bf16x8 __attribute__((ext_vector_type(8)));
typedef short s16x4 __attribute__((ext_vector_type(4)));
typedef float f32x4 __attribute__((ext_vector_type(4)));
typedef float f32x2 __attribute__((ext_vector_type(2)));
typedef unsigned u32x4 __attribute__((ext_vector_type(4)));
typedef unsigned u32x2 __attribute__((ext_vector_type(2)));

constexpr int D = 1024, NB = 8, SEQ = 2048, T = NB * SEQ, DFF = 2816, MEML = 256, TM = NB * MEML;
constexpr int DIN = 13312;
constexpr float EPS = 1e-6f;
constexpr float LOG2E = 1.4426950408889634f;

constexpr size_t MiB = 1u << 20;
constexpr size_t HALFMiB = 1u << 19;
constexpr size_t WS_WIN = 0;
constexpr size_t WS_W2GU = 26 * MiB;
constexpr size_t WS_W2D = 37 * MiB;
constexpr size_t WS_WDO = 42 * MiB + HALFMiB;
constexpr size_t WS_WMO = 44 * MiB + HALFMiB;
constexpr size_t WS_WOUT = 46 * MiB + HALFMiB;
constexpr size_t WS_WRO = 48 * MiB + HALFMiB;
constexpr size_t WS_WMKV = 52 * MiB + HALFMiB;
constexpr size_t WS_XB = 56 * MiB + HALFMiB;
constexpr size_t WS_W1GU = 88 * MiB + HALFMiB;
constexpr size_t WS_W1D = 99 * MiB + HALFMiB;
constexpr size_t WS_ACT = 105 * MiB;
constexpr size_t WS_MEMN = 236 * MiB;
constexpr size_t WS_MK = 240 * MiB;
constexpr size_t WS_MV = 244 * MiB;
constexpr size_t WS_DQ = 88 * MiB + HALFMiB;
constexpr size_t WS_DK = 120 * MiB + HALFMiB;
constexpr size_t WS_DV = 152 * MiB + HALFMiB;
constexpr size_t WS_MQ = 184 * MiB + HALFMiB;
constexpr size_t WS_SG = WS_DK;
constexpr size_t WS_M = WS_DV;
constexpr size_t WS_RQ = 88 * MiB + HALFMiB;
constexpr size_t WS_RK = 104 * MiB + HALFMiB;
constexpr size_t WS_RV = 120 * MiB + HALFMiB;
constexpr size_t WS_RG0 = 184 * MiB + HALFMiB;
constexpr size_t WS_RG1 = 216 * MiB + HALFMiB;
constexpr size_t WS_SG2 = 88 * MiB + HALFMiB;
constexpr size_t WS_ST = 0;
constexpr size_t WS_SGB = 216 * MiB + HALFMiB;
constexpr size_t WS_PART = 250 * MiB;
constexpr size_t WS_DROPE = 254 * MiB;
constexpr size_t WS_CTL = 255 * MiB;
constexpr size_t CTL_ZERO_BYTES = 64 * 1024;
constexpr size_t WS_RINV = 255 * MiB + 768 * 1024;
constexpr size_t WS_RSS = 255 * MiB + 128 * 1024;
constexpr size_t WS_END = 256 * MiB;

constexpr int RING_BYTES = 131072;
constexpr int ATT_BYTES = 157696;
#ifdef PROBE_PH
#ifndef PROBE_K
#define PROBE_K 0
#endif
#ifndef PROBE_BX
#define PROBE_BX 0
#endif
#ifndef PROBE_Q
#define PROBE_Q 2.0f
#endif
#ifndef PROBE_OFF
#define PROBE_OFF 0
#endif
#define PROBE_T0(lds_, ph_) do { if ((ph_) == PROBE_PH && WV == 0) { const unsigned t_ = (unsigned)__builtin_amdgcn_s_memrealtime(); if (lane_id() == 0) *(volatile LAS unsigned*)((lds_) + MISC_OFF + 128) = t_; } } while (0)
#define PROBE_MARK(lds_, ph_, k_) do { if ((ph_) == PROBE_PH && (k_) == PROBE_K && WV == 0) { const unsigned t_ = (unsigned)__builtin_amdgcn_s_memrealtime(); if (lane_id() == 0) { volatile LAS unsigned* m_ = (volatile LAS unsigned*)((lds_) + MISC_OFF + 128); m_[1] = t_ - m_[0]; } } } while (0)
#define PROBE_MARK1(lds_, k_) do { if ((k_) == PROBE_K && WV == 0) { const unsigned t_ = (unsigned)__builtin_amdgcn_s_memrealtime(); if (lane_id() == 0) { volatile LAS unsigned* m_ = (volatile LAS unsigned*)((lds_) + MISC_OFF + 128); if (m_[0] != 0u && m_[1] == 0u) m_[1] = t_ - m_[0]; } } } while (0)
#else
#define PROBE_MARK1(lds_, k_) do { } while (0)
#define PROBE_T0(lds_, ph_) do { } while (0)
#define PROBE_MARK(lds_, ph_, k_) do { } while (0)
#endif
constexpr int EPI_OFF = 131072;
constexpr int MISC_OFF = ATT_BYTES;
constexpr int LDS_BYTES = ATT_BYTES + 512;

#define RLX_AGENT __ATOMIC_RELAXED, __HIP_MEMORY_SCOPE_AGENT
typedef __bf16 bf16x2_t __attribute__((ext_vector_type(2)));
__device__ __forceinline__ unsigned cvt_pk_bf16(float lo, float hi) { f32x2 v = {lo, hi}; bf16x2_t b = __builtin_convertvector(v, bf16x2_t); return __builtin_bit_cast(unsigned, b); }
__device__ __forceinline__ float bf2f(unsigned short b) { return __uint_as_float((unsigned)b << 16); }
__device__ __forceinline__ float bflo(unsigned w) { return __uint_as_float(w << 16); }
__device__ __forceinline__ float bfhi(unsigned w) { return __uint_as_float(w & 0xffff0000u); }
__device__ __forceinline__ unsigned short f2bf(float f) { return (unsigned short)(cvt_pk_bf16(f, 0.f) & 0xffffu); }
__device__ __forceinline__ int lane_id() { int r; asm volatile("v_mbcnt_lo_u32_b32 %0, -1, 0\n\tv_mbcnt_hi_u32_b32 %0, -1, %0" : "=v"(r)); return r; }
#define TID_OF(wv) ((wv) * 64 + lane_id())

template <int K> __device__ __forceinline__ float xor_f(float v) {
    if (K == 32) { auto r = __builtin_amdgcn_permlane32_swap(__float_as_uint(v), __float_as_uint(v), false, false); return (lane_id() & 32) ? __uint_as_float(r[0]) : __uint_as_float(r[1]); }
    return __int_as_float(__builtin_amdgcn_ds_swizzle(__float_as_int(v), 0x1F | (K << 10)));
}
__device__ __forceinline__ float sum_xor32(float v) { auto r = __builtin_amdgcn_permlane32_swap(__float_as_uint(v), __float_as_uint(v), false, false); return __uint_as_float(r[0]) + __uint_as_float(r[1]); }
template <int CTRL> __device__ __forceinline__ float dppf(float v) { return __int_as_float(__builtin_amdgcn_update_dpp(0, __float_as_int(v), CTRL, 0xF, 0xF, true)); }
__device__ __forceinline__ float row32_sum(float v) {
    v += dppf<0xB1>(v); v += dppf<0x4E>(v); v += dppf<0x141>(v); v += dppf<0x140>(v);
    auto r = __builtin_amdgcn_permlane16_swap(__float_as_uint(v), __float_as_uint(v), false, false);
    return __uint_as_float(r[0]) + __uint_as_float(r[1]);
}
__device__ __forceinline__ float wave_sum(float v) {
    v += xor_f<1>(v); v += xor_f<2>(v); v += xor_f<4>(v); v += xor_f<8>(v); v += xor_f<16>(v);
    return sum_xor32(v);
}
__device__ __forceinline__ float wave_max(float v) {
    v = fmaxf(v, xor_f<1>(v)); v = fmaxf(v, xor_f<2>(v)); v = fmaxf(v, xor_f<4>(v)); v = fmaxf(v, xor_f<8>(v)); v = fmaxf(v, xor_f<16>(v));
    auto r = __builtin_amdgcn_permlane32_swap(__float_as_uint(v), __float_as_uint(v), false, false); return fmaxf(__uint_as_float(r[0]), __uint_as_float(r[1]));
}
__device__ __forceinline__ float uni(float v) { return __uint_as_float(__builtin_amdgcn_readfirstlane(__float_as_uint(v))); }

#define XB_TMO      128
#define XB_XCNT(j)  (256  + 64 * (j))
#define XB_XSUB(j)  (1280 + 64 * (j))
#define XB_XGEN(j)  (2304 + 64 * (j))
#define XB_TOP      3328
#define XB_TOPGEN   3392
#define XCD_BAR_WORDS 3456
#define XB_SPIN_CAP (1u << 22)
__device__ __forceinline__ unsigned xb_ld(unsigned* p)              { return __hip_atomic_load(p, __ATOMIC_RELAXED, __HIP_MEMORY_SCOPE_AGENT); }
__device__ __forceinline__ unsigned xb_add(unsigned* p, unsigned v) { return __hip_atomic_fetch_add(p, v, __ATOMIC_RELAXED, __HIP_MEMORY_SCOPE_AGENT); }
__device__ __forceinline__ unsigned xb_xcc_id() { return (unsigned)__builtin_amdgcn_s_getreg((3 << 11) | 20) & 0xFu; }
#define XB_SPIN(cond, bar) do { unsigned _sp = 0; while (cond) { __builtin_amdgcn_s_sleep(1); \
    if ((++_sp & 255u) == 0u) { if (xb_ld(&(bar)[XB_TMO])) break; if (_sp > XB_SPIN_CAP) { atomicAdd(&(bar)[XB_TMO], 1u); break; } } } } while (0)
struct XcdBarrier { unsigned* bar; unsigned x; volatile LAS unsigned* st; };
__device__ __forceinline__ XcdBarrier xcd_barrier_post(unsigned* bar, volatile LAS unsigned* st, bool t0) {
    XcdBarrier b; b.bar = bar; b.x = xb_xcc_id(); b.st = st;
    if (t0) (void)xb_add(&bar[XB_XCNT(b.x)], 1u);
    return b;
}
__device__ __forceinline__ void xcd_barrier_complete(unsigned* bar, unsigned x, unsigned& nloc, unsigned& nx) {
    const unsigned G = gridDim.x * gridDim.y * gridDim.z;
    unsigned sum, cnt, mine, sp = 0u;
    for (;;) {
        sum = 0u; cnt = 0u; mine = 0u;
#pragma unroll
        for (unsigned j = 0; j < 16; ++j) { const unsigned c = xb_ld(&bar[XB_XCNT(j)]); sum += c; cnt += (c > 0u) ? 1u : 0u; mine = (j == x) ? c : mine; }
        if (sum == G) break;
        __builtin_amdgcn_s_sleep(1);
        if ((++sp & 255u) == 0u) { if (xb_ld(&bar[XB_TMO])) break; if (sp > XB_SPIN_CAP) { atomicAdd(&bar[XB_TMO], 1u); break; } }
    }
    nloc = mine > 0u ? mine : 1u; nx = cnt > 0u ? cnt : 1u;
}
__device__ __forceinline__ void xcd_barrier(const XcdBarrier& b, bool t0) {
    asm volatile("s_waitcnt vmcnt(0)" ::: "memory");
    __syncthreads();
    if (t0) {
        unsigned* bar = b.bar;
        __builtin_amdgcn_s_waitcnt(0);
        unsigned nloc = b.st[0], nx = b.st[1];
        if (nloc == 0u) { xcd_barrier_complete(bar, b.x, nloc, nx); b.st[0] = nloc; b.st[1] = nx; }
        const unsigned old = xb_add(&bar[XB_XSUB(b.x)], 1u);
        const unsigned gen = old / nloc;
        if (old + 1u == (gen + 1u) * nloc) {
            __builtin_amdgcn_fence(__ATOMIC_RELEASE, "agent");
            asm volatile("s_waitcnt vmcnt(0)" ::: "memory");
            const unsigned og = xb_add(&bar[XB_TOP], 1u);
            const unsigned tg = og / nx;
            if (og + 1u == (tg + 1u) * nx) xb_add(&bar[XB_TOPGEN], 1u);
            else XB_SPIN(xb_ld(&bar[XB_TOPGEN]) == tg, bar);
            __builtin_amdgcn_fence(__ATOMIC_ACQUIRE, "agent");
            xb_add(&bar[XB_XGEN(b.x)], 1u);
            asm volatile("s_waitcnt vmcnt(0)" ::: "memory");
        } else {
            XB_SPIN(xb_ld(&bar[XB_XGEN(b.x)]) == gen, bar);
            __builtin_amdgcn_fence(__ATOMIC_ACQUIRE, "agent");
            asm volatile("s_waitcnt vmcnt(0)" ::: "memory");
        }
    }
    __syncthreads();
}

struct InTab { const float* p[30]; };
struct CtxIn {
    const __attribute__((address_space(4))) InTab* tab;
    __device__ __forceinline__ const float* operator[](int i) const { typedef const float* cfp; return *(volatile const __attribute__((address_space(4))) cfp*)&tab->p[i]; }
};
struct Ctx {
    CtxIn in;
    float* out;
    unsigned char* ws;
};
#define CX_F(i) (cx.in[i])
#define WSP(T_, off) ((T_*)(cx.ws + (off)))

namespace pg8 {
constexpr int BM = 256, BK = 64, HALF = 128, HTB = HALF * BK * 2, STAGE_BYTES = 8 * HTB, NXCD = 8, WGM = 4;
__device__ __forceinline__ int lds_byte(int r, int c) { const int st = (r >> 4) * 2 + (c >> 5), rr = r & 15, cc = c & 31, ob = rr * 64 + cc * 2; return st * 1024 + (ob ^ (((ob >> 9) & 1) << 5)); }
__device__ __forceinline__ void stage_rc(int b, int& R, int& C) { const int st = b / 1024, sb = b % 1024, swz = sb ^ (((sb >> 9) & 1) << 5); R = (st >> 1) * 16 + swz / 64; C = (st & 1) * 32 + (swz % 64) / 2; }
__device__ __forceinline__ int perm32(int rho) { const int n = rho >> 4, i = rho & 15; return 8 * (i >> 2) + 4 * n + (i & 3); }
__device__ __forceinline__ void tile_of(int L, int nM, int nN, int& pm, int& pn) {
    const int nwg = nM * nN; int wgid = L;
    { const int q = nwg / NXCD, r = nwg % NXCD, xcd = wgid % NXCD, off = wgid / NXCD; wgid = (xcd < r ? xcd * (q + 1) : r * (q + 1) + (xcd - r) * q) + off; }
    const int nig = WGM * nN, gid = wgid / nig, fm = gid * WGM, gsz = (nM - fm) < WGM ? (nM - fm) : WGM;
    pm = fm + ((wgid % nig) % gsz); pn = (wgid % nig) / gsz;
}
}

enum { EP_GU = 0, EP_MK, EP_MV, EP_RES, EP_DQK, EP_PLAIN, EP_MQ, EP_ROT, EP_SG, EP_PM, EP_RSC };
struct Unit { const bf16_t* A; const bf16_t* Bt; int K, lda; int pm, pn; int epi, aux, po; int kjt; long kjump; int rs; };

enum { PH_PRO = 0, PH_F1GU, PH_F1D, PH_IN_DM, PH_ATT_DM, PH_MG1, PH_IN_R0, PH_ST0, PH_ATT_R0, PH_IN_R1, PH_ST1, PH_ATT_R1,
       PH_MG2, PH_WOUT, PH_F2GU, PH_F2D, PH_FIN, PH_COUNT };

struct GemmSched {
    int ph, c, G;
    const Ctx* cxp;
    __device__ __forceinline__ bool next(int i, Unit& u) const { u.lda = 0; const bool ok = next_(i, u); if (u.lda == 0) u.lda = u.K; return ok; }
    __device__ __forceinline__ bool next_(int i, Unit& u) const {
        const Ctx& cx = *cxp;
        const int L = i * G + c;
        u.kjt = 1 << 30; u.kjump = 0; u.rs = 0;
        switch (ph) {
        case PH_F1GU: case PH_F2GU: {
            const int f2 = (ph == PH_F2GU);
            if (L < 64 * 22) { pg8::tile_of(L, 64, 22, u.pm, u.pn); u.A = WSP(bf16_t, WS_XB); u.Bt = WSP(bf16_t, f2 ? WS_W2GU : WS_W1GU); u.K = 1024; u.epi = EP_GU; u.aux = f2; u.po = u.pn; return true; }
            if (f2) return false;
            const int j = L - 64 * 22; if (j >= 64) return false;
            pg8::tile_of(j, 8, 8, u.pm, u.pn); u.A = WSP(bf16_t, WS_MEMN); u.Bt = WSP(bf16_t, WS_WMKV); u.K = 1024;
            if (u.pn < 4) { u.epi = EP_MK; u.po = u.pn; } else { u.epi = EP_MV; u.po = u.pn - 4; }
            u.aux = 0; return true; }
        case PH_F1D: case PH_F2D: {
            if (L >= 256) return false; pg8::tile_of(L, 64, 4, u.pm, u.pn);
            u.A = WSP(bf16_t, WS_ACT); u.Bt = WSP(bf16_t, ph == PH_F1D ? WS_W1D : WS_W2D); u.K = DFF; u.epi = EP_RES; u.aux = (ph == PH_F1D) ? 0 : 2; u.po = u.pn; return true; }
        case PH_IN_DM: {
            if (L >= 64 * 16) return false; pg8::tile_of(L, 64, 16, u.pm, u.pn);
            u.A = WSP(bf16_t, WS_XB); u.Bt = WSP(bf16_t, WS_WIN); u.K = 1024;
            const int s = u.pn >> 2; u.po = u.pn & 3;
            if (s == 0) { u.epi = EP_DQK; u.aux = 0; } else if (s == 1) { u.epi = EP_DQK; u.aux = 1; } else if (s == 2) { u.epi = EP_PLAIN; u.aux = 0; } else { u.epi = EP_MQ; u.aux = 0; }
            return true; }
        case PH_MG1: {
            const int kind = i & 3, tl = c + G * (i >> 2); if (tl >= 256) return false; pg8::tile_of(tl, 64, 4, u.pm, u.pn); u.K = 1024; u.po = u.pn;
            if (kind == 0) { u.A = WSP(bf16_t, WS_XB); u.Bt = WSP(bf16_t, WS_WIN); u.pn += 16; u.epi = EP_SG; u.aux = 1; }
            else if (kind == 1) { u.A = WSP(bf16_t, WS_DQ); u.Bt = WSP(bf16_t, WS_WDO); u.epi = EP_PM; u.aux = 0; }
            else if (kind == 2) { u.A = WSP(bf16_t, WS_XB); u.Bt = WSP(bf16_t, WS_WIN); u.pn += 20; u.epi = EP_SG; u.aux = 2; }
            else { u.A = WSP(bf16_t, WS_MQ); u.Bt = WSP(bf16_t, WS_WMO); u.epi = EP_PM; u.aux = 1 | 4; }
            return true; }
        case PH_MG2: {
            const int kind = i % 5, tl = c + G * (i / 5); if (tl >= 256) return false; pg8::tile_of(tl, 64, 4, u.pm, u.pn); u.po = u.pn;
            if (kind == 0) { u.A = WSP(bf16_t, WS_XB); u.Bt = WSP(bf16_t, WS_WIN); u.K = 1024; u.pn += 48; u.epi = EP_SG; u.aux = 0; }
            else { const int h = kind - 1; u.A = WSP(bf16_t, (h < 2) ? WS_RG0 : WS_RG1) + (h & 1) * 512; u.lda = 1024; u.Bt = WSP(bf16_t, WS_WRO) + (size_t)h * 1024 * 512; u.K = 512;
                   if (h < 3) { u.epi = EP_RSC; u.aux = h + 1; } else { u.epi = EP_PM; u.aux = 1 | 2; u.rs = 1; } }
            return true; }
        case PH_IN_R0: {
            if (L >= 64 * 24) return false; pg8::tile_of(L, 64, 24, u.pm, u.pn);
            const int hg = u.pn / 12; const int t = u.pn - 12 * hg;
            u.A = WSP(bf16_t, WS_XB); u.Bt = WSP(bf16_t, WS_WIN); u.K = 1024; u.pn = 24 + 12 * hg + t;
            if (t < 2) { u.epi = EP_ROT; u.aux = 0 | (hg << 3); u.po = t; } else if (t < 4) { u.epi = EP_ROT; u.aux = 1 | (hg << 3); u.po = t - 2; }
            else if (t < 8) { u.epi = EP_PLAIN; u.aux = 1 | (hg << 3); u.po = t - 4; } else { u.epi = EP_PLAIN; u.aux = 2 + hg; u.po = t - 8; }
            return true; }
        case PH_WOUT: {
            if (L >= 256) return false; pg8::tile_of(L, 64, 4, u.pm, u.pn);
            u.A = WSP(bf16_t, WS_M); u.Bt = WSP(bf16_t, WS_WOUT); u.K = 1024; u.epi = EP_RES; u.aux = 1; u.po = u.pn; return true; }
        default: return false;
        }
    }
};

__device__ __forceinline__ float row_rinv(const float* part, int row) {
    const f32x4* p = (const f32x4*)(part + (size_t)row * 16);
    const f32x4 a = p[0], b = p[1], c = p[2], d = p[3];
    const float s = ((a[0] + a[1]) + (a[2] + a[3])) + ((b[0] + b[1]) + (b[2] + b[3])) + ((c[0] + c[1]) + (c[2] + c[3])) + ((d[0] + d[1]) + (d[2] + d[3]));
    return __builtin_amdgcn_rsqf(s * (1.0f / 1024.0f) + EPS);
}
__device__ __forceinline__ float fsigmoid(float v) { return __builtin_amdgcn_rcpf(1.0f + __builtin_amdgcn_exp2f(v * (-LOG2E))); }
__device__ __forceinline__ f32x4 exp2_4(f32x4 v) { return (f32x4){__builtin_amdgcn_exp2f(v[0]), __builtin_amdgcn_exp2f(v[1]), __builtin_amdgcn_exp2f(v[2]), __builtin_amdgcn_exp2f(v[3])}; }
__device__ __forceinline__ f32x4 rcp_4(f32x4 v) { return (f32x4){__builtin_amdgcn_rcpf(v[0]), __builtin_amdgcn_rcpf(v[1]), __builtin_amdgcn_rcpf(v[2]), __builtin_amdgcn_rcpf(v[3])}; }
__device__ __forceinline__ float ret_rms2(const float* ss, int row, int h);
__device__ __forceinline__ void rescale_rows(const Ctx& cx, f32x4 (&acc)[2][2][4][2], int rowb, int hn);

__device__ __forceinline__ void epilogue(const Ctx& cx, const Unit& u, f32x4 (&acc)[2][2][4][2], int wr, int wc, int fr, int fq, LAS unsigned char* lds) {
    const int rowb = u.pm * 256 + wr * 64 + fr;
    const int colw = wc * 32 + 8 * fq;
    float* PART = WSP(float, WS_PART);
#ifdef EPI_ONLY
    if (u.epi != EPI_ONLY) return;
#endif
    LAS float* rl = (LAS float*)(lds + EPI_OFF + 8192);
    LAS float* pl = (LAS float*)(lds + EPI_OFF + 9216);
    LAS unsigned char* ropl = lds + EPI_OFF + 10240;
    {
        const float* rp = nullptr;
        if (u.epi == EP_GU) rp = PART + (size_t)(u.aux ? 2 : 0) * T * 16;
        else if (u.epi == EP_PLAIN || u.epi == EP_DQK || u.epi == EP_MQ || u.epi == EP_ROT || u.epi == EP_SG) rp = PART + (size_t)1 * T * 16;
        if (rp) {
            const int lt = (wr * 4 + wc) * 64 + fq * 16 + fr, r = lt >> 1, hf = lt & 1;
            const f32x4* p = (const f32x4*)(rp + (size_t)(u.pm * 256 + r) * 16 + hf * 8);
            const f32x4 a = p[0], b = p[1];
            f32x4 c0 = (f32x4){0.f, 0.f, 0.f, 0.f}, c1 = c0; float pf = 0.f;
            if (u.epi == EP_DQK) { const f32x4* q = (const f32x4*)(WSP(float, WS_DROPE) + (size_t)(u.pm * 256 + r) * 16 + hf * 8); c0 = q[0]; c1 = q[1]; }
            if (u.epi == EP_ROT) pf = (float)((const int*)cx.in[2])[u.pm * 256 + (lt & 255)];
            float s = ((a[0] + a[1]) + (a[2] + a[3])) + ((b[0] + b[1]) + (b[2] + b[3]));
            s += dppf<0xB1>(s);
            if (hf == 0) rl[r] = __builtin_amdgcn_rsqf(s * (1.0f / 1024.0f) + EPS);
            if (u.epi == EP_DQK) { *(LAS f32x4*)(ropl + r * 64 + hf * 32) = c0; *(LAS f32x4*)(ropl + r * 64 + hf * 32 + 16) = c1; }
            if (u.epi == EP_ROT && lt < 256) pl[lt] = pf;
            asm volatile("s_waitcnt vmcnt(0) lgkmcnt(0)" ::: "memory"); __builtin_amdgcn_s_barrier(); asm volatile("" ::: "memory");
        }
    }
    const int lrb = wr * 64 + fr;
    switch (u.epi) {
    case EP_GU: {
        bf16_t* O = WSP(bf16_t, WS_ACT);
#pragma unroll
        for (int ai = 0; ai < 2; ++ai)
#pragma unroll
            for (int m = 0; m < 4; ++m) {
                const int row = rowb + ai * 128 + m * 16; const float ri = rl[lrb + ai * 128 + m * 16];
                const float k1 = -ri * LOG2E, ri2 = ri * ri; f32x4 ov[2];
#pragma unroll
                for (int n = 0; n < 2; ++n) { const f32x4 gq = acc[ai][0][m][n], uq = acc[ai][1][m][n];
                    const f32x4 den = exp2_4(gq * k1) + 1.0f; ov[n] = (gq * uq) * (rcp_4(den) * ri2); }
                u32x4 w; w.x = cvt_pk_bf16(ov[0][0], ov[0][1]); w.y = cvt_pk_bf16(ov[0][2], ov[0][3]); w.z = cvt_pk_bf16(ov[1][0], ov[1][1]); w.w = cvt_pk_bf16(ov[1][2], ov[1][3]);
                *(u32x4*)(O + (size_t)row * DFF + u.po * 128 + colw) = w;
            }
    } break;
    case EP_MV: case EP_PLAIN: {
        bf16_t* O; int ld; const bool part = (u.epi != EP_MV);
        if (u.epi == EP_MV) { O = WSP(bf16_t, WS_MV); ld = 1024; }
        else { ld = 1024; O = (u.aux == 9) ? (bf16_t*)cx.out + (size_t)T * 1024 : WSP(bf16_t, u.aux == 0 ? WS_DV : u.aux == 1 ? WS_RV : u.aux == 2 ? WS_RG0 : WS_RG1); }
#pragma unroll
        for (int ai = 0; ai < 2; ++ai)
#pragma unroll
            for (int m = 0; m < 4; ++m) {
                const int row = rowb + ai * 128 + m * 16; const float ri = part ? rl[lrb + ai * 128 + m * 16] : 1.0f;
#pragma unroll
                for (int bj = 0; bj < 2; ++bj) { const f32x4 v0 = acc[ai][bj][m][0] * ri, v1 = acc[ai][bj][m][1] * ri;
                    u32x4 w; w.x = cvt_pk_bf16(v0[0], v0[1]); w.y = cvt_pk_bf16(v0[2], v0[3]); w.z = cvt_pk_bf16(v1[0], v1[1]); w.w = cvt_pk_bf16(v1[2], v1[3]);
                    *(u32x4*)(O + (size_t)row * ld + u.po * 256 + bj * 128 + colw) = w; }
            }
    } break;
    case EP_RES: if (u.aux == 2) {
        float* part = PART + (size_t)3 * T * 16; unsigned* cnt = WSP(unsigned, WS_CTL) + 8192 + 64 * u.pm; const float* wn = cx.in[29]; const bf16_t* XB = WSP(bf16_t, WS_XB);
        LAS unsigned* flag = (LAS unsigned*)(lds + EPI_OFF);
#pragma unroll
        for (int ai = 0; ai < 2; ++ai) {
            u32x4 xv[4][2];
#pragma unroll
            for (int m = 0; m < 4; ++m)
#pragma unroll
                for (int bj = 0; bj < 2; ++bj) xv[m][bj] = *(const u32x4*)(XB + (size_t)(rowb + ai * 128 + m * 16) * D + u.po * 256 + bj * 128 + colw);
#pragma unroll
            for (int m = 0; m < 4; ++m) {
                const int row = rowb + ai * 128 + m * 16; float ss = 0.f;
#pragma unroll
                for (int bj = 0; bj < 2; ++bj) { const u32x4 xq = xv[m][bj];
                    const f32x4 x0 = (f32x4){bflo(xq.x), bfhi(xq.x), bflo(xq.y), bfhi(xq.y)}, x1 = (f32x4){bflo(xq.z), bfhi(xq.z), bflo(xq.w), bfhi(xq.w)};
                    const f32x4 y0 = x0 + acc[ai][bj][m][0] * 0.5f, y1 = x1 + acc[ai][bj][m][1] * 0.5f;
                    ss += (y0[0] * y0[0] + y0[1] * y0[1]) + (y0[2] * y0[2] + y0[3] * y0[3]) + (y1[0] * y1[0] + y1[1] * y1[1]) + (y1[2] * y1[2] + y1[3] * y1[3]); }
                ss += xor_f<16>(ss); ss = sum_xor32(ss);
                if (fq == 0) __hip_atomic_store(part + (size_t)row * 16 + u.po * 4 + wc, ss, __ATOMIC_RELAXED, __HIP_MEMORY_SCOPE_AGENT);
            }
        }
        asm volatile("s_waitcnt vmcnt(0)" ::: "memory");
        if (fr == 0 && fq == 0) __hip_atomic_fetch_add(cnt, 1u, __ATOMIC_RELAXED, __HIP_MEMORY_SCOPE_AGENT);
        if (wr == 0 && wc == 0) {
            unsigned sp = 0;
            while ((unsigned)__builtin_amdgcn_readfirstlane(__hip_atomic_load(cnt, __ATOMIC_RELAXED, __HIP_MEMORY_SCOPE_AGENT)) < 32u) { __builtin_amdgcn_s_sleep(2); if (++sp > (1u << 22)) break; }
            __builtin_amdgcn_fence(__ATOMIC_ACQUIRE, "agent");
            asm volatile("s_waitcnt vmcnt(0)" ::: "memory");
            if (fr == 0 && fq == 0) flag[0] = 1u;
        }
        asm volatile("s_waitcnt vmcnt(0) lgkmcnt(0)" ::: "memory"); __builtin_amdgcn_s_barrier(); asm volatile("" ::: "memory");
        int rowb2 = rowb, colw2 = colw; asm volatile("" : "+v"(rowb2), "+v"(colw2));
#pragma unroll
        for (int q4 = 0; q4 < 4; ++q4) {
            const int ai = q4 >> 1, m0 = (q4 & 1) * 2;
            u32x4 xv[2][2]; float ri[2];
#pragma unroll
            for (int mm = 0; mm < 2; ++mm) { const int row = rowb2 + ai * 128 + (m0 + mm) * 16; ri[mm] = row_rinv(part, row);
#pragma unroll
                for (int bj = 0; bj < 2; ++bj) xv[mm][bj] = *(const u32x4*)(XB + (size_t)row * D + u.po * 256 + bj * 128 + colw2); }
            __builtin_amdgcn_sched_barrier(0);
#pragma unroll
            for (int mm = 0; mm < 2; ++mm) { const int row = rowb2 + ai * 128 + (m0 + mm) * 16;
#pragma unroll
                for (int bj = 0; bj < 2; ++bj) { const size_t off = (size_t)row * D + u.po * 256 + bj * 128 + colw2; const u32x4 xq = xv[mm][bj];
                    const f32x4 x0 = (f32x4){bflo(xq.x), bfhi(xq.x), bflo(xq.y), bfhi(xq.y)}, x1 = (f32x4){bflo(xq.z), bfhi(xq.z), bflo(xq.w), bfhi(xq.w)};
                    const f32x4 w0 = *(const f32x4*)(wn + u.po * 256 + bj * 128 + colw2), w1 = *(const f32x4*)(wn + u.po * 256 + bj * 128 + colw2 + 4);
                    __builtin_nontemporal_store((x0 + acc[ai][bj][m0 + mm][0] * 0.5f) * ri[mm] * w0, (f32x4*)(cx.out + off)); __builtin_nontemporal_store((x1 + acc[ai][bj][m0 + mm][1] * 0.5f) * ri[mm] * w1, (f32x4*)(cx.out + off + 4)); } }
            __builtin_amdgcn_sched_barrier(0);
        }
    } else {
        float* part = PART + (size_t)(u.aux + 1) * T * 16; bf16_t* XB = WSP(bf16_t, WS_XB);
#pragma unroll
        for (int ai = 0; ai < 2; ++ai) {
            f32x4 xv[4][2][2];
            {
                u32x4 xb[4][2];
#pragma unroll
                for (int m = 0; m < 4; ++m)
#pragma unroll
                    for (int bj = 0; bj < 2; ++bj) xb[m][bj] = *(const u32x4*)(XB + (size_t)(rowb + ai * 128 + m * 16) * D + u.po * 256 + bj * 128 + colw);
#pragma unroll
                for (int m = 0; m < 4; ++m)
#pragma unroll
                    for (int bj = 0; bj < 2; ++bj) { const u32x4 xq = xb[m][bj];
                        xv[m][bj][0] = (f32x4){bflo(xq.x), bfhi(xq.x), bflo(xq.y), bfhi(xq.y)}; xv[m][bj][1] = (f32x4){bflo(xq.z), bfhi(xq.z), bflo(xq.w), bfhi(xq.w)}; }
            }
            __builtin_amdgcn_sched_barrier(0);
            const float sc = (u.aux == 1) ? 1.0f : 0.5f;
#pragma unroll
            for (int m = 0; m < 4; ++m) {
                const int row = rowb + ai * 128 + m * 16; float ss = 0.f;
#pragma unroll
                for (int bj = 0; bj < 2; ++bj) { const size_t off = (size_t)row * D + u.po * 256 + bj * 128 + colw;
                    const f32x4 y0 = xv[m][bj][0] + acc[ai][bj][m][0] * sc, y1 = xv[m][bj][1] + acc[ai][bj][m][1] * sc;
                    ss += (y0[0] * y0[0] + y0[1] * y0[1]) + (y0[2] * y0[2] + y0[3] * y0[3]) + (y1[0] * y1[0] + y1[1] * y1[1]) + (y1[2] * y1[2] + y1[3] * y1[3]);
                    u32x4 w; w.x = cvt_pk_bf16(y0[0], y0[1]); w.y = cvt_pk_bf16(y0[2], y0[3]); w.z = cvt_pk_bf16(y1[0], y1[1]); w.w = cvt_pk_bf16(y1[2], y1[3]);
                    *(u32x4*)(XB + off) = w; }
                ss += xor_f<16>(ss); ss = sum_xor32(ss);
                if (fq == 0) part[(size_t)row * 16 + u.po * 4 + wc] = ss;
            }
            __builtin_amdgcn_sched_barrier(0);
        }
    } break;
    case EP_DQK: {
        const float* wn = cx.in[u.aux ? 12 : 11];
        bf16_t* O = WSP(bf16_t, u.aux ? WS_DK : WS_DQ);
        f32x4 wv[2][2];
#pragma unroll
        for (int bj = 0; bj < 2; ++bj)
#pragma unroll
            for (int n = 0; n < 2; ++n) wv[bj][n] = *(const f32x4*)(wn + 16 * fq + 8 * bj + 4 * n);
#pragma unroll
        for (int ai = 0; ai < 2; ++ai)
#pragma unroll
            for (int m = 0; m < 4; ++m) {
                const int row = rowb + ai * 128 + m * 16; const float ri = rl[lrb + ai * 128 + m * 16];
                f32x4 v[2][2]; float ss = 0.f;
#pragma unroll
                for (int bj = 0; bj < 2; ++bj)
#pragma unroll
                    for (int n = 0; n < 2; ++n) { v[bj][n] = acc[ai][bj][m][n] * ri; ss += (v[bj][n][0] * v[bj][n][0] + v[bj][n][1] * v[bj][n][1]) + (v[bj][n][2] * v[bj][n][2] + v[bj][n][3] * v[bj][n][3]); }
                ss += xor_f<16>(ss); ss = sum_xor32(ss);
                const float r2 = __builtin_amdgcn_rsqf(ss * (1.0f / 64.0f) + EPS);
#pragma unroll
                for (int bj = 0; bj < 2; ++bj)
#pragma unroll
                    for (int n = 0; n < 2; ++n) v[bj][n] = v[bj][n] * r2 * wv[bj][n];
                if (fq == 0) {
                    const LAS f32x4* rp = (const LAS f32x4*)(ropl + (lrb + ai * 128 + m * 16) * 64);
#pragma unroll
                    for (int n = 0; n < 2; ++n) { const f32x4 cs0 = rp[2 * n], cs1 = rp[2 * n + 1];
                        const float c_[4] = {cs0[0], cs0[2], cs1[0], cs1[2]}, s_[4] = {cs0[1], cs0[3], cs1[1], cs1[3]};
#pragma unroll
                        for (int e = 0; e < 4; ++e) { const float x1 = v[0][n][e], x2 = v[1][n][e]; v[0][n][e] = x1 * c_[e] - x2 * s_[e]; v[1][n][e] = x2 * c_[e] + x1 * s_[e]; } }
                }
#pragma unroll
                for (int bj = 0; bj < 2; ++bj) { u32x4 w; w.x = cvt_pk_bf16(v[bj][0][0], v[bj][0][1]); w.y = cvt_pk_bf16(v[bj][0][2], v[bj][0][3]); w.z = cvt_pk_bf16(v[bj][1][0], v[bj][1][1]); w.w = cvt_pk_bf16(v[bj][1][2], v[bj][1][3]);
                    *(u32x4*)(O + (size_t)row * 1024 + u.po * 256 + wc * 64 + bj * 32 + 8 * fq) = w; }
            }
    } break;
    case EP_MQ: case EP_MK: {
        const bool part = (u.epi == EP_MQ); const float* wn = cx.in[u.epi == EP_MQ ? 21 : 22];
        bf16_t* O = WSP(bf16_t, u.epi == EP_MQ ? WS_MQ : WS_MK);
        LAS float* red = (LAS float*)(lds + EPI_OFF);
        float ri[2][4];
#pragma unroll
        for (int ai = 0; ai < 2; ++ai)
#pragma unroll
            for (int m = 0; m < 4; ++m) {
                ri[ai][m] = part ? rl[lrb + ai * 128 + m * 16] : 1.0f; float ss = 0.f;
#pragma unroll
                for (int bj = 0; bj < 2; ++bj)
#pragma unroll
                    for (int n = 0; n < 2; ++n) { const f32x4 v = acc[ai][bj][m][n] * ri[ai][m]; ss += (v[0] * v[0] + v[1] * v[1]) + (v[2] * v[2] + v[3] * v[3]); }
                ss += xor_f<16>(ss); ss = sum_xor32(ss);
                if (fq == 0) red[(ai * 128 + wr * 64 + m * 16 + fr) * 4 + wc] = ss;
            }
        asm volatile("s_waitcnt lgkmcnt(0)" ::: "memory"); __builtin_amdgcn_s_barrier(); asm volatile("" ::: "memory");
        f32x4 wv[2][2];
#pragma unroll
        for (int bj = 0; bj < 2; ++bj)
#pragma unroll
            for (int n = 0; n < 2; ++n) wv[bj][n] = *(const f32x4*)(wn + bj * 128 + colw + 4 * n);
#pragma unroll
        for (int ai = 0; ai < 2; ++ai)
#pragma unroll
            for (int m = 0; m < 4; ++m) {
                const int row = rowb + ai * 128 + m * 16; const int lr = ai * 128 + wr * 64 + m * 16 + fr;
                const float tot = (red[lr * 4 + 0] + red[lr * 4 + 1]) + (red[lr * 4 + 2] + red[lr * 4 + 3]);
                const float r2 = __builtin_amdgcn_rsqf(tot * (1.0f / 256.0f) + EPS) * ri[ai][m];
#pragma unroll
                for (int bj = 0; bj < 2; ++bj) { const f32x4 v0 = acc[ai][bj][m][0] * r2 * wv[bj][0], v1 = acc[ai][bj][m][1] * r2 * wv[bj][1];
                    u32x4 w; w.x = cvt_pk_bf16(v0[0], v0[1]); w.y = cvt_pk_bf16(v0[2], v0[3]); w.z = cvt_pk_bf16(v1[0], v1[1]); w.w = cvt_pk_bf16(v1[2], v1[3]);
                    *(u32x4*)(O + (size_t)row * 1024 + u.po * 256 + bj * 128 + colw) = w; }
            }
        asm volatile("s_waitcnt lgkmcnt(0)" ::: "memory"); __builtin_amdgcn_s_barrier(); asm volatile("" ::: "memory");
    } break;
    case EP_ROT: {
        const float* rinvf = WSP(float, WS_RINV);
        const int isk = u.aux & 1; bf16_t* O = (u.aux & 8) ? (bf16_t*)cx.out + (isk ? (size_t)T * 512 : (size_t)0) : WSP(bf16_t, isk ? WS_RK : WS_RQ); const float ksc = isk ? 0.0625f : 1.0f;
        f32x4 fr4[2];
#pragma unroll
        for (int bj = 0; bj < 2; ++bj) fr4[bj] = *(const f32x4*)(rinvf + (bj * 128 + colw) / 2);
#pragma unroll
        for (int ai = 0; ai < 2; ++ai)
#pragma unroll
            for (int m = 0; m < 4; ++m) {
                const int row = rowb + ai * 128 + m * 16; const float ri = rl[lrb + ai * 128 + m * 16] * ksc; const float pf = pl[lrb + ai * 128 + m * 16];
#pragma unroll
                for (int bj = 0; bj < 2; ++bj) { float o[8];
#pragma unroll
                    for (int p = 0; p < 4; ++p) { const float ang = pf * fr4[bj][p];
                        const float rh = ang * 0.15915494309189535f; const float rl = __builtin_fmaf(ang, 0.15915494309189535f, -rh) + ang * (-1.2154201256553420e-10f);
                        float fr_ = rh - floorf(rh); fr_ += rl;
                        const float sn = __builtin_amdgcn_sinf(fr_), cs = __builtin_amdgcn_cosf(fr_);
                        const float xe = acc[ai][bj][m][p >> 1][(p & 1) * 2] * ri, xo = acc[ai][bj][m][p >> 1][(p & 1) * 2 + 1] * ri;
                        o[2 * p] = xe * cs - xo * sn; o[2 * p + 1] = xo * cs + xe * sn; }
                    u32x4 w; w.x = cvt_pk_bf16(o[0], o[1]); w.y = cvt_pk_bf16(o[2], o[3]); w.z = cvt_pk_bf16(o[4], o[5]); w.w = cvt_pk_bf16(o[6], o[7]);
                    *(u32x4*)(O + (size_t)row * 512 + u.po * 256 + bj * 128 + colw) = w; }
            }
    } break;
    case EP_SG: {
        const float* bg = cx.in[9] + u.aux * 1024 + u.po * 256;
        bf16_t* O = WSP(bf16_t, u.aux == 0 ? WS_SG2 : u.aux == 1 ? WS_SG : WS_SGB);
        f32x4 bv[2][2];
#pragma unroll
        for (int bj = 0; bj < 2; ++bj)
#pragma unroll
            for (int n = 0; n < 2; ++n) bv[bj][n] = *(const f32x4*)(bg + bj * 128 + colw + 4 * n);
#pragma unroll
        for (int ai = 0; ai < 2; ++ai)
#pragma unroll
            for (int m = 0; m < 4; ++m) {
                const int row = rowb + ai * 128 + m * 16; const float ri = rl[lrb + ai * 128 + m * 16];
#pragma unroll
                for (int bj = 0; bj < 2; ++bj) { f32x4 ov[2];
#pragma unroll
                    for (int n = 0; n < 2; ++n) ov[n] = rcp_4(exp2_4((acc[ai][bj][m][n] * ri + bv[bj][n]) * (-LOG2E)) + 1.0f);
                    u32x4 w; w.x = cvt_pk_bf16(ov[0][0], ov[0][1]); w.y = cvt_pk_bf16(ov[0][2], ov[0][3]); w.z = cvt_pk_bf16(ov[1][0], ov[1][1]); w.w = cvt_pk_bf16(ov[1][2], ov[1][3]);
                    *(u32x4*)(O + (size_t)row * 1024 + u.po * 256 + bj * 128 + colw) = w; }
            }
    } break;
    case EP_PM: {
        const bf16_t* SG = WSP(bf16_t, (u.aux & 2) ? WS_SG2 : (u.aux & 4) ? WS_SGB : WS_SG); bf16_t* Mb = WSP(bf16_t, WS_M); const bool accum = (u.aux & 1);
#pragma unroll
        for (int ai = 0; ai < 2; ++ai) {
            u32x4 gv[4][2], pv[4][2]; float rs[4];
#pragma unroll
            for (int m = 0; m < 4; ++m) { const int row = rowb + ai * 128 + m * 16; rs[m] = u.rs ? rsqrtf(ret_rms2(WSP(float, WS_RSS), row, 3)) : 1.0f;
#pragma unroll
                for (int bj = 0; bj < 2; ++bj) { const size_t off = (size_t)row * 1024 + u.po * 256 + bj * 128 + colw;
                    gv[m][bj] = *(const u32x4*)(SG + off); pv[m][bj] = (u32x4){0u, 0u, 0u, 0u}; if (accum) pv[m][bj] = *(const u32x4*)(Mb + off); } }
            __builtin_amdgcn_sched_barrier(0);
#pragma unroll
            for (int m = 0; m < 4; ++m) { const int row = rowb + ai * 128 + m * 16;
#pragma unroll
                for (int bj = 0; bj < 2; ++bj) { const size_t off = (size_t)row * 1024 + u.po * 256 + bj * 128 + colw;
                    const u32x4 g = gv[m][bj], pm = pv[m][bj];
                    const f32x4 a0 = acc[ai][bj][m][0] * rs[m], a1 = acc[ai][bj][m][1] * rs[m];
                    float o[8];
                    o[0] = bflo(g.x) * a0[0] + bflo(pm.x); o[1] = bfhi(g.x) * a0[1] + bfhi(pm.x); o[2] = bflo(g.y) * a0[2] + bflo(pm.y); o[3] = bfhi(g.y) * a0[3] + bfhi(pm.y);
                    o[4] = bflo(g.z) * a1[0] + bflo(pm.z); o[5] = bfhi(g.z) * a1[1] + bfhi(pm.z); o[6] = bflo(g.w) * a1[2] + bflo(pm.w); o[7] = bfhi(g.w) * a1[3] + bfhi(pm.w);
                    u32x4 w; w.x = cvt_pk_bf16(o[0], o[1]); w.y = cvt_pk_bf16(o[2], o[3]); w.z = cvt_pk_bf16(o[4], o[5]); w.w = cvt_pk_bf16(o[6], o[7]);
                    *(u32x4*)(Mb + off) = w; } }
            __builtin_amdgcn_sched_barrier(0);
        }
    } break;
    default: break;
    }
}


__device__ __forceinline__ float ret_rms2(const float* ss, int row, int h) { const f32x2 v = *(const f32x2*)(ss + (size_t)row * 8 + 2 * h); return (v[0] + v[1]) * (1.0f / 512.0f) + EPS; }
__device__ __forceinline__ void rescale_rows(const Ctx& cx, f32x4 (&acc)[2][2][4][2], int rowb, int hn) {
    const float* ss = WSP(float, WS_RSS);
#pragma unroll
    for (int ai = 0; ai < 2; ++ai)
#pragma unroll
        for (int m = 0; m < 4; ++m) { const int row = rowb + ai * 128 + m * 16; const float f = sqrtf(ret_rms2(ss, row, hn) / ret_rms2(ss, row, hn - 1));
#pragma unroll
            for (int bj = 0; bj < 2; ++bj)
#pragma unroll
                for (int n = 0; n < 2; ++n) acc[ai][bj][m][n] = acc[ai][bj][m][n] * f; }
}
__device__ __forceinline__ void gemm_phase(LAS unsigned char* lds, const GemmSched& S, const Ctx& cx, int WV) {
    using namespace pg8;
    int tid = TID_OF(WV); asm volatile("" : "+v"(tid));
    const int wid = __builtin_amdgcn_readfirstlane(tid >> 6), lane = tid & 63, wr = wid >> 2, wc = wid & 3, fr = lane & 15, fq = lane >> 4;
    int RA, RB, CC;
    { int R, C; stage_rc(tid * 16, R, C); RA = R * 2; RB = ((R & ~31) + perm32(R & 31)) * 2; CC = C * 2; }
    const size_t kstep = (size_t)(BK * 2);
    const unsigned ldsw = (unsigned)wid * 1024u;
    const int aoff = lds_byte(wr * 64 + fr, fq * 8), boff = lds_byte(wc * 32 + fr, fq * 8);
#define PG8_SA(b, h) (((b) * 2 + (h)) * HTB)
#define PG8_SB(b, h) ((4 + (b) * 2 + (h)) * HTB)
#define PG8_STAGE(bufoff, gbase, voff, hs) do { \
        __builtin_amdgcn_global_load_lds((const unsigned*)((const char*)(gbase) + (voff)), (LAS unsigned*)(lds + (bufoff) + ldsw), 16, 0, 0); \
        __builtin_amdgcn_global_load_lds((const unsigned*)((const char*)(gbase) + ((hs) >> 1) + (voff)), (LAS unsigned*)(lds + (bufoff) + ldsw + 8192), 16, 0, 0); } while (0)
#define PG8_LDA(dst, b, h) do { _Pragma("unroll") for (int m = 0; m < 4; ++m) _Pragma("unroll") for (int k = 0; k < 2; ++k) dst[m][k] = *(const LAS bf16x8*)(lds + PG8_SA(b, h) + aoff + m * 2048 + k * 1024); } while (0)
#define PG8_LDB(dst, b, h) do { _Pragma("unroll") for (int n = 0; n < 2; ++n) _Pragma("unroll") for (int k = 0; k < 2; ++k) dst[n][k] = *(const LAS bf16x8*)(lds + PG8_SB(b, h) + boff + n * 2048 + k * 1024); } while (0)
#define PG8_MMA(ai, bj, At, Bt) do { __builtin_amdgcn_s_setprio(1); _Pragma("unroll") for (int m = 0; m < 4; ++m) _Pragma("unroll") for (int n = 0; n < 2; ++n) _Pragma("unroll") for (int k = 0; k < 2; ++k) \
        acc[ai][bj][m][n] = __builtin_amdgcn_mfma_f32_16x16x32_bf16(Bt[n][k], At[m][k], acc[ai][bj][m][n], 0, 0, 0); __builtin_amdgcn_s_setprio(0); } while (0)
#define PG8_WAIT_V(n) asm volatile("s_waitcnt vmcnt(" #n ")" ::: "memory")
#define PG8_WAIT_L(n) asm volatile("s_waitcnt lgkmcnt(" #n ")" ::: "memory")
#define PG8_BAR __builtin_amdgcn_s_barrier()
#define PG8_SCHED __builtin_amdgcn_sched_barrier(0)
    Unit cur, nxt; int ui = 0;
    if (!S.next(0, cur)) return;
    f32x4 acc[2][2][4][2];
    { float z = 0.f; asm volatile("" : "+v"(z));
#pragma unroll
    for (int a = 0; a < 2; ++a)
#pragma unroll
        for (int b = 0; b < 2; ++b)
#pragma unroll
            for (int m = 0; m < 4; ++m)
#pragma unroll
                for (int n = 0; n < 2; ++n) acc[a][b][m][n] = (f32x4){z, z, z, z}; }
    bf16x8 At[4][2], B0[2][2], B1[2][2];
    int Kc = cur.K; size_t hsAc = (size_t)HALF * cur.lda * 2, hsBc = (size_t)HALF * Kc * 2;
    unsigned vAc = (unsigned)(RA * cur.lda + CC), vBc = (unsigned)(RB * Kc + CC);
    const char* cA = (const char*)cur.A + (size_t)cur.pm * 2 * hsAc; const char* cB = (const char*)cur.Bt + (size_t)cur.pn * 2 * hsBc;
    PG8_STAGE(PG8_SB(0, 0), cB, vBc, hsBc); PG8_STAGE(PG8_SB(0, 1), cB + hsBc, vBc, hsBc); PG8_STAGE(PG8_SA(0, 0), cA, vAc, hsAc); PG8_STAGE(PG8_SA(0, 1), cA + hsAc, vAc, hsAc);
    if (wr == 1) PG8_BAR;
    PG8_WAIT_V(2); PG8_BAR;
    PG8_STAGE(PG8_SB(1, 0), cB + kstep, vBc, hsBc); PG8_STAGE(PG8_SA(1, 0), cA + kstep, vAc, hsAc); PG8_STAGE(PG8_SB(1, 1), cB + hsBc + kstep, vBc, hsBc);
    PG8_WAIT_V(6); PG8_BAR;
    PROBE_MARK(lds, S.ph, 0);
    for (;;) {
        const bool has_next = S.next(ui + 1, nxt);
        const int Kn = has_next ? nxt.K : Kc; const int ldan = has_next ? nxt.lda : cur.lda; const size_t hsAn = (size_t)HALF * ldan * 2, hsBn = (size_t)HALF * Kn * 2;
        const unsigned vAn = (unsigned)(RA * ldan + CC), vBn = (unsigned)(RB * Kn + CC);
        const char* nA = has_next ? (const char*)nxt.A + (size_t)nxt.pm * 2 * hsAn : cA; const char* nB = has_next ? (const char*)nxt.Bt + (size_t)nxt.pn * 2 * hsBn : cB;
        const int nt = Kc / BK; const int kjt = cur.kjt; const size_t kj = (size_t)cur.kjump;
#define PG8_AOFF(tt) ((size_t)(tt) * kstep + (((tt) >= kjt) ? kj : (size_t)0))
        for (int t = 0; t < nt; t += 2) {
            const bool last = (t == nt - 2);
            const char* a1 = cA + PG8_AOFF(t + 1);
            const char* a2 = last ? nA : cA + PG8_AOFF(t + 2); const char* b2 = last ? nB : cB + (size_t)(t + 2) * kstep;
            const char* a3 = last ? nA + kstep : cA + PG8_AOFF(t + 3); const char* b3 = b2 + kstep;
            const size_t hsA2 = last ? hsAn : hsAc, hsB2 = last ? hsBn : hsBc;
            const unsigned vA2 = last ? vAn : vAc, vB2 = last ? vBn : vBc;
            PG8_LDB(B0, 0, 0); PG8_LDB(B1, 0, 1); PG8_SCHED; PG8_LDA(At, 0, 0); PG8_STAGE(PG8_SA(1, 1), a1 + hsAc, vAc, hsAc);
            PG8_WAIT_V(8); PG8_WAIT_L(0); PG8_BAR; PG8_MMA(0, 0, At, B0); PG8_MMA(0, 1, At, B1); PG8_BAR; PG8_SCHED;
            PG8_LDA(At, 0, 1); PG8_STAGE(PG8_SB(0, 0), b2, vB2, hsB2); PG8_STAGE(PG8_SB(0, 1), b2 + hsB2, vB2, hsB2); PG8_STAGE(PG8_SA(0, 0), a2, vA2, hsA2);
            PG8_WAIT_V(8); PG8_WAIT_L(0); PG8_BAR; PG8_MMA(1, 0, At, B0); PG8_MMA(1, 1, At, B1); PG8_BAR; PG8_SCHED;
            PG8_LDB(B0, 1, 0); PG8_LDB(B1, 1, 1); PG8_SCHED; PG8_LDA(At, 1, 0); PG8_STAGE(PG8_SA(0, 1), a2 + hsA2, vA2, hsA2);
            PG8_WAIT_V(8); PG8_WAIT_L(0); PG8_BAR; PG8_MMA(0, 0, At, B0); PG8_MMA(0, 1, At, B1); PG8_BAR; PG8_SCHED;
            PG8_LDA(At, 1, 1); PG8_STAGE(PG8_SB(1, 0), b3, vB2, hsB2); PG8_STAGE(PG8_SB(1, 1), b3 + hsB2, vB2, hsB2); PG8_STAGE(PG8_SA(1, 0), a3, vA2, hsA2);
            PG8_WAIT_V(8); PG8_WAIT_L(0); PG8_BAR; PG8_MMA(1, 0, At, B0); PG8_MMA(1, 1, At, B1); PG8_BAR; PG8_SCHED;
        }
#undef PG8_AOFF
        if (wr == 0) PG8_BAR;
        if (ui == 0) PROBE_MARK(lds, S.ph, 1); if (!has_next) PROBE_MARK(lds, S.ph, 3);
        { int fr_ = fr, fq_ = fq; asm volatile("" : "+v"(fr_), "+v"(fq_));
          epilogue(cx, cur, acc, wr, wc, fr_, fq_, lds); }
        if (ui == 0) PROBE_MARK(lds, S.ph, 2); if (!has_next) PROBE_MARK(lds, S.ph, 4);
        if (!has_next) break;
        {
            const bool rsc = (cur.epi == EP_RSC); const int hn = rsc ? cur.aux : 1; const float* ss = WSP(float, WS_RSS); const int rowb = cur.pm * 256 + wr * 64 + fr;
#pragma unroll
            for (int a = 0; a < 2; ++a)
#pragma unroll
                for (int m = 0; m < 4; ++m) { const int row = rowb + a * 128 + m * 16; float f = 0.0f; if (rsc) f = sqrtf(ret_rms2(ss, row, hn) / ret_rms2(ss, row, hn - 1));
#pragma unroll
                    for (int b = 0; b < 2; ++b)
#pragma unroll
                        for (int n = 0; n < 2; ++n) acc[a][b][m][n] = acc[a][b][m][n] * f; }
        }
        cur = nxt; cA = nA; cB = nB; Kc = Kn; hsAc = hsAn; hsBc = hsBn; vAc = vAn; vBc = vBn;
        ++ui;
        if (wr == 1) PG8_BAR;
    }
    PG8_WAIT_V(0);
    PG8_BAR;
#undef PG8_SA
#undef PG8_SB
#undef PG8_STAGE
#undef PG8_LDA
#undef PG8_LDB
#undef PG8_MMA
#undef PG8_WAIT_V
#undef PG8_WAIT_L
#undef PG8_BAR
#undef PG8_SCHED
}

struct AttItem {
    const bf16_t* Q; int ldq;
    const bf16_t* K; int ldk;
    const bf16_t* V; int ldv;
    bf16_t* O; int ldo;
    const bf16_t* G;
    int nt;
    int q0;
    float p0, p1, p2;
};
__device__ __forceinline__ s16x4 ds_tr16(const LAS unsigned char* p) { return __builtin_bit_cast(s16x4, __builtin_amdgcn_ds_read_tr16_b64_v4i16((LAS s16x4*)p)); }

template <int NM, int DQ, int DV, int MODE>
__device__ __forceinline__ void attn_item(LAS unsigned char* lds, const AttItem& it, const Ctx& cx, int WV) {
    constexpr int QW = NM * DQ, QP = (QW + 8) * 2  , VP = (DV + 8) * 2, PP = 72 * 2;
    constexpr int OFF_Q = 0, OFF_K = OFF_Q + 64 * QP, OFF_V = OFF_K + 64 * QP, OFF_P = OFF_V + 64 * VP, OFF_R = OFF_P + NM * 64 * PP;
    static_assert(OFF_R + 8 * 64 * 4 + 2 * 64 * 4 <= ATT_BYTES, "attention LDS");
    int tid = TID_OF(WV); asm volatile("" : "+v"(tid));
    const int w = __builtin_amdgcn_readfirstlane(tid >> 6), l = tid & 63, l15 = l & 15, g = l >> 4;
    const int rb = w >> 1, ch = w & 1;
    constexpr int NTV = DV / 128;
    const int c0 = w * (DV / 8);
    LAS float* RED = (LAS float*)(lds + OFF_R);
    LAS float* FIN = RED + 8 * 64;
    for (int i = tid; i < 64 * (QW / 8); i += 512) { const int r = i / (QW / 8), c = i % (QW / 8);
        *(LAS u32x4*)(lds + OFF_Q + r * QP + c * 16) = *(const u32x4*)(it.Q + (size_t)r * it.ldq + c * 8); }
    f32x4 o[NM][4][NTV];
#pragma unroll
    for (int r = 0; r < NM; ++r)
#pragma unroll
        for (int m = 0; m < 4; ++m)
#pragma unroll
            for (int n = 0; n < NTV; ++n) o[r][m][n] = (f32x4){0.f, 0.f, 0.f, 0.f};
    float lsum[NM][4];
#pragma unroll
    for (int r = 0; r < NM; ++r)
#pragma unroll
        for (int j = 0; j < 4; ++j) lsum[r][j] = 0.f;
    for (int kt = 0; kt < it.nt; ++kt) {
        for (int i = tid; i < 64 * (QW / 8); i += 512) { const int r = i / (QW / 8), c = i % (QW / 8);
            *(LAS u32x4*)(lds + OFF_K + r * QP + c * 16) = *(const u32x4*)(it.K + (size_t)(kt * 64 + r) * it.ldk + c * 8); }
        for (int i = tid; i < 64 * (DV / 8); i += 512) { const int r = i / (DV / 8), c = i % (DV / 8);
            *(LAS u32x4*)(lds + OFF_V + r * VP + c * 16) = *(const u32x4*)(it.V + (size_t)(kt * 64 + r) * it.ldv + c * 8); }
        __syncthreads();
#pragma unroll
        for (int r = 0; r < NM; ++r) {
            f32x4 s[2]; s[0] = (f32x4){0.f, 0.f, 0.f, 0.f}; s[1] = s[0];
#pragma unroll
            for (int ks = 0; ks < DQ / 32; ++ks) {
                const bf16x8 a = *(const LAS bf16x8*)(lds + OFF_Q + (16 * rb + l15) * QP + (r * DQ + 32 * ks + 8 * g) * 2);
#pragma unroll
                for (int n = 0; n < 2; ++n) { const bf16x8 b = *(const LAS bf16x8*)(lds + OFF_K + (32 * ch + 16 * n + l15) * QP + (r * DQ + 32 * ks + 8 * g) * 2);
                    s[n] = __builtin_amdgcn_mfma_f32_16x16x32_bf16(a, b, s[n], 0, 0, 0); }
            }
#pragma unroll
            for (int n = 0; n < 2; ++n)
#pragma unroll
                for (int j = 0; j < 4; ++j) {
                    const int row = 16 * rb + 4 * g + j, key = 32 * ch + 16 * n + l15; float p;
                    if (MODE == 0) { const int dist = (it.q0 + row) - (kt * 64 + key); p = s[n][j] * __builtin_amdgcn_exp2f(it.p0 * (float)(dist < 0 ? -dist : dist)); }
                    else { p = __builtin_amdgcn_exp2f(s[n][j] * it.p0 - it.p1); lsum[r][j] += p; }
                    *(LAS unsigned short*)(lds + OFF_P + r * 64 * PP + row * PP + key * 2) = f2bf(p);
                }
        }
        __syncthreads();
#pragma unroll
        for (int ks = 0; ks < 2; ++ks) {
            bf16x8 bv[NTV];
#pragma unroll
            for (int n = 0; n < NTV; ++n) {
                const int q = (l & 15) >> 2, p = l & 3;
                const LAS unsigned char* base = lds + OFF_V + (32 * ks + 8 * g + q) * VP + (c0 + 16 * n + 4 * p) * 2;
                const s16x4 t0 = ds_tr16(base), t1 = ds_tr16(base + 4 * VP);
                bv[n] = (bf16x8){t0[0], t0[1], t0[2], t0[3], t1[0], t1[1], t1[2], t1[3]};
            }
#pragma unroll
            for (int r = 0; r < NM; ++r)
#pragma unroll
                for (int m = 0; m < 4; ++m) {
                    const bf16x8 a = *(const LAS bf16x8*)(lds + OFF_P + r * 64 * PP + (16 * m + l15) * PP + (32 * ks + 8 * g) * 2);
#pragma unroll
                    for (int n = 0; n < NTV; ++n) o[r][m][n] = __builtin_amdgcn_mfma_f32_16x16x32_bf16(a, bv[n], o[r][m][n], 0, 0, 0);
                }
        }
        __syncthreads();
    }
    if (MODE != 0) {
#pragma unroll
        for (int r = 0; r < NM; ++r)
#pragma unroll
            for (int j = 0; j < 4; ++j) { float v = lsum[r][j]; v += xor_f<1>(v); v += xor_f<2>(v); v += xor_f<4>(v); v += xor_f<8>(v);
                if (l15 == 0) RED[(r * 2 + ch) * 64 + 16 * rb + 4 * g + j] = v; }
        __syncthreads();
        if (tid < NM * 64) { const int r = tid >> 6, row = tid & 63; FIN[r * 64 + row] = 1.0f / (RED[(r * 2 + 0) * 64 + row] + RED[(r * 2 + 1) * 64 + row]); }
        __syncthreads();
    }
    f32x4 y[4][NTV];
#pragma unroll
    for (int m = 0; m < 4; ++m)
#pragma unroll
        for (int n = 0; n < NTV; ++n)
#pragma unroll
            for (int j = 0; j < 4; ++j) { const int row = 16 * m + 4 * g + j;
                if (MODE == 0) y[m][n][j] = o[0][m][n][j];
                else if (MODE == 1) y[m][n][j] = o[0][m][n][j] * FIN[row] - it.p2 * (o[NM - 1][m][n][j] * FIN[(NM - 1) * 64 + row]);
                else y[m][n][j] = o[0][m][n][j] * FIN[row]; }
    if (MODE != 2) {
        __syncthreads();
#pragma unroll
        for (int m = 0; m < 4; ++m)
#pragma unroll
            for (int j = 0; j < 4; ++j) { float v = 0.f;
#pragma unroll
                for (int n = 0; n < NTV; ++n) v += y[m][n][j] * y[m][n][j];
                v += xor_f<1>(v); v += xor_f<2>(v); v += xor_f<4>(v); v += xor_f<8>(v);
                if (l15 == 0) RED[w * 64 + 16 * m + 4 * g + j] = v; }
        __syncthreads();
        if (tid < 64) { float s = 0.f;
#pragma unroll
            for (int k = 0; k < 8; ++k) s += RED[k * 64 + tid];
            FIN[tid] = rsqrtf(s * (1.0f / DV) + EPS); }
        __syncthreads();
    }
#pragma unroll
    for (int m = 0; m < 4; ++m)
#pragma unroll
        for (int n = 0; n < NTV; ++n)
#pragma unroll
            for (int j = 0; j < 4; ++j) { const int row = 16 * m + 4 * g + j, col = c0 + 16 * n + l15; float v = y[m][n][j];
                if (MODE == 0) { const float gt = bf2f(it.G[(size_t)row * it.ldv + col]); v = v * FIN[row] * (gt * fsigmoid(gt)); }
                else if (MODE == 1) { v = v * FIN[row] * cx.in[17][col] * 0.8f; }
                it.O[(size_t)row * it.ldo + col] = f2bf(v); }
    __syncthreads();
}


#define TR8(lo, hh, addr, base) asm volatile( \
    "ds_read_b64_tr_b16 %0, %8 offset:%c9\n\tds_read_b64_tr_b16 %4, %8 offset:%c10\n\t" \
    "ds_read_b64_tr_b16 %1, %8 offset:%c11\n\tds_read_b64_tr_b16 %5, %8 offset:%c12\n\t" \
    "ds_read_b64_tr_b16 %2, %8 offset:%c13\n\tds_read_b64_tr_b16 %6, %8 offset:%c14\n\t" \
    "ds_read_b64_tr_b16 %3, %8 offset:%c15\n\tds_read_b64_tr_b16 %7, %8 offset:%c16\n\ts_waitcnt lgkmcnt(0)" \
    : "=&v"(lo[0]), "=&v"(lo[1]), "=&v"(lo[2]), "=&v"(lo[3]), "=&v"(hh[0]), "=&v"(hh[1]), "=&v"(hh[2]), "=&v"(hh[3]) \
    : "v"(addr), "i"((base)), "i"((base) + 512), "i"((base) + 1024), "i"((base) + 1536), "i"((base) + 2048), "i"((base) + 2560), "i"((base) + 3072), "i"((base) + 3584) : "memory")
#define TR8K(lo, hh, addr, base) asm volatile( \
    "ds_read_b64_tr_b16 %0, %8 offset:%c9\n\tds_read_b64_tr_b16 %4, %8 offset:%c10\n\t" \
    "ds_read_b64_tr_b16 %1, %8 offset:%c11\n\tds_read_b64_tr_b16 %5, %8 offset:%c12\n\t" \
    "ds_read_b64_tr_b16 %2, %8 offset:%c13\n\tds_read_b64_tr_b16 %6, %8 offset:%c14\n\t" \
    "ds_read_b64_tr_b16 %3, %8 offset:%c15\n\tds_read_b64_tr_b16 %7, %8 offset:%c16\n\ts_waitcnt lgkmcnt(0)" \
    : "=&v"(lo[0]), "=&v"(lo[1]), "=&v"(lo[2]), "=&v"(lo[3]), "=&v"(hh[0]), "=&v"(hh[1]), "=&v"(hh[2]), "=&v"(hh[3]) \
    : "v"(addr), "i"((base)), "i"((base) + 512), "i"((base) + 4096), "i"((base) + 4608), "i"((base) + 8192), "i"((base) + 8704), "i"((base) + 12288), "i"((base) + 12800) : "memory")
typedef float f32x16 __attribute__((ext_vector_type(16)));
struct FaUnit {
    const bf16_t* Q; int ldq;
    const bf16_t* K; int ldk;
    const bf16_t* V; int ldv;
    bf16_t* O; int ldo;
    int nt;
    int vis0;
    float c, mc, lam;
};
__device__ __forceinline__ int crow(int r, int hi) { return (r & 3) + 8 * (r >> 2) + 4 * hi; }
#define FA_WAIT_BAR() asm volatile("s_waitcnt vmcnt(0) lgkmcnt(0)\n\ts_barrier" ::: "memory")

template <int NM, int DQ, int NDVB, int MODE, int NPASS, bool QLDS, bool KEEP = false>
__device__ __forceinline__ void fa_unit(LAS unsigned char* lds, const FaUnit& U, const Ctx& cx, int WV) {
    constexpr int NKP = NM * DQ / 8;
    constexpr int NVP = NDVB * 4;
    constexpr int KB = NKP * 1024, VB = NVP * 1024, SLOT = KB + VB;
    constexpr int OFF_WS = 2 * SLOT;
    constexpr int OFF_QL = OFF_WS + 8 * NM * 32 * 4;
    constexpr int NQF = NM * (DQ / 16);
    static_assert(OFF_QL + (QLDS ? NQF * 8192 : 0) <= ATT_BYTES, "fa LDS");
    static_assert(QLDS ? (8 * 32 * (NDVB * 64) <= NQF * 8192) : (8 * 32 * (NDVB * 64) <= OFF_WS), "fa stage");
    int tid = TID_OF(WV); asm volatile("" : "+v"(tid));
    const int w = __builtin_amdgcn_readfirstlane(tid >> 6), l = tid & 63, r32 = l & 31, hi = l >> 5;
    const unsigned kvo = (unsigned)(l * U.ldk * 2), vvo = (unsigned)((l >> 2) * U.ldv * 2 + (l & 3) * 16);
    const size_t ktile = (size_t)64 * U.ldk * 2, vtile = (size_t)64 * U.ldv * 2;
#define FA_DMA(t, slot) do { \
        const char* kb_ = (const char*)U.K + (size_t)(t) * ktile; const char* vb_ = (const char*)U.V + (size_t)(t) * vtile + ps * (64 * NDVB); \
        unsigned kvo_ = kvo, vvo_ = vvo; asm volatile("" : "+v"(kvo_), "+v"(vvo_));   \
        if (!(KEEP && ps == 1)) { _Pragma("unroll") for (int i_ = 0; i_ < NKP / 8; ++i_) { const int ck = w + 8 * i_; \
            __builtin_amdgcn_global_load_lds((const unsigned*)(kb_ + ck * 16 + kvo_), (LAS unsigned*)(lds + (slot) * SLOT + ck * 1024), 16, 0, 0); } }   \
        _Pragma("unroll") for (int i_ = 0; i_ < NVP / 8; ++i_) { const int pv_ = w + 8 * i_, dvb_ = pv_ >> 2, kg_ = pv_ & 3; \
            __builtin_amdgcn_global_load_lds((const unsigned*)(vb_ + (size_t)(16 * kg_) * U.ldv * 2 + 64 * dvb_ + vvo_), (LAS unsigned*)(lds + (slot) * SLOT + KB + pv_ * 1024), 16, 0, 0); } \
    } while (0)
    bf16x8 qr[NM][DQ / 16];
    LAS unsigned char* qls = lds + OFF_QL + tid * 16;
    { const bf16_t* qp = U.Q + (size_t)(32 * w + r32) * U.ldq + 8 * hi;
#pragma unroll
      for (int r = 0; r < NM; ++r)
#pragma unroll
          for (int d0 = 0; d0 < DQ / 16; ++d0) { const bf16x8 v = *(const bf16x8*)(qp + r * DQ + 16 * d0);
              if (QLDS) *(LAS bf16x8*)(qls + (r * (DQ / 16) + d0) * 8192) = v; else qr[r][d0] = v; } }
    static_assert(!KEEP || (NM == 1 && NPASS == 2), "KEEP");
    bf16x8 pst[KEEP ? 4 : 1][4];
    float lsum[NM];
#pragma unroll
    for (int r = 0; r < NM; ++r) lsum[r] = 0.f;
#pragma unroll 1
    for (int ps_ = 0; ps_ < (KEEP ? 1 : NPASS); ++ps_)
#pragma unroll
    for (int ps = (KEEP ? 0 : ps_); ps < (KEEP ? NPASS : ps_ + 1); ++ps) {
    FA_DMA(0, 0);
    float zf_ = 0.f; asm volatile("" : "+v"(zf_));
    f32x16 o[NM][NDVB];
#pragma unroll
    for (int r = 0; r < NM; ++r)
#pragma unroll
        for (int d = 0; d < NDVB; ++d)
#pragma unroll
            for (int i = 0; i < 16; ++i) o[r][d][i] = zf_;
    if (!KEEP) {
#pragma unroll
        for (int r = 0; r < NM; ++r) lsum[r] = 0.f; }
    const int vis = U.vis0 + (w >> 1);
    const int kfo = hi * 1024 + r32 * 16;
    const int vfo = (4 * hi + ((l & 15) >> 2)) * 64 + ((l >> 4) & 1) * 32 + (l & 3) * 8;
    FA_WAIT_BAR();
    auto tile_body = [&](const int t, const int tk) {
        const int slot = t & 1;
        if (t + 1 < U.nt) FA_DMA(t + 1, slot ^ 1);
        if (t <= vis) {
            const LAS unsigned char* kb = lds + slot * SLOT + kfo;
            const unsigned vba = (unsigned)(size_t)(lds + slot * SLOT + KB + vfo);
#pragma unroll
            for (int r = 0; r < NM; ++r) {
                bf16x8 pw[4]; float ls = 0.f;
                if (KEEP && ps == 1) {
#pragma unroll
                    for (int k4 = 0; k4 < 4; ++k4) pw[k4] = pst[KEEP ? tk : 0][k4];
                } else {
#pragma unroll
                for (int kh = 0; kh < 2; ++kh) {
                    f32x16 p;
#pragma unroll
                    for (int i = 0; i < 16; ++i) p[i] = 0.f;
#pragma unroll
                    for (int d0 = 0; d0 < DQ / 16; ++d0) {
                        const bf16x8 a0 = *(const LAS bf16x8*)(kb + (r * (DQ / 8) + 2 * d0) * 1024 + kh * 512);
                        bf16x8 qf; if (QLDS) qf = *(const LAS bf16x8*)(qls + (r * (DQ / 16) + d0) * 8192); else qf = qr[r][d0];
                        p = __builtin_amdgcn_mfma_f32_32x32x16_bf16(a0, qf, p, 0, 0, 0);
                    }
#pragma unroll
                    for (int i = 0; i < 16; ++i) { p[i] = __builtin_amdgcn_exp2f(__builtin_fmaf(p[i], U.c, -U.mc)); ls += p[i]; }
                    u32x4 t0, t1;
                    t0.x = cvt_pk_bf16(p[0], p[1]); t0.y = cvt_pk_bf16(p[2], p[3]); t0.z = cvt_pk_bf16(p[4], p[5]); t0.w = cvt_pk_bf16(p[6], p[7]);
                    t1.x = cvt_pk_bf16(p[8], p[9]); t1.y = cvt_pk_bf16(p[10], p[11]); t1.z = cvt_pk_bf16(p[12], p[13]); t1.w = cvt_pk_bf16(p[14], p[15]);
                    pw[2 * kh] = __builtin_bit_cast(bf16x8, t0); pw[2 * kh + 1] = __builtin_bit_cast(bf16x8, t1);
                }
                if (KEEP) {
#pragma unroll
                    for (int k4 = 0; k4 < 4; ++k4) pst[KEEP ? tk : 0][k4] = pw[k4]; }
                lsum[r] += ls;
                }
                static_assert(NDVB == 4, "P V step layout");
#pragma unroll
                for (int ks = 0; ks < 4; ++ks) {
                    s16x4 lo[4], hh[4];
                    TR8K(lo, hh, vba, ks * 1024);
                    __builtin_amdgcn_sched_barrier(0);
#pragma unroll
                    for (int d = 0; d < 4; ++d) {
                        const bf16x8 vf = (bf16x8){lo[d][0], lo[d][1], lo[d][2], lo[d][3], hh[d][0], hh[d][1], hh[d][2], hh[d][3]};
                        o[r][d] = __builtin_amdgcn_mfma_f32_32x32x16_bf16(pw[ks], vf, o[r][d], 0, 0, 0); }
                }
            }
        }
        FA_WAIT_BAR();
    };
    if constexpr (KEEP) {
#pragma unroll
        for (int t = 0; t < 4; ++t) tile_body(t, t);
    } else {
        for (int t = 0; t < U.nt; ++t) tile_body(t, 0);
    }
#ifdef FA_NOEPI
    { float acc_ = lsum[0]; for (int r = 0; r < NM; ++r) for (int d = 0; d < NDVB; ++d) for (int i = 0; i < 16; ++i) acc_ += o[r][d][i]; U.O[tid] = f2bf(acc_); }
#else
    LAS float* wsf = (LAS float*)(lds + OFF_WS) + w * (NM * 32);
#pragma unroll
    for (int r = 0; r < NM; ++r) { const float v = sum_xor32(lsum[r]); if (hi == 0) wsf[r * 32 + r32] = __builtin_amdgcn_rcpf(v); }
    asm volatile("s_waitcnt lgkmcnt(0)" ::: "memory");
    char* ob = (char*)U.O + ((size_t)(32 * w) * U.ldo + ps * (32 * NDVB)) * 2;
    constexpr int SPITCH = NDVB * 64; LAS unsigned char* stg = lds + (QLDS ? OFF_QL : 0) + w * (32 * SPITCH);
    float wv[NDVB];
#pragma unroll
    for (int d = 0; d < NDVB; ++d) wv[d] = (MODE == 1) ? cx.in[17][32 * d + r32] * 0.8f : 1.0f;
#pragma unroll
    for (int i = 0; i < 16; ++i) {
        const int q = crow(i, hi); const float li0 = wsf[q]; float y[NDVB];
        if (MODE == 1) { const float li1 = wsf[(NM - 1) * 32 + q] * U.lam; float s2 = 0.f;
#pragma unroll
            for (int d = 0; d < NDVB; ++d) { y[d] = o[0][d][i] * li0 - o[NM - 1][d][i] * li1; s2 += y[d] * y[d]; }
            s2 = row32_sum(s2);
            const float rn = __builtin_amdgcn_rsqf(s2 * (1.0f / (32 * NDVB)) + EPS);
#pragma unroll
            for (int d = 0; d < NDVB; ++d) y[d] = y[d] * rn * wv[d]; }
        else {
#pragma unroll
            for (int d = 0; d < NDVB; ++d) y[d] = o[0][d][i] * li0; }
#pragma unroll
        for (int d = 0; d < NDVB; ++d) *(LAS bf16_t*)(stg + q * SPITCH + (32 * d + r32) * 2) = f2bf(y[d]);
    }
    asm volatile("s_waitcnt lgkmcnt(0)" ::: "memory");
#pragma unroll
    for (int it = 0; it < NDVB * 2; ++it) { const int c = it * 64 + l, row = c / (NDVB * 4), ch = c % (NDVB * 4);
        const u32x4 v = *(const LAS u32x4*)(stg + row * SPITCH + ch * 16);
        *(u32x4*)(ob + ((size_t)row * U.ldo + ch * 8) * 2) = v; }
#endif
    FA_WAIT_BAR();
    }
#undef FA_DMA
}


struct RetUnit {
    const bf16_t* Q; const bf16_t* K; const bf16_t* V;
    const bf16_t* G; bf16_t* O;
    int nt;
    int c0;
    float lg;
};
__device__ __forceinline__ void fa_ret_unit(LAS unsigned char* lds, const RetUnit& U, int WV) {
    constexpr int LDQ = 512, LDK = 512, LDV = 1024, LDO = 1024;
    constexpr int KB = 16384, SLOT = 49152, OFF_QP = 2 * SLOT, OFF_WS = OFF_QP + 4 * 14 * 1024;
    static_assert(OFF_WS + 8 * 32 * 4 <= ATT_BYTES, "ret LDS");
    int tid = TID_OF(WV); asm volatile("" : "+v"(tid));
    const int w = __builtin_amdgcn_readfirstlane(tid >> 6), l = tid & 63, r32 = l & 31, hi = l >> 5, rb = w >> 1, dh = w & 1;
    const unsigned kvo = (unsigned)((l & 31) * LDK * 2 + (l >> 5) * 16), vvo = (unsigned)((l >> 2) * LDV * 2 + (l & 3) * 16);
#define RT_DMA(t, slot) do { \
        const char* kb_ = (const char*)U.K + (size_t)(t) * (32 * LDK * 2); const char* vb_ = (const char*)U.V + (size_t)(t) * (32 * LDV * 2); \
        unsigned kvo_ = kvo, vvo_ = vvo; asm volatile("" : "+v"(kvo_), "+v"(vvo_)); \
        _Pragma("unroll") for (int i_ = 0; i_ < 2; ++i_) { const int cp = w + 8 * i_; \
            __builtin_amdgcn_global_load_lds((const unsigned*)(kb_ + cp * 32 + kvo_), (LAS unsigned*)(lds + (slot) * SLOT + cp * 1024), 16, 0, 0); } \
        _Pragma("unroll") for (int i_ = 0; i_ < 4; ++i_) { const int pv_ = w + 8 * i_, dvb_ = pv_ >> 1, kg_ = pv_ & 1; \
            __builtin_amdgcn_global_load_lds((const unsigned*)(vb_ + kg_ * (16 * LDV * 2) + 64 * dvb_ + vvo_), (LAS unsigned*)(lds + (slot) * SLOT + KB + pv_ * 1024), 16, 0, 0); } \
    } while (0)
    RT_DMA(0, 0);
    bf16x8 q0r, q1r;
    { const bf16_t* qp = U.Q + (size_t)(32 * rb + r32) * LDQ + 8 * hi; LAS unsigned char* qpk = lds + OFF_QP + rb * 14336 + l * 16;
      q0r = *(const bf16x8*)(qp); q1r = *(const bf16x8*)(qp + 16);
      if (dh == 0) {
#pragma unroll
          for (int d0 = 2; d0 < 16; ++d0) *(LAS bf16x8*)(qpk + (d0 - 2) * 1024) = *(const bf16x8*)(qp + 16 * d0); } }
    f32x16 o[8];
#pragma unroll
    for (int d = 0; d < 8; ++d)
#pragma unroll
        for (int i = 0; i < 16; ++i) o[d][i] = 0.f;
    const int cw = U.c0 + (rb >> 1);
    const int kfo = hi * 512 + r32 * 16;
    const int vfo = (4 * hi + ((l & 15) >> 2)) * 64 + ((l >> 4) & 1) * 32 + (l & 3) * 8;
    const LAS unsigned char* qpk = lds + OFF_QP + rb * 14336 + l * 16;
    const float qpos = (float)(64 * U.c0 + 32 * rb + r32);
    FA_WAIT_BAR();
    for (int t = 0; t < U.nt; ++t) {
        const int slot = t & 1;
        if (t + 1 < U.nt) RT_DMA(t + 1, slot ^ 1);
        if ((t >> 1) <= cw) {
            const LAS unsigned char* kb = lds + slot * SLOT + kfo;
            const unsigned vba = (unsigned)(size_t)(lds + slot * SLOT + KB + dh * 16384 + vfo);
            f32x16 p;
#pragma unroll
            for (int i = 0; i < 16; ++i) p[i] = 0.f;
            {
                bf16x8 ka[2][4], qa[2][4];
#define RT_LOADB(buf, b_) do { _Pragma("unroll") for (int j = 0; j < 4; ++j) { const int d0 = 4 * (b_) + j; ka[buf][j] = *(const LAS bf16x8*)(kb + d0 * 1024); \
                    if (d0 == 0) qa[buf][j] = q0r; else if (d0 == 1) qa[buf][j] = q1r; else qa[buf][j] = *(const LAS bf16x8*)(qpk + (d0 - 2) * 1024); } } while (0)
                RT_LOADB(0, 0);
#pragma unroll
                for (int b_ = 0; b_ < 4; ++b_) {
                    if (b_ < 3) RT_LOADB((b_ + 1) & 1, b_ + 1);
                    __builtin_amdgcn_sched_barrier(0);
#pragma unroll
                    for (int j = 0; j < 4; ++j) p = __builtin_amdgcn_mfma_f32_32x32x16_bf16(ka[b_ & 1][j], qa[b_ & 1][j], p, 0, 0, 0);
                    __builtin_amdgcn_sched_barrier(0);
                }
#undef RT_LOADB
            }
            const float dq = qpos - (float)(32 * t + 4 * hi);
#pragma unroll
            for (int i = 0; i < 16; ++i) { const float dd = dq - (float)((i & 3) + 8 * (i >> 2)); p[i] *= __builtin_amdgcn_exp2f(U.lg * __builtin_fabsf(dd)); }
            bf16x8 pw0, pw1;
            { u32x4 t0, t1;
              t0.x = cvt_pk_bf16(p[0], p[1]); t0.y = cvt_pk_bf16(p[2], p[3]); t0.z = cvt_pk_bf16(p[4], p[5]); t0.w = cvt_pk_bf16(p[6], p[7]);
              t1.x = cvt_pk_bf16(p[8], p[9]); t1.y = cvt_pk_bf16(p[10], p[11]); t1.z = cvt_pk_bf16(p[12], p[13]); t1.w = cvt_pk_bf16(p[14], p[15]);
              pw0 = __builtin_bit_cast(bf16x8, t0); pw1 = __builtin_bit_cast(bf16x8, t1); }
            {
#pragma unroll
                for (int dp = 0; dp < 4; ++dp) {
                    s16x4 lo[4], hh[4];
                    TR8(lo, hh, vba, dp * 4096);
                    __builtin_amdgcn_sched_barrier(0);
#pragma unroll
                    for (int j = 0; j < 4; ++j) {
                        const bf16x8 vf = (bf16x8){lo[j][0], lo[j][1], lo[j][2], lo[j][3], hh[j][0], hh[j][1], hh[j][2], hh[j][3]};
                        o[dp * 2 + (j >> 1)] = __builtin_amdgcn_mfma_f32_32x32x16_bf16((j & 1) ? pw1 : pw0, vf, o[dp * 2 + (j >> 1)], 0, 0, 0); }
                }
            }
        }
        FA_WAIT_BAR();
    }
#undef RT_DMA
    LAS float* wsf = (LAS float*)(lds + OFF_WS);
    float ssr[16];
#pragma unroll
    for (int i = 0; i < 16; ++i) { float s2 = 0.f;
#pragma unroll
        for (int d = 0; d < 8; ++d) s2 += o[d][i] * o[d][i];
        s2 = row32_sum(s2);
        ssr[i] = s2; if (r32 == 0) wsf[w * 32 + crow(i, hi)] = s2; }
    FA_WAIT_BAR();
    const size_t gbase = (size_t)(32 * rb) * LDO + 256 * dh + r32;
#pragma unroll
    for (int i = 0; i < 16; ++i) {
        const int q = crow(i, hi); const float rn = rsqrtf((ssr[i] + wsf[(w ^ 1) * 32 + q]) * (1.0f / 512.0f) + EPS);
        const size_t ro = gbase + (size_t)q * LDO;
#pragma unroll
        for (int d = 0; d < 8; ++d) { const float gt = bf2f(U.G[ro + 32 * d]); U.O[ro + 32 * d] = f2bf(o[d][i] * rn * (gt * fsigmoid(gt))); }
        __builtin_amdgcn_sched_barrier(0);
    }
    FA_WAIT_BAR();
}


struct Ret2Unit {
    const bf16_t* Q; const bf16_t* K; const bf16_t* V;
    const bf16_t* G; bf16_t* O; float* SS;
    int nt, c0; float lg;
};
__device__ __forceinline__ void fa_ret2_unit(LAS unsigned char* lds, const Ret2Unit& U, int WV) {
    constexpr int LDQ = 512, LDK = 512, LDV = 1024, LDO = 1024;
    constexpr int KB = 16384, SLOT = 32768, NS = 3, OFF_WS = NS * SLOT;
    static_assert(OFF_WS + 8 * 32 * 4 <= ATT_BYTES, "ret2 LDS");
    int tid = TID_OF(WV); asm volatile("" : "+v"(tid));
    const int w = __builtin_amdgcn_readfirstlane(tid >> 6), l = tid & 63, r32 = l & 31, hi = l >> 5, rb = w >> 1, dq = w & 1;
    const unsigned kvo = (unsigned)((l & 31) * LDK * 2 + (l >> 5) * 16), vvo = (unsigned)((l >> 2) * LDV * 2 + (l & 3) * 16);
#define R2_DMA(t, slot) do { \
        const char* kb_ = (const char*)U.K + (size_t)(t) * (32 * LDK * 2); const char* vb_ = (const char*)U.V + (size_t)(t) * (32 * LDV * 2); \
        unsigned kvo_ = kvo, vvo_ = vvo; asm volatile("" : "+v"(kvo_), "+v"(vvo_)); \
        _Pragma("unroll") for (int i_ = 0; i_ < 2; ++i_) { const int cp = w + 8 * i_; \
            __builtin_amdgcn_global_load_lds((const unsigned*)(kb_ + cp * 32 + kvo_), (LAS unsigned*)(lds + (slot) * SLOT + cp * 1024), 16, 0, 0); } \
        _Pragma("unroll") for (int i_ = 0; i_ < 2; ++i_) { const int pv_ = w + 8 * i_, dvb_ = pv_ >> 1, kg_ = pv_ & 1; \
            __builtin_amdgcn_global_load_lds((const unsigned*)(vb_ + kg_ * (16 * LDV * 2) + 64 * dvb_ + vvo_), (LAS unsigned*)(lds + (slot) * SLOT + KB + pv_ * 1024), 16, 0, 0); } \
    } while (0)
    R2_DMA(0, 0);
    if (U.nt > 1) R2_DMA(1, 1);
    bf16x8 qr[16];
    { const bf16_t* qp = U.Q + (size_t)(32 * rb + r32) * LDQ + 8 * hi;
#pragma unroll
      for (int d0 = 0; d0 < 16; ++d0) qr[d0] = *(const bf16x8*)(qp + 16 * d0); }
    f32x16 o[4];
    { float z = 0.f; asm volatile("" : "+v"(z));
#pragma unroll
    for (int d = 0; d < 4; ++d)
#pragma unroll
        for (int i = 0; i < 16; ++i) o[d][i] = z; }
    const int cw = U.c0 + (rb >> 1);
    const int kfo = hi * 512 + r32 * 16;
    const int vfo = (4 * hi + ((l & 15) >> 2)) * 64 + ((l >> 4) & 1) * 32 + (l & 3) * 8;
    const float qpos = (float)(64 * U.c0 + 32 * rb + r32);
    float cf[16];
#pragma unroll
    for (int i = 0; i < 16; ++i) cf[i] = __builtin_amdgcn_exp2f(-U.lg * (float)((i & 3) + 8 * (i >> 2)));
    asm volatile("s_waitcnt vmcnt(0) lgkmcnt(0)\n\ts_barrier" ::: "memory");
    int slot = 0;
    for (int t = 0; t < U.nt; ++t) {
        const int s2 = (slot >= 1) ? slot - 1 : 2;
        const bool more = (t + 2 < U.nt);
        if ((t >> 1) <= cw) {
            const LAS unsigned char* kb = lds + slot * SLOT + kfo;
            const unsigned vba = (unsigned)(size_t)(lds + slot * SLOT + KB + dq * 8192 + vfo);
            f32x16 p;
#pragma unroll
            for (int i = 0; i < 16; ++i) p[i] = 0.f;
            {   bf16x8 ka[2][4];
#define R2_LOADB(buf, b_) do { _Pragma("unroll") for (int j = 0; j < 4; ++j) ka[buf][j] = *(const LAS bf16x8*)(kb + (4 * (b_) + j) * 1024); } while (0)
                R2_LOADB(0, 0);
#pragma unroll
                for (int b_ = 0; b_ < 4; ++b_) {
                    if (b_ < 3) R2_LOADB((b_ + 1) & 1, b_ + 1);
                    __builtin_amdgcn_sched_barrier(0);
#pragma unroll
                    for (int j = 0; j < 4; ++j) p = __builtin_amdgcn_mfma_f32_32x32x16_bf16(ka[b_ & 1][j], qr[4 * b_ + j], p, 0, 0, 0);
                    __builtin_amdgcn_sched_barrier(0);
                }
#undef R2_LOADB
            }
            const float dqp = qpos - (float)(32 * t + 4 * hi);
            if ((t >> 1) < cw) {
                const float rowf = __builtin_amdgcn_exp2f(U.lg * dqp);
#pragma unroll
                for (int i = 0; i < 16; ++i) p[i] *= rowf * cf[i];
            } else {
#pragma unroll
                for (int i = 0; i < 16; ++i) { const float dd = dqp - (float)((i & 3) + 8 * (i >> 2)); p[i] *= __builtin_amdgcn_exp2f(U.lg * __builtin_fabsf(dd)); }
            }
            bf16x8 pw0, pw1;
            { u32x4 t0, t1;
              t0.x = cvt_pk_bf16(p[0], p[1]); t0.y = cvt_pk_bf16(p[2], p[3]); t0.z = cvt_pk_bf16(p[4], p[5]); t0.w = cvt_pk_bf16(p[6], p[7]);
              t1.x = cvt_pk_bf16(p[8], p[9]); t1.y = cvt_pk_bf16(p[10], p[11]); t1.z = cvt_pk_bf16(p[12], p[13]); t1.w = cvt_pk_bf16(p[14], p[15]);
              pw0 = __builtin_bit_cast(bf16x8, t0); pw1 = __builtin_bit_cast(bf16x8, t1); }
            {
                const LAS unsigned char* vbp = lds + slot * SLOT + KB + dq * 8192 + vfo;
#pragma unroll
                for (int dp = 0; dp < 2; ++dp)
#pragma unroll
                    for (int j = 0; j < 4; ++j) {
                        const s16x4 lo = ds_tr16(vbp + (dp * 4 + j) * 1024), hh = ds_tr16(vbp + (dp * 4 + j) * 1024 + 512);
                        const bf16x8 vf = (bf16x8){lo[0], lo[1], lo[2], lo[3], hh[0], hh[1], hh[2], hh[3]};
                        o[dp * 2 + (j >> 1)] = __builtin_amdgcn_mfma_f32_32x32x16_bf16((j & 1) ? pw1 : pw0, vf, o[dp * 2 + (j >> 1)], 0, 0, 0); }
            }
        }
        if (more) R2_DMA(t + 2, s2);
        if (more) asm volatile("s_waitcnt vmcnt(4) lgkmcnt(0)\n\ts_barrier" ::: "memory");
        else asm volatile("s_waitcnt vmcnt(0) lgkmcnt(0)\n\ts_barrier" ::: "memory");
        slot = (slot == 2) ? 0 : slot + 1;
    }
#undef R2_DMA
    LAS float* wsf = (LAS float*)(lds + OFF_WS);
    float ssr[16];
#pragma unroll
    for (int i = 0; i < 16; ++i) { float s2v = 0.f;
#pragma unroll
        for (int d = 0; d < 4; ++d) s2v += o[d][i] * o[d][i];
        s2v = row32_sum(s2v);
        ssr[i] = s2v; if (r32 == 0) wsf[w * 32 + crow(i, hi)] = s2v; }
    FA_WAIT_BAR();
    if (dq == 0 && r32 == 0) {
#pragma unroll
        for (int i = 0; i < 16; ++i) { const int q = crow(i, hi); U.SS[(size_t)(32 * rb + q) * 8] = ssr[i] + wsf[(w ^ 1) * 32 + q]; } }
    const size_t gbase = (size_t)(32 * rb) * LDO + 128 * dq + r32;
#pragma unroll
    for (int i = 0; i < 16; ++i) {
        const size_t ro = gbase + (size_t)crow(i, hi) * LDO;
#pragma unroll
        for (int d = 0; d < 4; ++d) { const float gt = bf2f(U.G[ro + 32 * d]); U.O[ro + 32 * d] = f2bf(o[d][i] * (gt * fsigmoid(gt))); }
        __builtin_amdgcn_sched_barrier(0);
    }
    FA_WAIT_BAR();
}

struct Ret3Unit {
    const bf16_t* Q; const bf16_t* K; const bf16_t* V;
    const bf16_t* G; bf16_t* O; float* SS;
    const bf16_t* ST;
    int nst, nt, c0; float lg;
};
__device__ __forceinline__ void fa_ret3_unit(LAS unsigned char* lds, const Ret3Unit& U, int WV) {
    constexpr int LDQ = 512, LDK = 512, LDV = 1024, LDO = 1024;
    constexpr int KB = 16384, SLOT = 32768, NS = 3, OFF_WS = NS * SLOT;
    static_assert(OFF_WS + 8 * 32 * 4 <= ATT_BYTES, "ret2 LDS");
    int tid = TID_OF(WV); asm volatile("" : "+v"(tid));
    const int w = __builtin_amdgcn_readfirstlane(tid >> 6), l = tid & 63, r32 = l & 31, hi = l >> 5, rb = w >> 1, dq = w & 1;
    const unsigned kvo = (unsigned)((l & 31) * LDK * 2 + (l >> 5) * 16), vvo = (unsigned)((l >> 2) * LDV * 2 + (l & 3) * 16);
#define R3_DMA(t, slot) do { \
        const char* kb_ = (const char*)U.K + (size_t)(t) * (32 * LDK * 2); const char* vb_ = (const char*)U.V + (size_t)(t) * (32 * LDV * 2); \
        unsigned kvo_ = kvo, vvo_ = vvo; asm volatile("" : "+v"(kvo_), "+v"(vvo_)); \
        _Pragma("unroll") for (int i_ = 0; i_ < 2; ++i_) { const int cp = w + 8 * i_; \
            __builtin_amdgcn_global_load_lds((const unsigned*)(kb_ + cp * 32 + kvo_), (LAS unsigned*)(lds + (slot) * SLOT + cp * 1024), 16, 0, 0); } \
        _Pragma("unroll") for (int i_ = 0; i_ < 2; ++i_) { const int pv_ = w + 8 * i_, dvb_ = pv_ >> 1, kg_ = pv_ & 1; \
            __builtin_amdgcn_global_load_lds((const unsigned*)(vb_ + kg_ * (16 * LDV * 2) + 64 * dvb_ + vvo_), (LAS unsigned*)(lds + (slot) * SLOT + KB + pv_ * 1024), 16, 0, 0); } \
    } while (0)
    const unsigned svo = (unsigned)(l * 512);
#define R3_DMAS(ts, slot) do { const char* sb_ = (const char*)U.ST + (size_t)((ts) >> 2) * (512 * 256 * 2) + ((ts) & 3) * 128; unsigned svo_ = svo; asm volatile("" : "+v"(svo_)); \
        _Pragma("unroll") for (int i_ = 0; i_ < 4; ++i_) { const int p_ = w + 8 * i_, c_ = p_ >> 2, dvq_ = p_ & 3; \
            __builtin_amdgcn_global_load_lds((const unsigned*)(sb_ + dvq_ * (64 * 512) + c_ * 16 + svo_), (LAS unsigned*)(lds + (slot) * SLOT + p_ * 1024), 16, 0, 0); } \
    } while (0)
#define R3_ANY(tt, slot) do { if ((tt) < nst) R3_DMAS((tt), (slot)); else R3_DMA((tt) - nst, (slot)); } while (0)
    const int nst = U.nst;
    R3_ANY(0, 0);
    R3_ANY(1, 1);
    bf16x8 qr[16];
    { const bf16_t* qp = U.Q + (size_t)(32 * rb + r32) * LDQ + 8 * hi;
#pragma unroll
      for (int d0 = 0; d0 < 16; ++d0) qr[d0] = *(const bf16x8*)(qp + 16 * d0); }
    f32x16 o[4];
    { float z = 0.f; asm volatile("" : "+v"(z));
#pragma unroll
    for (int d = 0; d < 4; ++d)
#pragma unroll
        for (int i = 0; i < 16; ++i) o[d][i] = z; }
    const int cw = U.c0 + (rb >> 1);
    const int kfo = hi * 512 + r32 * 16;
    const int vfo = (4 * hi + ((l & 15) >> 2)) * 64 + ((l >> 4) & 1) * 32 + (l & 3) * 8;
    const float qpos = (float)(64 * U.c0 + 32 * rb + r32);
    float cf[16];
#pragma unroll
    for (int i = 0; i < 16; ++i) cf[i] = __builtin_amdgcn_exp2f(-U.lg * (float)((i & 3) + 8 * (i >> 2)));
    asm volatile("s_waitcnt vmcnt(0) lgkmcnt(0)\n\ts_barrier" ::: "memory");
    PROBE_MARK1(lds, 10);
    int slot = 0;
    if (nst) {
        const float g512 = __builtin_amdgcn_exp2f(U.lg * 512.0f);
        const int ngrp = nst >> 2;
        for (int grp = 0; grp < ngrp; ++grp) {
            if (grp) {
#pragma unroll
                for (int d = 0; d < 4; ++d)
#pragma unroll
                    for (int i = 0; i < 16; ++i) o[d][i] *= g512; }
#pragma unroll
            for (int ts = 0; ts < 4; ++ts) {
                const LAS unsigned char* sb = lds + slot * SLOT + hi * 4096 + (128 * dq + r32) * 16;
#pragma unroll
                for (int d0l = 0; d0l < 4; ++d0l) {
                    bf16x8 sf[4];
#pragma unroll
                    for (int d = 0; d < 4; ++d) sf[d] = *(const LAS bf16x8*)(sb + d0l * 8192 + d * 512);
#pragma unroll
                    for (int d = 0; d < 4; ++d) o[d] = __builtin_amdgcn_mfma_f32_32x32x16_bf16(qr[4 * ts + d0l], sf[d], o[d], 0, 0, 0);
                }
                const int s2 = (slot >= 1) ? slot - 1 : 2;
                R3_ANY(4 * grp + ts + 2, s2);
                asm volatile("s_waitcnt vmcnt(4) lgkmcnt(0)\n\ts_barrier" ::: "memory");
                slot = (slot == 2) ? 0 : slot + 1;
            }
        }
#pragma unroll
        for (int i = 0; i < 16; ++i) { const float rf = __builtin_amdgcn_exp2f(U.lg * (float)(64 * U.c0 + 32 * rb + crow(i, hi) + 1));
#pragma unroll
            for (int d = 0; d < 4; ++d) o[d][i] *= rf; }
    }
#ifdef PROBE_NOTILE
    const int ntl_ = 0;
#else
    const int ntl_ = U.nt;
#endif
    for (int t = 0; t < ntl_; ++t) {
        const int s2 = (slot >= 1) ? slot - 1 : 2;
        const bool more = (t + 2 < U.nt);
        if ((t >> 1) <= cw) {
            const LAS unsigned char* kb = lds + slot * SLOT + kfo;
            const unsigned vba = (unsigned)(size_t)(lds + slot * SLOT + KB + dq * 8192 + vfo);
            f32x16 p;
#pragma unroll
            for (int i = 0; i < 16; ++i) p[i] = 0.f;
            {   bf16x8 ka[2][4];
#define R3_LOADB(buf, b_) do { _Pragma("unroll") for (int j = 0; j < 4; ++j) ka[buf][j] = *(const LAS bf16x8*)(kb + (4 * (b_) + j) * 1024); } while (0)
                R3_LOADB(0, 0);
#pragma unroll
                for (int b_ = 0; b_ < 4; ++b_) {
                    if (b_ < 3) R3_LOADB((b_ + 1) & 1, b_ + 1);
                    __builtin_amdgcn_sched_barrier(0);
#pragma unroll
                    for (int j = 0; j < 4; ++j) p = __builtin_amdgcn_mfma_f32_32x32x16_bf16(ka[b_ & 1][j], qr[4 * b_ + j], p, 0, 0, 0);
                    __builtin_amdgcn_sched_barrier(0);
                }
#undef R3_LOADB
            }
            const float dqp = qpos - (float)(32 * t + 4 * hi);
            if ((t >> 1) < cw) {
                const float rowf = __builtin_amdgcn_exp2f(U.lg * dqp);
#pragma unroll
                for (int i = 0; i < 16; ++i) p[i] *= rowf * cf[i];
            } else {
#pragma unroll
                for (int i = 0; i < 16; ++i) { const float dd = dqp - (float)((i & 3) + 8 * (i >> 2)); p[i] *= __builtin_amdgcn_exp2f(U.lg * __builtin_fabsf(dd)); }
            }
            bf16x8 pw0, pw1;
            { u32x4 t0, t1;
              t0.x = cvt_pk_bf16(p[0], p[1]); t0.y = cvt_pk_bf16(p[2], p[3]); t0.z = cvt_pk_bf16(p[4], p[5]); t0.w = cvt_pk_bf16(p[6], p[7]);
              t1.x = cvt_pk_bf16(p[8], p[9]); t1.y = cvt_pk_bf16(p[10], p[11]); t1.z = cvt_pk_bf16(p[12], p[13]); t1.w = cvt_pk_bf16(p[14], p[15]);
              pw0 = __builtin_bit_cast(bf16x8, t0); pw1 = __builtin_bit_cast(bf16x8, t1); }
            {
#pragma unroll
                for (int dp = 0; dp < 2; ++dp) {
                    s16x4 lo[4], hh[4];
                    TR8(lo, hh, vba, dp * 4096);
                    __builtin_amdgcn_sched_barrier(0);
#pragma unroll
                    for (int j = 0; j < 4; ++j) {
                        const bf16x8 vf = (bf16x8){lo[j][0], lo[j][1], lo[j][2], lo[j][3], hh[j][0], hh[j][1], hh[j][2], hh[j][3]};
                        o[dp * 2 + (j >> 1)] = __builtin_amdgcn_mfma_f32_32x32x16_bf16((j & 1) ? pw1 : pw0, vf, o[dp * 2 + (j >> 1)], 0, 0, 0); }
                }
            }
        }
        if (more) R3_DMA(t + 2, s2);
        if (more) asm volatile("s_waitcnt vmcnt(4) lgkmcnt(0)\n\ts_barrier" ::: "memory");
        else asm volatile("s_waitcnt vmcnt(0) lgkmcnt(0)\n\ts_barrier" ::: "memory");
        slot = (slot == 2) ? 0 : slot + 1;
    }
#undef R3_DMA
#undef R3_DMAS
#undef R3_ANY
    PROBE_MARK1(lds, 11);
    const char* gb = (const char*)U.G + ((size_t)(32 * rb) * LDO + 128 * dq) * 2;
    u32x4 gq[8];
#pragma unroll
    for (int it = 0; it < 8; ++it) { const int c = it * 64 + l, row = c >> 4, ch = c & 15; gq[it] = *(const u32x4*)(gb + ((size_t)row * LDO + ch * 8) * 2); }
    LAS float* wsf = (LAS float*)(lds + OFF_WS);
    float ssr[16];
#pragma unroll
    for (int i = 0; i < 16; ++i) { float s2v = 0.f;
#pragma unroll
        for (int d = 0; d < 4; ++d) s2v += o[d][i] * o[d][i];
        s2v = row32_sum(s2v);
        ssr[i] = s2v; if (r32 == 0) wsf[w * 32 + crow(i, hi)] = s2v; }
    FA_WAIT_BAR();
    PROBE_MARK1(lds, 12);
    if (dq == 0 && r32 == 0) {
#pragma unroll
        for (int i = 0; i < 16; ++i) { const int q = crow(i, hi); U.SS[(size_t)(32 * rb + q) * 8] = ssr[i] + wsf[(w ^ 1) * 32 + q]; } }
#ifndef PROBE_NOEPI_A
    { LAS unsigned char* stg = lds + w * 8192; char* obp = (char*)U.O + ((size_t)(32 * rb) * LDO + 128 * dq) * 2;
#pragma unroll
      for (int it = 0; it < 8; ++it) { const int c = it * 64 + l, row = c >> 4, ch = c & 15; *(LAS u32x4*)(stg + row * 256 + ch * 16) = gq[it]; }
      asm volatile("s_waitcnt lgkmcnt(0)" ::: "memory");
      PROBE_MARK1(lds, 13);
#ifndef PROBE_NOEPI_B
      unsigned short gt16[16][4];
#pragma unroll
      for (int i = 0; i < 16; ++i) { const int q = crow(i, hi);
#pragma unroll
          for (int d = 0; d < 4; ++d) gt16[i][d] = *(const LAS bf16_t*)(stg + q * 256 + (32 * d + r32) * 2); }
      asm volatile("s_waitcnt lgkmcnt(0)" ::: "memory");
#pragma unroll
      for (int i = 0; i < 16; ++i) { const int q = crow(i, hi);
#pragma unroll
          for (int d = 0; d < 4; ++d) { const float gt = bf2f(gt16[i][d]); *(LAS bf16_t*)(stg + q * 256 + (32 * d + r32) * 2) = f2bf(o[d][i] * (gt * fsigmoid(gt))); } }
#endif
      asm volatile("s_waitcnt lgkmcnt(0)" ::: "memory");
      PROBE_MARK1(lds, 14);
#pragma unroll
      for (int it = 0; it < 8; ++it) { const int c = it * 64 + l, row = c >> 4, ch = c & 15; *(u32x4*)(obp + ((size_t)row * LDO + ch * 8) * 2) = *(const LAS u32x4*)(stg + row * 256 + ch * 16); } }
#else
    { float a_ = 0.f; for (int d = 0; d < 4; ++d) for (int i = 0; i < 16; ++i) a_ += o[d][i]; U.O[tid] = f2bf(a_); }
#endif
    FA_WAIT_BAR();
    PROBE_MARK1(lds, 15);
}


struct StJob { const bf16_t* K; const bf16_t* V; bf16_t* ST; int nt; float lg; const bf16_t* PREV; float gprev; unsigned* waitc; };
__device__ __forceinline__ void st_job(LAS unsigned char* lds, const StJob& J, int WV) {
    constexpr int LDK = 512, LDV = 1024, VB = 16384, SLOT = 49152;
    static_assert(2 * SLOT <= ATT_BYTES, "st LDS");
    int tid = TID_OF(WV); asm volatile("" : "+v"(tid));
    const int w = __builtin_amdgcn_readfirstlane(tid >> 6), l = tid & 63, r32 = l & 31, hi = l >> 5, wm = w >> 1, wn = w & 1;
    const unsigned vvo = (unsigned)((l >> 2) * LDV * 2 + (l & 3) * 16), kvo = (unsigned)((l >> 2) * LDK * 2 + (l & 3) * 16);
#define ST_DMA(t, slot) do { const char* vb_ = (const char*)J.V + (size_t)(t) * (64 * LDV * 2); const char* kb_ = (const char*)J.K + (size_t)(t) * (64 * LDK * 2); \
        unsigned vvo_ = vvo, kvo_ = kvo; asm volatile("" : "+v"(vvo_), "+v"(kvo_)); \
        _Pragma("unroll") for (int i_ = 0; i_ < 2; ++i_) { const int p_ = w + 8 * i_, blk_ = p_ >> 2, kg_ = p_ & 3; \
            __builtin_amdgcn_global_load_lds((const unsigned*)(vb_ + kg_ * (16 * LDV * 2) + 64 * blk_ + vvo_), (LAS unsigned*)(lds + (slot) * SLOT + p_ * 1024), 16, 0, 0); } \
        _Pragma("unroll") for (int i_ = 0; i_ < 4; ++i_) { const int p_ = w + 8 * i_, blk_ = p_ >> 2, kg_ = p_ & 3; \
            __builtin_amdgcn_global_load_lds((const unsigned*)(kb_ + kg_ * (16 * LDK * 2) + 64 * blk_ + kvo_), (LAS unsigned*)(lds + (slot) * SLOT + VB + p_ * 1024), 16, 0, 0); } \
    } while (0)
    ST_DMA(0, 0);
    f32x16 acc[4];
    { float z = 0.f; asm volatile("" : "+v"(z));
#pragma unroll
    for (int d = 0; d < 4; ++d)
#pragma unroll
        for (int i = 0; i < 16; ++i) acc[d][i] = z; }
    float gj[8], gs[4];
#pragma unroll
    for (int j = 0; j < 8; ++j) gj[j] = __builtin_amdgcn_exp2f(-J.lg * (float)(8 * (j >> 2) + (j & 3)));
#pragma unroll
    for (int sI = 0; sI < 4; ++sI) gs[sI] = __builtin_amdgcn_exp2f(J.lg * (float)(63 - 16 * sI - 4 * hi));
    const float g64 = __builtin_amdgcn_exp2f(J.lg * 64.0f);
    const int tfo = (4 * hi + ((l & 15) >> 2)) * 64 + ((l >> 4) & 1) * 32 + (l & 3) * 8;
    FA_WAIT_BAR();
    for (int t = 0; t < J.nt; ++t) {
        const int slot = t & 1;
        if (t + 1 < J.nt) ST_DMA(t + 1, slot ^ 1);
#pragma unroll
        for (int d = 0; d < 4; ++d)
#pragma unroll
            for (int i = 0; i < 16; ++i) acc[d][i] *= g64;
        const unsigned va = (unsigned)(size_t)(lds + slot * SLOT + wm * 4096 + tfo);
        const unsigned ka = (unsigned)(size_t)(lds + slot * SLOT + VB + wn * 16384 + tfo);
#pragma unroll
        for (int sI = 0; sI < 4; ++sI) {
            s16x4 vlo, vhh, klo[4], khh[4];
            asm volatile("ds_read_b64_tr_b16 %0, %10 offset:%c12\n\tds_read_b64_tr_b16 %1, %10 offset:%c13\n\t"
                         "ds_read_b64_tr_b16 %2, %11 offset:%c14\n\tds_read_b64_tr_b16 %3, %11 offset:%c15\n\t"
                         "ds_read_b64_tr_b16 %4, %11 offset:%c16\n\tds_read_b64_tr_b16 %5, %11 offset:%c17\n\t"
                         "ds_read_b64_tr_b16 %6, %11 offset:%c18\n\tds_read_b64_tr_b16 %7, %11 offset:%c19\n\t"
                         "ds_read_b64_tr_b16 %8, %11 offset:%c20\n\tds_read_b64_tr_b16 %9, %11 offset:%c21\n\ts_waitcnt lgkmcnt(0)"
                         : "=&v"(vlo), "=&v"(vhh), "=&v"(klo[0]), "=&v"(khh[0]), "=&v"(klo[1]), "=&v"(khh[1]), "=&v"(klo[2]), "=&v"(khh[2]), "=&v"(klo[3]), "=&v"(khh[3])
                         : "v"(va), "v"(ka), "i"(sI * 1024), "i"(sI * 1024 + 512),
                           "i"(0 * 4096 + sI * 1024), "i"(0 * 4096 + sI * 1024 + 512), "i"(1 * 4096 + sI * 1024), "i"(1 * 4096 + sI * 1024 + 512),
                           "i"(2 * 4096 + sI * 1024), "i"(2 * 4096 + sI * 1024 + 512), "i"(3 * 4096 + sI * 1024), "i"(3 * 4096 + sI * 1024 + 512) : "memory");
            __builtin_amdgcn_sched_barrier(0);
            float x[8];
#pragma unroll
            for (int j = 0; j < 4; ++j) { x[j] = bf2f((unsigned short)vlo[j]) * (gs[sI] * gj[j]); x[4 + j] = bf2f((unsigned short)vhh[j]) * (gs[sI] * gj[4 + j]); }
            u32x4 aw; aw.x = cvt_pk_bf16(x[0], x[1]); aw.y = cvt_pk_bf16(x[2], x[3]); aw.z = cvt_pk_bf16(x[4], x[5]); aw.w = cvt_pk_bf16(x[6], x[7]);
            const bf16x8 af = __builtin_bit_cast(bf16x8, aw);
#pragma unroll
            for (int d = 0; d < 4; ++d) { const bf16x8 kf = (bf16x8){klo[d][0], klo[d][1], klo[d][2], klo[d][3], khh[d][0], khh[d][1], khh[d][2], khh[d][3]};
                acc[d] = __builtin_amdgcn_mfma_f32_32x32x16_bf16(af, kf, acc[d], 0, 0, 0); }
        }
        FA_WAIT_BAR();
    }
#undef ST_DMA
    if (J.waitc) {
        if (WV == 0) { unsigned sp = 0;
            while ((unsigned)__builtin_amdgcn_readfirstlane(__hip_atomic_load(J.waitc, __ATOMIC_RELAXED, __HIP_MEMORY_SCOPE_AGENT)) < 4u) { __builtin_amdgcn_s_sleep(2); if (++sp > (1u << 22)) break; }
            __builtin_amdgcn_fence(__ATOMIC_ACQUIRE, "agent");
            asm volatile("s_waitcnt vmcnt(0)" ::: "memory"); }
        asm volatile("s_waitcnt vmcnt(0) lgkmcnt(0)\n\ts_barrier" ::: "memory");
    }
    unsigned short pv[16][4];
    { const bf16_t* pp = J.PREV + (size_t)(32 * wm) * 256 + 128 * wn + r32;
#pragma unroll
      for (int i = 0; i < 16; ++i)
#pragma unroll
          for (int d = 0; d < 4; ++d) pv[i][d] = pp[(size_t)crow(i, hi) * 256 + 32 * d]; }
    const float gp = J.gprev;
    const int odd = l & 1;
    unsigned* op = (unsigned*)(J.ST + (size_t)(32 * wm) * 256 + 128 * wn + (r32 & ~1));
#pragma unroll
    for (int i = 0; i < 16; ++i) {
#pragma unroll
        for (int dp = 0; dp < 2; ++dp) {
            const float ae = acc[2 * dp][i] + gp * bf2f(pv[i][2 * dp]), ao = acc[2 * dp + 1][i] + gp * bf2f(pv[i][2 * dp + 1]);
            const float mine = odd ? ao : ae, give = odd ? ae : ao;
            const float got = dppf<0xB1>(give);
            const unsigned w2 = odd ? cvt_pk_bf16(got, mine) : cvt_pk_bf16(mine, got);
            __hip_atomic_store(op + ((size_t)crow(i, hi) * 256 + 32 * (2 * dp + odd)) / 2, w2, __ATOMIC_RELAXED, __HIP_MEMORY_SCOPE_AGENT);
        }
        __builtin_amdgcn_sched_barrier(0);
    }
    FA_WAIT_BAR();
}

__device__ __forceinline__ unsigned pk2(float lo, float hi) { return cvt_pk_bf16(lo, hi); }
__device__ __forceinline__ int win_src(int r) {
    if (r < 2048) {
        const int sec = r >> 10, rr = r & 1023, t = rr >> 8, p = rr & 255, bj = p >> 7, wc = (p >> 5) & 3, fq = (p >> 3) & 3, ne = p & 7;
        const int d = (fq == 0) ? (8 * bj + ne) : (16 * fq + 8 * bj + ne);
        return 6144 + sec * 1024 + t * 256 + 64 * wc + d; }
    if (r < 3072) return 8192 + (r - 2048);
    if (r < 4096) return 9216 + (r - 3072);
    if (r < 5120) return 10240 + 1024 + (r - 4096);
    if (r < 6144) return 10240 + 2048 + (r - 5120);
    if (r < 6656) return (r - 6144);
    if (r < 7168) return 1024 + (r - 6656);
    if (r < 8192) return 2048 + (r - 7168);
    if (r < 9216) return 4096 + (r - 8192);
    if (r < 9728) return 512 + (r - 9216);
    if (r < 10240) return 1536 + (r - 9728);
    if (r < 11264) return 3072 + (r - 10240);
    if (r < 12288) return 5120 + (r - 11264);
    return 10240 + (r - 12288);
}
struct P0Item { f32x4 v[8]; float sc[8]; };
__device__ __forceinline__ void p0_load(P0Item& it, int kind, const float* W, const float* W2, int Nsrc, const float* scale, int Nout, int item, int lane) {
    const int nblk = Nout / 32, kb = item / nblk, nb = item % nblk, k0 = 64 * kb, n0 = 32 * nb;
    const int kr = lane >> 3, c4 = lane & 7, rr = n0 + 4 * c4; const float* src = W; int sc;
    if (kind == 0) sc = rr; else if (kind == 1) sc = win_src(rr); else { const int t = rr >> 8, p = rr & 255; if (p < 128) sc = 128 * t + p; else { sc = 128 * t + p - 128; src = W2; } }
#pragma unroll
    for (int i = 0; i < 8; ++i) it.v[i] = __builtin_nontemporal_load((const f32x4*)(src + (size_t)(k0 + 8 * i + kr) * Nsrc + sc));
#pragma unroll
    for (int i = 0; i < 8; ++i) it.sc[i] = scale ? scale[k0 + 8 * i + kr] : 1.0f;
}
__device__ __forceinline__ void p0_store(const P0Item& it, bf16_t* WT, int K, int Nout, LAS float* scr, int item, int lane) {
    const int nblk = Nout / 32, kb = item / nblk, nb = item % nblk, k0 = 64 * kb, n0 = 32 * nb;
    const int kr = lane >> 3, c4 = lane & 7;
#pragma unroll
    for (int i = 0; i < 8; ++i) { const int kk = 8 * i + kr; const f32x4 x = it.v[i] * it.sc[i];
        scr[kk * 33 + 4 * c4 + 0] = x[0]; scr[kk * 33 + 4 * c4 + 1] = x[1]; scr[kk * 33 + 4 * c4 + 2] = x[2]; scr[kk * 33 + 4 * c4 + 3] = x[3]; }
    asm volatile("s_waitcnt lgkmcnt(0)" ::: "memory");
    const int c = lane & 7;
#pragma unroll
    for (int j = 0; j < 4; ++j) { const int n = (lane >> 3) + 8 * j; const LAS float* s = scr + (8 * c) * 33 + n;
        u32x4 o; o.x = pk2(s[0 * 33], s[1 * 33]); o.y = pk2(s[2 * 33], s[3 * 33]); o.z = pk2(s[4 * 33], s[5 * 33]); o.w = pk2(s[6 * 33], s[7 * 33]);
        *(u32x4*)(WT + (size_t)(n0 + n) * K + k0 + 8 * c) = o; }
    asm volatile("s_waitcnt lgkmcnt(0)" ::: "memory");
}

struct Args { InTab in; float* out; unsigned char* ws; int ph_lo, ph_hi; };

__global__ void __launch_bounds__(512, 2) mk_fwd(const Args args) {
    extern __shared__ __attribute__((aligned(16))) unsigned char lds_raw[];
    LAS unsigned char* lds = (LAS unsigned char*)lds_raw;
    volatile LAS unsigned* MISC = (volatile LAS unsigned*)(lds + MISC_OFF);
    const int tid0 = threadIdx.x;
    const int WV = __builtin_amdgcn_readfirstlane(tid0 >> 6);
    const int G = gridDim.x, bx = blockIdx.x; const int vcu = (G % 8 == 0) ? (bx % 8) * (G / 8) + bx / 8 : bx;
    Ctx cx;
    cx.in.tab = (const __attribute__((address_space(4))) InTab*)__builtin_amdgcn_kernarg_segment_ptr();
    cx.out = args.out; cx.ws = args.ws;
    for (int u = tid0; u < (LDS_BYTES - MISC_OFF) / 4; u += 512) ((LAS unsigned*)(lds + MISC_OFF))[u] = 0u;
    __syncthreads();
    unsigned* ctl = WSP(unsigned, WS_CTL);
    XcdBarrier bar; bar.bar = ctl + 4096; bar.x = 0; bar.st = nullptr;
    const bool multi = (args.ph_hi - args.ph_lo) > 1;
    if (multi) bar = xcd_barrier_post(ctl + 4096, MISC + 8, tid0 == 0);
    const int NGW = G * 8;

#define PHASE_IDS const int lane = lane_id(), wave = WV, tid = wave * 64 + lane, gw = vcu * 8 + wave; (void)tid; (void)gw
    if (args.ph_lo <= PH_PRO && PH_PRO < args.ph_hi) { PHASE_IDS;
            LAS float* scr = (LAS float*)(lds + wave * 16384);
            int base = 0;
#define RUNJOB(kind, W, W2, Nsrc, scale, dst, K_, Nout) do { const int nit = ((K_) / 64) * ((Nout) / 32); const int first = (gw - (base % NGW) + NGW) % NGW; \
                if (first < nit) { P0Item cur_; p0_load(cur_, kind, W, W2, Nsrc, scale, Nout, first, lane); \
                    for (int itx = first; itx < nit; itx += NGW) { P0Item nx_ = cur_; if (itx + NGW < nit) p0_load(nx_, kind, W, W2, Nsrc, scale, Nout, itx + NGW, lane); \
                        p0_store(cur_, WSP(bf16_t, dst), K_, Nout, scr, itx, lane); cur_ = nx_; } } \
                base += nit; } while (0)
            RUNJOB(1, CX_F(8), nullptr, DIN, CX_F(7), WS_WIN, 1024, DIN);
            RUNJOB(2, CX_F(4), CX_F(5), DFF, CX_F(3), WS_W1GU, 1024, 2 * DFF);
            RUNJOB(0, CX_F(6), nullptr, D, nullptr, WS_W1D, DFF, D);
            RUNJOB(2, CX_F(26), CX_F(27), DFF, CX_F(25), WS_W2GU, 1024, 2 * DFF);
            RUNJOB(0, CX_F(28), nullptr, D, nullptr, WS_W2D, DFF, D);
            RUNJOB(0, CX_F(10), nullptr, D, nullptr, WS_WRO, 512, D);
            RUNJOB(0, CX_F(10) + (size_t)512 * 1024, nullptr, D, nullptr, WS_WRO + (size_t)1 * 1024 * 512 * 2, 512, D);
            RUNJOB(0, CX_F(10) + (size_t)1024 * 1024, nullptr, D, nullptr, WS_WRO + (size_t)2 * 1024 * 512 * 2, 512, D);
            RUNJOB(0, CX_F(10) + (size_t)1536 * 1024, nullptr, D, nullptr, WS_WRO + (size_t)3 * 1024 * 512 * 2, 512, D);
            RUNJOB(0, CX_F(18), nullptr, D, nullptr, WS_WDO, 1024, D);
            RUNJOB(0, CX_F(23), nullptr, D, nullptr, WS_WMO, 1024, D);
            RUNJOB(0, CX_F(24), nullptr, D, nullptr, WS_WOUT, 1024, D);
            RUNJOB(0, CX_F(20), nullptr, 2048, nullptr, WS_WMKV, 1024, 2048);
#undef RUNJOB
            float* part0 = WSP(float, WS_PART); bf16_t* XB = WSP(bf16_t, WS_XB);
            for (int m0 = gw; m0 < T; m0 += 4 * NGW) {
                f32x4 v[4][4];
#pragma unroll
                for (int r = 0; r < 4; ++r) { const int mr = (m0 + r * NGW < T) ? m0 + r * NGW : m0; const f32x4* xr = (const f32x4*)(CX_F(0) + (size_t)mr * D) + lane;
#pragma unroll
                    for (int j = 0; j < 4; ++j) v[r][j] = __builtin_nontemporal_load(xr + 64 * j); }
#pragma unroll
                for (int r = 0; r < 4; ++r) { const int m = m0 + r * NGW; if (m >= T) break; float s = 0.f; unsigned long long* o8 = (unsigned long long*)(XB + (size_t)m * D) + lane;
#pragma unroll
                    for (int j = 0; j < 4; ++j) { const f32x4 x = v[r][j]; s += (x[0] * x[0] + x[1] * x[1]) + (x[2] * x[2] + x[3] * x[3]);
                        o8[64 * j] = (unsigned long long)pk2(x[0], x[1]) | ((unsigned long long)pk2(x[2], x[3]) << 32); }
                    s = wave_sum(s);
                    if (lane < 16) part0[(size_t)m * 16 + lane] = (lane == 0) ? s : 0.f; }
            }
            bf16_t* MN = WSP(bf16_t, WS_MEMN);
            for (int m = gw; m < TM; m += NGW) {
                const f32x4* xr = (const f32x4*)(CX_F(1) + (size_t)m * D) + lane; const f32x4* wr_ = (const f32x4*)CX_F(19) + lane; f32x4 v[4]; float s = 0.f;
#pragma unroll
                for (int j = 0; j < 4; ++j) { v[j] = xr[64 * j]; s += (v[j][0] * v[j][0] + v[j][1] * v[j][1]) + (v[j][2] * v[j][2] + v[j][3] * v[j][3]); }
                const float ri = rsqrtf(wave_sum(s) * (1.0f / D) + EPS); unsigned long long* o8 = (unsigned long long*)(MN + (size_t)m * D) + lane;
#pragma unroll
                for (int j = 0; j < 4; ++j) { const f32x4 wv = wr_[64 * j]; const f32x4 y = v[j] * ri * wv;
                    o8[64 * j] = (unsigned long long)pk2(y[0], y[1]) | ((unsigned long long)pk2(y[2], y[3]) << 32); }
            }
            float* rope = WSP(float, WS_DROPE); const int* pos = (const int*)CX_F(2);
            for (int e = gw * 64 + lane; e < T * 8; e += NGW * 64) { const int m = e >> 3, i = e & 7;
                const float inv = 1.0f / powf(500000.0f, (float)(2 * i) / 16.0f); const float ang = (float)pos[m] * inv; const float sn = sinf(ang), cs = cosf(ang);
                rope[(size_t)e * 2] = cs; rope[(size_t)e * 2 + 1] = sn; }
            if (bx == 0 && tid < 128) { const float tt = (float)tid / 127.0f; WSP(float, WS_RINV)[tid] = 1.0f / powf(10000.0f, tt); }
        if (multi) xcd_barrier(bar, WV == 0 && lane_id() == 0);
    }
#ifndef PHASE_SEQ
#define PHASE_SEQ 1,2,3,4,5,6,8,12,13,14,15
#endif
    constexpr int seq_[] = {PHASE_SEQ}; constexpr int nseq = sizeof(seq_) / sizeof(int);
    for (int si = 0; si < nseq; ++si) {
        int ph = 0;
#pragma unroll
        for (int k = 0; k < nseq; ++k) ph = (si == k) ? seq_[k] : ph;
        if (ph < args.ph_lo || ph >= args.ph_hi) continue;
        PROBE_T0(lds, ph);
        switch (ph) {
        case PH_F1GU: case PH_F1D: case PH_IN_DM: case PH_MG1: case PH_IN_R0: case PH_IN_R1: case PH_MG2: case PH_WOUT: case PH_F2GU: case PH_F2D: {
#ifndef NO_GEMM
            GemmSched S; S.ph = ph; S.c = bx; S.G = G; S.cxp = &cx;
            gemm_phase(lds, S, cx, WV);
#endif
        } break;
        case PH_ATT_DM: { PHASE_IDS;
            float lam, mcd;
            { float a = CX_F(13)[lane] * CX_F(14)[lane], b = CX_F(15)[lane] * CX_F(16)[lane], mq_ = fabsf(CX_F(11)[lane]), mk_ = fabsf(CX_F(12)[lane]);
              a = wave_sum(a); b = wave_sum(b); mq_ = wave_max(mq_); mk_ = wave_max(mk_);
              lam = uni(expf(a) - expf(b) + 0.2f); mcd = uni(8.0f * mq_ * mk_ * LOG2E); }
            bf16_t* DQ = WSP(bf16_t, WS_DQ); const bf16_t* DK = WSP(bf16_t, WS_DK); const bf16_t* DV_ = WSP(bf16_t, WS_DV);
            for (int id = vcu; id < 256; id += G) {
                const int bh = id >> 2, p = id & 3, b = bh >> 3, h = bh & 7;
#pragma unroll 1
                for (int half = 0; half < 2; ++half) { const int qb = half ? 7 - p : p;
                    FaUnit U; const size_t r0 = (size_t)b * SEQ + qb * 256;
                    U.Q = DQ + r0 * 1024 + h * 128; U.ldq = 1024; U.K = DK + (size_t)b * SEQ * 1024 + h * 128; U.ldk = 1024; U.V = DV_ + (size_t)b * SEQ * 1024 + h * 128; U.ldv = 1024;
                    U.O = DQ + r0 * 1024 + h * 128; U.ldo = 1024; U.nt = 4 * qb + 4; U.vis0 = 4 * qb; U.c = 0.125f * LOG2E; U.mc = mcd; U.lam = lam;
#ifndef NO_FADIFF
                    fa_unit<2, 64, 4, 1, 1, true>(lds, U, cx, WV);
#endif
                }
            }
            PROBE_MARK1(lds, 20);
            float mcm;
            { const int ln = lane_id(); float nq = 0.f, nk = 0.f;
#pragma unroll
              for (int j = 0; j < 4; ++j) { nq = fmaxf(nq, fabsf(CX_F(21)[ln + 64 * j])); nk = fmaxf(nk, fabsf(CX_F(22)[ln + 64 * j])); }
              nq = wave_max(nq); nk = wave_max(nk); mcm = uni(16.0f * nq * nk * LOG2E); }
            bf16_t* MQ = WSP(bf16_t, WS_MQ); const bf16_t* MK = WSP(bf16_t, WS_MK); const bf16_t* MV = WSP(bf16_t, WS_MV);
            for (int id = vcu; id < 256; id += G) {
                const int bh = id >> 3, qb = id & 7, b = bh >> 2, h = bh & 3;
                { FaUnit U; const size_t r0 = (size_t)b * SEQ + qb * 256;
                    U.Q = MQ + r0 * 1024 + h * 256; U.ldq = 1024; U.K = MK + (size_t)b * MEML * 1024 + h * 256; U.ldk = 1024; U.V = MV + (size_t)b * MEML * 1024 + h * 256; U.ldv = 1024;
                    U.O = MQ + r0 * 1024 + h * 256; U.ldo = 1024; U.nt = 4; U.vis0 = 4; U.c = 0.0625f * LOG2E; U.mc = mcm; U.lam = 0.f;
#ifndef NO_FAMEM
                    fa_unit<1, 256, 4, 2, 2, false, true>(lds, U, cx, WV);
#endif
                }
            }
        } break;
        case PH_ATT_R0: {
            unsigned* stc = WSP(unsigned, WS_CTL) + 12288;
            for (int sid = vcu; sid < 384; sid += G) {
                const int up = sid >> 7, x = sid & 127, hg = x >> 6, bh = (x >> 2) & 15, dvq = x & 3, b = bh >> 1, hl = bh & 1, h = 2 * hg + hl;
                const bf16_t* RK = hg ? (const bf16_t*)cx.out + (size_t)T * 512 : WSP(bf16_t, WS_RK); const bf16_t* RV = hg ? (const bf16_t*)cx.out + (size_t)T * 1024 : WSP(bf16_t, WS_RV);
                StJob J; J.K = RK + ((size_t)b * SEQ + 512 * up) * 512 + hl * 256; J.V = RV + ((size_t)b * SEQ + 512 * up) * 1024 + hl * 512 + dvq * 128;
                J.ST = WSP(bf16_t, WS_ST) + (size_t)hg * (6 * MiB) + ((size_t)(bh * 3 + up) * 512 + dvq * 128) * 256; J.nt = 8; J.lg = log2f(1.0f - exp2f(-5.0f - (float)h));
                J.PREV = up ? J.ST - (size_t)512 * 256 : J.K; J.gprev = up ? exp2f(J.lg * 512.0f) : 0.0f; J.waitc = up ? stc + ((hg * 16 + bh) * 3 + up - 1) * 16 : nullptr;
                st_job(lds, J, WV);
                if (WV == 0 && lane_id() == 0) __hip_atomic_fetch_add(stc + ((hg * 16 + bh) * 3 + up) * 16, 1u, __ATOMIC_RELAXED, __HIP_MEMORY_SCOPE_AGENT);
            }
            for (int jid = vcu; jid < 512; jid += G) {
                const int a = (jid >> 7) & 1, idx = ((jid >> 8) << 7) | (jid & 127), hg = idx >> 7, bh = (idx >> 3) & 15, r8 = idx & 7, v0 = r8 >> 1, dvh = r8 & 1;
                const int b = bh >> 1, hl = bh & 1, h = 2 * hg + hl;
                const bf16_t* RQ = hg ? (const bf16_t*)cx.out : WSP(bf16_t, WS_RQ); const bf16_t* RK = hg ? (const bf16_t*)cx.out + (size_t)T * 512 : WSP(bf16_t, WS_RK);
                const bf16_t* RV = hg ? (const bf16_t*)cx.out + (size_t)T * 1024 : WSP(bf16_t, WS_RV); bf16_t* RG = WSP(bf16_t, hg ? WS_RG1 : WS_RG0);
                const float lg = log2f(1.0f - exp2f(-5.0f - (float)h));
                int have = 0;
#pragma unroll 1
                for (int half = 0; half < 2; ++half) { const int sc = half ? 3 - a : a, v = half ? 3 - v0 : v0, u = 4 * sc + v;
                    if (sc > have) {
                        if (WV == 0) {
                            { unsigned sp = 0; unsigned* cp = stc + ((hg * 16 + bh) * 3 + sc - 1) * 16;
                                while ((unsigned)__builtin_amdgcn_readfirstlane(__hip_atomic_load(cp, __ATOMIC_RELAXED, __HIP_MEMORY_SCOPE_AGENT)) < 4u) { __builtin_amdgcn_s_sleep(2); if (++sp > (1u << 22)) break; } }
                            __builtin_amdgcn_fence(__ATOMIC_ACQUIRE, "agent");
                            asm volatile("s_waitcnt vmcnt(0)" ::: "memory"); }
                        asm volatile("s_waitcnt vmcnt(0) lgkmcnt(0)\n\ts_barrier" ::: "memory");
                        have = sc;
                    }
                    Ret3Unit U; const size_t r0 = (size_t)b * SEQ + u * 128, k0 = (size_t)b * SEQ + sc * 512;
                    U.Q = RQ + r0 * 512 + hl * 256; U.K = RK + k0 * 512 + hl * 256; U.V = RV + k0 * 1024 + hl * 512 + dvh * 256;
                    U.G = RG + r0 * 1024 + hl * 512 + dvh * 256; U.O = RG + r0 * 1024 + hl * 512 + dvh * 256; U.SS = WSP(float, WS_RSS) + r0 * 8 + h * 2 + dvh;
                    U.ST = WSP(bf16_t, WS_ST) + (size_t)hg * (6 * MiB) + ((size_t)(bh * 3 + (sc ? sc - 1 : 0)) * 512 + dvh * 256) * 256;
                    U.nst = sc ? 4 : 0; U.nt = 2 * (2 * v + 2); U.c0 = 2 * v; U.lg = lg;
                    fa_ret3_unit(lds, U, WV); }
            }
        } break;
        default: break;
        }
        PROBE_MARK(lds, ph, 6);
        if (multi && si + 1 < nseq) xcd_barrier(bar, WV == 0 && lane_id() == 0);
        PROBE_MARK(lds, ph, 5);
    }
#ifdef PROBE_PH
    if (multi) xcd_barrier(bar, WV == 0 && lane_id() == 0);
    if (bx == PROBE_BX && WV == 0 && lane_id() == 0) { const float us = (float)((volatile LAS unsigned*)(lds + MISC_OFF + 128))[1] * 0.01f - (float)PROBE_OFF; cx.out[0] = PROBE_Q * floorf(us / PROBE_Q + 0.5f); }
#endif
    if (false) { PHASE_IDS;
            const float* part3 = WSP(float, WS_PART) + (size_t)3 * T * 16;
            for (int m = gw; m < T; m += NGW) {
                const float ri = row_rinv(part3, m); f32x4* xr = (f32x4*)(cx.out + (size_t)m * D) + lane; const f32x4* wr_ = (const f32x4*)CX_F(29) + lane;
#pragma unroll
                for (int j = 0; j < 4; ++j) { const f32x4 v = xr[64 * j]; xr[64 * j] = v * ri * wr_[64 * j]; }
            }
    }
}

extern "C" void kernel_launch(void* const* d_in, const int* in_sizes, int n_in, void* d_out, int out_size, void* d_ws, size_t ws_size, hipStream_t stream) {
    static int grid = 0;
    if (grid == 0) {
        if (n_in != 30 || out_size != T * D || ws_size < WS_END) { fprintf(stderr, "kernel_launch: unexpected shapes (n_in %d out %d ws %zu)\n", n_in, out_size, ws_size); grid = -1; return; }
        int dev = 0, cus = 0, per_cu = 0;
        if (hipGetDevice(&dev) != hipSuccess || hipDeviceGetAttribute(&cus, hipDeviceAttributeMultiprocessorCount, dev) != hipSuccess) { grid = -1; return; }
        if (hipFuncSetAttribute((const void*)mk_fwd, hipFuncAttributeMaxDynamicSharedMemorySize, LDS_BYTES) != hipSuccess) { fprintf(stderr, "kernel_launch: hipFuncSetAttribute failed\n"); grid = -1; return; }
        if (hipOccupancyMaxActiveBlocksPerMultiprocessor(&per_cu, (const void*)mk_fwd, 512, LDS_BYTES) != hipSuccess || per_cu < 1) { fprintf(stderr, "kernel_launch: occupancy query says %d\n", per_cu); }
        (void)hipGetLastError();
        grid = cus;
    }
    if (grid < 0) return;
    (void)hipMemsetAsync((char*)d_ws + WS_CTL, 0, CTL_ZERO_BYTES, stream);
    Args a{};
    for (int i = 0; i < 30; ++i) a.in.p[i] = (const float*)d_in[i];
    a.out = (float*)d_out; a.ws = (unsigned char*)d_ws;
#if MK_N_LAUNCHES == 1
    a.ph_lo = 0; a.ph_hi = PH_COUNT;
    hipLaunchKernelGGL(mk_fwd, dim3(grid), dim3(512), LDS_BYTES, stream, a);
#else
    for (int ph = 0; ph < PH_COUNT; ++ph) { a.ph_lo = ph; a.ph_hi = ph + 1; hipLaunchKernelGGL(mk_fwd, dim3(grid), dim3(512), LDS_BYTES, stream, a); }
#endif
}
```
